# Optimizing an MI355X kernel written in HIP

```python
import jax, jax.numpy as jnp
from jax import lax
import numpy as np

D_MODEL = 2048
BATCH = 4
SEQ = 8192
DEPTH = 1

MIX_WIDTH = D_MODEL
NSA_HEAD_DIM = 64
NSA_HEADS = (MIX_WIDTH // 2) // NSA_HEAD_DIM
NSA_KV_HEADS = max(1, NSA_HEADS // 4)
NSA_GROUP = NSA_HEADS // NSA_KV_HEADS
NSA_WIDTH = NSA_HEADS * NSA_HEAD_DIM
NSA_KV_WIDTH = NSA_KV_HEADS * NSA_HEAD_DIM
CMP_LEN = 32
CMP_STRIDE = 16
CMP_HIDDEN = 128
SLC_BLOCK = 64
SLC_TOPK = 16
SLC_LOCAL = 2
WINDOW = 512
NSA_QBLOCK = 64
SLC_FORCE_SCORE = 1e4
NEG_INF = -1e30
RET_HEADS = 8
RET_WIDTH = MIX_WIDTH - NSA_WIDTH
RET_V_DIM = RET_WIDTH // RET_HEADS
RET_QK_DIM = RET_V_DIM
RET_CHUNK = 128
IN_SIZES = (NSA_WIDTH,) + (NSA_KV_WIDTH,) * 6 + (3 * NSA_HEADS, RET_HEADS * RET_QK_DIM, RET_HEADS * RET_QK_DIM, RET_WIDTH, RET_WIDTH)
IN_WIDTH = NSA_WIDTH + 6 * NSA_KV_WIDTH + 3 * NSA_HEADS + 2 * RET_HEADS * RET_QK_DIM + 2 * RET_WIDTH
PEER_HEADS = 8
PEER_N_KEYS = 128
PEER_EXPERTS = PEER_N_KEYS * PEER_N_KEYS
PEER_TOPK = 16
PEER_QUERY_DIM = 256
PEER_CHUNK = 128
EPS = 1e-6

kernel_name = "hymba_nsa_retention_peer_adaln"

F32 = jnp.float32


def rmsnorm(x, g):
    xf = x.astype(F32)
    y = xf * lax.rsqrt(jnp.mean(xf * xf, axis=-1, keepdims=True) + EPS)
    return (y * g.astype(F32)).astype(x.dtype)


def alibi_slopes(n):
    return jnp.exp2(-8.0 * (jnp.arange(n, dtype=F32) + 1.0) / n)


def split_cols(a, sizes):
    idx = []
    acc = 0
    for s in sizes[:-1]:
        acc += s
        idx.append(acc)
    return jnp.split(a, idx, axis=-1)


def nsa_compress(k, pe, w1, w2, idx):
    B, n_cmp, L = k.shape[0], idx.shape[0], idx.shape[1]
    blk = k[:, idx] + pe[:, None, :]
    blk = jnp.swapaxes(blk, 2, 3).reshape(B, n_cmp, NSA_KV_HEADS, L * NSA_HEAD_DIM)
    out = jax.nn.gelu(blk @ w1) @ w2
    return jnp.swapaxes(out, 1, 2)


def nsa_attention(q, kc, vc, ks, vs, kw, vw, gates, pe_k, pe_v, ck_w1, ck_w2, cv_w1, cv_w2):
    B, S = q.shape[0], q.shape[1]
    G, R, dk, QB = NSA_KV_HEADS, NSA_GROUP, NSA_HEAD_DIM, NSA_QBLOCK
    scale = dk ** -0.5
    dt = q.dtype
    n_cmp = (S - CMP_LEN) // CMP_STRIDE + 1
    cmp_idx = np.arange(n_cmp)[:, None] * CMP_STRIDE + np.arange(CMP_LEN)[None, :]
    cmp_end = jnp.asarray(cmp_idx[:, -1], jnp.int32)
    Kc = nsa_compress(kc, pe_k, ck_w1, ck_w2, cmp_idx)
    Vc = nsa_compress(vc, pe_v, cv_w1, cv_w2, cmp_idx)
    n_slc = S // SLC_BLOCK
    top_n = min(SLC_TOPK, n_slc)
    slc_start = np.arange(n_slc) * SLC_BLOCK
    overlap = jnp.asarray(((cmp_idx[:, :1] < slc_start[None, :] + SLC_BLOCK)
                           & (cmp_idx[:, -1:] >= slc_start[None, :])).astype(np.float32))
    Ks = ks.reshape(B, n_slc, SLC_BLOCK, G, dk).transpose(0, 3, 1, 2, 4)
    Vs = vs.reshape(B, n_slc, SLC_BLOCK, G, dk).transpose(0, 3, 1, 2, 4)
    Kw = jnp.pad(kw, ((0, 0), (WINDOW, 0), (0, 0), (0, 0)))
    Vw = jnp.pad(vw, ((0, 0), (WINDOW, 0), (0, 0), (0, 0)))
    slopes = alibi_slopes(NSA_HEADS).reshape(G, R)[:, :, None, None]
    nqb = S // QB
    qb = q.reshape(B, nqb, QB, G, R, dk).transpose(1, 0, 3, 4, 2, 5)
    gb = gates.reshape(B, nqb, QB, G, R, 3).transpose(1, 0, 3, 4, 2, 5)
    b_ix = jnp.arange(B)[:, None, None, None]
    g_ix = jnp.arange(G)[None, :, None, None]
    blk_ids = jnp.arange(n_slc)
    in_blk = jnp.arange(SLC_BLOCK)
    win_off = jnp.arange(WINDOW + QB)

    def query_block(args):
        i, qi, gi = args
        t = i * QB + jnp.arange(QB)
        d_c = t[:, None] - cmp_end[None, :]
        valid_c = d_c >= 0
        s_c = jnp.einsum('bgrqd,bgnd->bgrqn', qi, Kc).astype(F32) * scale - slopes * d_c.astype(F32)
        p_c = jnp.where(valid_c, jax.nn.softmax(jnp.where(valid_c, s_c, NEG_INF), axis=-1), 0.0)
        o_c = jnp.einsum('bgrqn,bgnd->bgrqd', p_c.astype(dt), Vc)
        imp = jnp.einsum('bgrqn,nm->bgqm', p_c, overlap)
        back = (t // SLC_BLOCK)[:, None] - blk_ids[None, :]
        valid_s = back >= 0
        forced = valid_s & ((blk_ids[None, :] == 0) | (back < SLC_LOCAL))
        imp = jnp.where(forced, SLC_FORCE_SCORE, jnp.where(valid_s, imp, -1.0))
        _, sel = lax.top_k(imp, top_n)
        K_sel = Ks[b_ix, g_ix, sel].reshape(B, G, QB, top_n * SLC_BLOCK, dk)
        V_sel = Vs[b_ix, g_ix, sel].reshape(B, G, QB, top_n * SLC_BLOCK, dk)
        pos_s = (sel[..., None] * SLC_BLOCK + in_blk).reshape(B, G, QB, top_n * SLC_BLOCK)
        d_s = (t[None, None, :, None] - pos_s)[:, :, None]
        s_s = jnp.einsum('bgrqd,bgqkd->bgrqk', qi, K_sel).astype(F32) * scale - slopes * d_s.astype(F32)
        p_s = jax.nn.softmax(jnp.where(d_s >= 0, s_s, NEG_INF), axis=-1)
        o_s = jnp.einsum('bgrqk,bgqkd->bgrqd', p_s.astype(dt), V_sel)
        K_w = lax.dynamic_slice_in_dim(Kw, i * QB, WINDOW + QB, axis=1)
        V_w = lax.dynamic_slice_in_dim(Vw, i * QB, WINDOW + QB, axis=1)
        pos_w = i * QB - WINDOW + win_off
        d_w = t[:, None] - pos_w[None, :]
        valid_w = (d_w >= 0) & (d_w < WINDOW) & (pos_w[None, :] >= 0)
        s_w = jnp.einsum('bgrqd,bkgd->bgrqk', qi, K_w).astype(F32) * scale - slopes * d_w.astype(F32)
        p_w = jax.nn.softmax(jnp.where(valid_w, s_w, NEG_INF), axis=-1)
        o_w = jnp.einsum('bgrqk,bkgd->bgrqd', p_w.astype(dt), V_w)
        gw = jax.nn.sigmoid(gi.astype(F32))
        o = gw[..., 0:1] * o_c + gw[..., 1:2] * o_s + gw[..., 2:3] * o_w
        return o.astype(dt)

    out = lax.map(query_block, (jnp.arange(nqb), qb, gb))
    return out.transpose(1, 0, 4, 2, 3, 5).reshape(B, S, NSA_HEADS, dk)


def retention(q, k, v, gate, g_out):
    B, S = q.shape[0], q.shape[1]
    H, dk, dv, C = RET_HEADS, RET_QK_DIM, RET_V_DIM, RET_CHUNK
    nC = S // C
    dt = q.dtype
    lg = jnp.log1p(-jnp.exp2(-5.0 - jnp.arange(H, dtype=F32)))
    pos = jnp.arange(C, dtype=F32)
    diff = pos[:, None] - pos[None, :]
    intra_decay = jnp.where(diff >= 0, jnp.exp(lg[:, None, None] * jnp.maximum(diff, 0.0)), 0.0)
    k_decay = jnp.exp(lg[:, None] * (C - 1.0 - pos))
    q_decay = jnp.exp(lg[:, None] * (pos + 1.0))
    chunk_decay = jnp.exp(lg * C)

    def to_chunks(a):
        return a.reshape(B, nC, C, H, a.shape[-1]).transpose(0, 3, 1, 2, 4).astype(F32)

    qc = to_chunks(q)
    kc = to_chunks(k) * (dk ** -0.5)
    vc = to_chunks(v)
    att = jnp.einsum('bhncd,bhnsd->bhncs', qc, kc) * intra_decay[:, None]
    o_intra = jnp.einsum('bhncs,bhnse->bhnce', att, vc)
    kv = jnp.einsum('bhncd,bhnce->nbhde', kc * k_decay[:, None, :, None], vc)

    def step(state, kv_n):
        return state * chunk_decay[None, :, None, None] + kv_n, state

    _, r_prev = lax.scan(step, jnp.zeros((B, H, dk, dv), F32), kv)
    o_cross = jnp.einsum('bhncd,nbhde->bhnce', qc * q_decay[:, None, :, None], r_prev)
    o = (o_intra + o_cross).transpose(0, 2, 3, 1, 4).reshape(B, S, H, dv)
    mu = jnp.mean(o, axis=-1, keepdims=True)
    var = jnp.mean(jnp.square(o - mu), axis=-1, keepdims=True)
    y = (o - mu) * lax.rsqrt(var + EPS) * g_out.astype(F32)
    return (jax.nn.silu(gate.astype(F32)) * y.reshape(B, S, H * dv)).astype(dt)


def peer_ffn(h, w_q, sub_keys, w_u, w_v):
    B, S, D = h.shape
    T = B * S
    K = PEER_TOPK
    dt = h.dtype
    hf = h.reshape(T, D)
    q = (hf @ w_q).reshape(T, PEER_HEADS, 2, PEER_QUERY_DIM // 2)
    s_half = jnp.einsum('thpd,hpkd->thpk', q, sub_keys).astype(F32)
    v_half, i_half = lax.top_k(s_half, K)
    cand_s = (v_half[:, :, 0, :, None] + v_half[:, :, 1, None, :]).reshape(T, PEER_HEADS, K * K)
    cand_i = (i_half[:, :, 0, :, None] * PEER_N_KEYS + i_half[:, :, 1, None, :]).reshape(T, PEER_HEADS, K * K)
    top_s, pick = lax.top_k(cand_s, K)
    experts = jnp.take_along_axis(cand_i, pick, axis=-1)
    gates = jax.nn.softmax(top_s, axis=-1)
    n_chunks = T // PEER_CHUNK
    E = PEER_HEADS * K

    def chunk(args):
        hc, ec, gc = args
        a = jnp.einsum('cd,ced->ce', hc, w_u[ec]).astype(F32)
        coef = (gc * jax.nn.gelu(a)).astype(dt)
        return jnp.einsum('ce,ced->cd', coef, w_v[ec])

    out = lax.map(chunk, (hf.reshape(n_chunks, PEER_CHUNK, D),
                          experts.reshape(n_chunks, PEER_CHUNK, E),
                          gates.reshape(n_chunks, PEER_CHUNK, E)))
    return out.reshape(B, S, D).astype(dt)


def setup_inputs(seed: int = 0) -> dict:
    key = jax.random.key(seed)
    ks = jax.random.split(key, 24)
    L = DEPTH

    def nrm(k, shape, s):
        return jax.random.normal(k, shape, F32) * s

    return {
        "x": nrm(ks[0], (BATCH, SEQ, D_MODEL), 1.0),
        "c": nrm(ks[1], (BATCH, D_MODEL), 1.0),
        "w_ada": nrm(ks[2], (L, D_MODEL, 6 * D_MODEL), 0.5 * D_MODEL ** -0.5),
        "b_ada": nrm(ks[3], (L, 6 * D_MODEL), 0.01),
        "g_norm_mix": 1.0 + nrm(ks[4], (L, D_MODEL), 0.02),
        "g_norm_ffn": 1.0 + nrm(ks[5], (L, D_MODEL), 0.02),
        "g_norm_final": 1.0 + nrm(ks[6], (D_MODEL,), 0.02),
        "w_in": nrm(ks[7], (L, D_MODEL, IN_WIDTH), D_MODEL ** -0.5),
        "cmp_pe_k": nrm(ks[8], (L, CMP_LEN, NSA_HEAD_DIM), 0.1),
        "cmp_pe_v": nrm(ks[9], (L, CMP_LEN, NSA_HEAD_DIM), 0.1),
        "cmp_k_w1": nrm(ks[10], (L, CMP_LEN * NSA_HEAD_DIM, CMP_HIDDEN), (CMP_LEN * NSA_HEAD_DIM) ** -0.5),
        "cmp_k_w2": nrm(ks[11], (L, CMP_HIDDEN, NSA_HEAD_DIM), CMP_HIDDEN ** -0.5),
        "cmp_v_w1": nrm(ks[12], (L, CMP_LEN * NSA_HEAD_DIM, CMP_HIDDEN), (CMP_LEN * NSA_HEAD_DIM) ** -0.5),
        "cmp_v_w2": nrm(ks[13], (L, CMP_HIDDEN, NSA_HEAD_DIM), CMP_HIDDEN ** -0.5),
        "g_nsa_out": 1.0 + nrm(ks[14], (L, NSA_HEADS, NSA_HEAD_DIM), 0.02),
        "g_ret_out": 1.0 + nrm(ks[15], (L, RET_HEADS, RET_V_DIM), 0.02),
        "w_out": nrm(ks[16], (L, MIX_WIDTH, D_MODEL), MIX_WIDTH ** -0.5),
        "peer_w_q": nrm(ks[17], (L, D_MODEL, PEER_HEADS * PEER_QUERY_DIM), D_MODEL ** -0.5),
        "peer_sub_keys": nrm(ks[18], (L, PEER_HEADS, 2, PEER_N_KEYS, PEER_QUERY_DIM // 2), (PEER_QUERY_DIM // 2) ** -0.5),
        "peer_u": nrm(ks[19], (L, PEER_EXPERTS, D_MODEL), D_MODEL ** -0.5),
        "peer_v": nrm(ks[20], (L, PEER_EXPERTS, D_MODEL), 0.25),
    }


def reference(x, c, w_ada, b_ada, g_norm_mix, g_norm_ffn, g_norm_final, w_in, cmp_pe_k, cmp_pe_v,
              cmp_k_w1, cmp_k_w2, cmp_v_w1, cmp_v_w2, g_nsa_out, g_ret_out, w_out,
              peer_w_q, peer_sub_keys, peer_u, peer_v):
    B, S, D = x.shape
    c_act = jax.nn.silu(c)
    for l in range(DEPTH):
        mod = (c_act @ w_ada[l] + b_ada[l]).reshape(B, 6, 1, D)
        shift1, scale1, gate1, shift2, scale2, gate2 = jnp.moveaxis(mod, 1, 0)
        h = rmsnorm(x, g_norm_mix[l]) * (1.0 + scale1) + shift1
        q_a, k_c, v_c, k_s, v_s, k_w, v_w, g_a, q_r, k_r, v_r, g_r = split_cols(h @ w_in[l], IN_SIZES)
        o_nsa = nsa_attention(q_a.reshape(B, S, NSA_HEADS, NSA_HEAD_DIM),
                              k_c.reshape(B, S, NSA_KV_HEADS, NSA_HEAD_DIM), v_c.reshape(B, S, NSA_KV_HEADS, NSA_HEAD_DIM),
                              k_s.reshape(B, S, NSA_KV_HEADS, NSA_HEAD_DIM), v_s.reshape(B, S, NSA_KV_HEADS, NSA_HEAD_DIM),
                              k_w.reshape(B, S, NSA_KV_HEADS, NSA_HEAD_DIM), v_w.reshape(B, S, NSA_KV_HEADS, NSA_HEAD_DIM),
                              g_a, cmp_pe_k[l], cmp_pe_v[l], cmp_k_w1[l], cmp_k_w2[l], cmp_v_w1[l], cmp_v_w2[l])
        o_nsa = rmsnorm(o_nsa, g_nsa_out[l]).reshape(B, S, NSA_WIDTH)
        o_ret = retention(q_r.reshape(B, S, RET_HEADS, RET_QK_DIM), k_r.reshape(B, S, RET_HEADS, RET_QK_DIM),
                          v_r.reshape(B, S, RET_HEADS, RET_V_DIM), g_r, g_ret_out[l])
        x = x + gate1 * (jnp.concatenate([o_nsa, o_ret], axis=-1) @ w_out[l])
        h2 = rmsnorm(x, g_norm_ffn[l]) * (1.0 + scale2) + shift2
        x = x + gate2 * peer_ffn(h2, peer_w_q[l], peer_sub_keys[l], peer_u[l], peer_v[l])
    return rmsnorm(x, g_norm_final)
```

```cpp
#include <hip/hip_runtime.h>
#include <hip/hip_cooperative_groups.h>
#include <stdint.h>
#include <cstdio>
#include <cstring>
namespace cg = cooperative_groups;

#define DEV __device__ __forceinline__
typedef unsigned short bf16_t;
typedef short bf16x8 __attribute__((ext_vector_type(8)));
typedef float f32x4 __attribute__((ext_vector_type(4)));
typedef unsigned u32x4 __attribute__((ext_vector_type(4)));
typedef unsigned u32x2 __attribute__((ext_vector_type(2)));

constexpr int D = 2048, NB = 4, S = 8192, T = NB * S;
constexpr int LDY = 6784;
constexpr int LDT = T + 192;
constexpr int C_QA = 0, C_KC = 1024, C_VC = 1280, C_KS = 1536, C_VS = 1792, C_KW = 2048, C_VW = 2304,
              C_QR = 2560, C_KR = 3584, C_VR = 4608, C_GR = 5632, C_GA = 6656;
constexpr int R_VS = 0, R_VW = 256, R_KR = 512, R_VR = 1536, NYT = 2560;
constexpr int LDS_BYTES = 73728;
constexpr float LOG2E = 1.4426950408889634f;

struct Params {
  const float *x, *c, *w_ada, *b_ada, *g_mix, *g_ffn, *g_final, *w_in, *pe_k, *pe_v, *ck_w1, *ck_w2, *cv_w1, *cv_w2,
      *g_nsa, *g_ret, *w_out, *w_q, *sub_keys, *peer_u, *peer_v;
  float* out;
  float *mod_part, *mod, *cbias, *X1;
  unsigned* bar;
  unsigned char *U8, *V8;
  bf16_t *WinT, *WoutT, *WqT, *SK, *w1T, *w2T, *H, *Y, *YT, *Kc, *VcT, *RT, *H2, *Qp, *Omix;
  int ph_lo, ph_hi;
};

typedef __bf16 bf16v2_t __attribute__((ext_vector_type(2)));
typedef float f32x2_t __attribute__((ext_vector_type(2)));
DEV unsigned pk_bf16(float lo, float hi) {
  const bf16v2_t r = __builtin_convertvector((f32x2_t){lo, hi}, bf16v2_t);
  return __builtin_bit_cast(unsigned, r);
}
DEV float bf_lo(unsigned w) { return __uint_as_float(w << 16); }
DEV float bf_hi(unsigned w) { return __uint_as_float(w & 0xffff0000u); }
DEV float bf2f(bf16_t h) { return __uint_as_float(((unsigned)h) << 16); }
DEV float ex2(float x) { return __builtin_amdgcn_exp2f(x); }
DEV float sigmoidf_(float x) { return 1.0f / (1.0f + __expf(-x)); }
DEV float gelu_tanh(float x) {
  float u = 0.7978845608028654f * (x + 0.044715f * x * x * x);
  float t = 1.0f - 2.0f / (__expf(2.0f * u) + 1.0f);
  return 0.5f * x * (1.0f + t);
}
DEV f32x4 mfma16(bf16x8 a, bf16x8 b, f32x4 c) { return __builtin_amdgcn_mfma_f32_16x16x32_bf16(a, b, c, 0, 0, 0); }
DEV bf16x8 ld8(const bf16_t* p) { return *(const bf16x8*)p; }
DEV bf16x8 as_bf8(u32x4 v) { return __builtin_bit_cast(bf16x8, v); }
DEV float wave_sum(float v) {
#pragma unroll
  for (int o = 32; o >= 1; o >>= 1) v += __shfl_xor(v, o);
  return v;
}


DEV int opaque_tid() { int t = threadIdx.x; asm volatile("" : "+v"(t)); return t; }

DEV void transpose_tile(const float* __restrict__ src, int ld_src, int mode, bf16_t* __restrict__ dst, int Kdim, int n0, int k0,
                        float* tile) {
  const int tid = threadIdx.x, tx = tid & 63, ty = tid >> 6;
  const int n = n0 + tx;
  int sc = n;
  bool ok = true;
  if (mode == 1) {
    if (n < 2560) sc = n;
    else if (n < 6656) sc = n + 48;
    else if (n < 6704) sc = n - 6656 + 2560;
    else { sc = 0; ok = false; }
  }
#pragma unroll
  for (int i = 0; i < 16; ++i) {
    const int kk = ty + 4 * i;
    tile[kk * 65 + tx] = ok ? src[(size_t)(k0 + kk) * ld_src + sc] : 0.f;
  }
  __syncthreads();
  const int nn = tid >> 2, kc = (tid & 3) * 16;
  unsigned w[8];
#pragma unroll
  for (int j = 0; j < 8; ++j) w[j] = pk_bf16(tile[(kc + 2 * j) * 65 + nn], tile[(kc + 2 * j + 1) * 65 + nn]);
  u32x4* d = (u32x4*)(dst + (size_t)(n0 + nn) * Kdim + k0 + kc);
  d[0] = (u32x4){w[0], w[1], w[2], w[3]};
  d[1] = (u32x4){w[4], w[5], w[6], w[7]};
  __syncthreads();
}

DEV void convert_unit(const float* __restrict__ src, bf16_t* __restrict__ dst, int unit) {
  const int tid = threadIdx.x;
#pragma unroll
  for (int i = 0; i < 4; ++i) {
    const size_t e = (size_t)unit * 8192 + i * 2048 + tid * 8;
    const f32x4 a = *(const f32x4*)(src + e), b = *(const f32x4*)(src + e + 4);
    *(u32x4*)(dst + e) = (u32x4){pk_bf16(a[0], a[1]), pk_bf16(a[2], a[3]), pk_bf16(b[0], b[1]), pk_bf16(b[2], b[3])};
  }
}

typedef float f32x2v __attribute__((ext_vector_type(2)));
DEV unsigned pk4_fp8(float a, float b, float c, float d) {
  int w = __builtin_amdgcn_cvt_pk_fp8_f32(a, b, 0, false);
  w = __builtin_amdgcn_cvt_pk_fp8_f32(c, d, w, true);
  return (unsigned)w;
}
DEV void convert_unit_fp8(const float* __restrict__ src, unsigned char* __restrict__ dst, int unit, float scale) {
  const int tid = threadIdx.x;
#pragma unroll
  for (int i = 0; i < 2; ++i) {
    const size_t e = (size_t)unit * 8192 + i * 4096 + tid * 16;
    f32x4 a[4];
#pragma unroll
    for (int j = 0; j < 4; ++j) a[j] = *(const f32x4*)(src + e + 4 * j) * scale;
    *(u32x4*)(dst + e) = (u32x4){pk4_fp8(a[0][0], a[0][1], a[0][2], a[0][3]), pk4_fp8(a[1][0], a[1][1], a[1][2], a[1][3]),
                                 pk4_fp8(a[2][0], a[2][1], a[2][2], a[2][3]), pk4_fp8(a[3][0], a[3][1], a[3][2], a[3][3])};
  }
}
constexpr float U8_SCALE = 64.0f, V8_SCALE = 4.0f;

DEV void phase0(const Params& p, char* lds) {
  float* fl = (float*)lds;
  const int tid = threadIdx.x;
  constexpr int U_MOD = 768, U_WIN = 106 * 32, U_W1 = 128, U_W2 = 4, U_CB = 32;
  constexpr int TOT = U_MOD + U_WIN + U_W1 + U_W2 + U_CB;
  for (int u0 = blockIdx.x; u0 < TOT; u0 += gridDim.x) {
    int u = u0;
    if (u < U_MOD) {
      const int colblk = u % 48, ks = u / 48;
      for (int i = tid; i < 512; i += 256) {
        const int b = i >> 7, k = i & 127;
        const float cv = p.c[b * D + ks * 128 + k];
        fl[i] = cv * sigmoidf_(cv);
      }
      __syncthreads();
      const int col = colblk * 256 + tid;
      float a0 = 0, a1 = 0, a2 = 0, a3 = 0;
      const float* wp = p.w_ada + (size_t)(ks * 128) * 12288 + col;
#pragma unroll 8
      for (int k = 0; k < 128; ++k) {
        const float w = wp[(size_t)k * 12288];
        a0 += fl[k] * w; a1 += fl[128 + k] * w; a2 += fl[256 + k] * w; a3 += fl[384 + k] * w;
      }
      float* mp = p.mod_part + (size_t)ks * 4 * 12288 + col;
      mp[0] = a0; mp[12288] = a1; mp[2 * 12288] = a2; mp[3 * 12288] = a3;
      __syncthreads();
      continue;
    }
    u -= U_MOD;
    if (u < U_WIN) { transpose_tile(p.w_in, 6704, 1, p.WinT, 2048, (u >> 5) * 64, (u & 31) * 64, fl); continue; }
    u -= U_WIN;
    if (u < U_W1) {
      const int kv = u >> 6, r = u & 63;
      transpose_tile(kv ? p.cv_w1 : p.ck_w1, 128, 0, p.w1T + (size_t)kv * 128 * 2048, 2048, (r >> 5) * 64, (r & 31) * 64, fl);
      continue;
    }
    u -= U_W1;
    if (u < U_W2) {
      const int kv = u >> 1, r = u & 1;
      transpose_tile(kv ? p.cv_w2 : p.ck_w2, 64, 0, p.w2T + (size_t)kv * 64 * 128, 128, 0, r * 64, fl);
      continue;
    }
    u -= U_W2;
    if (u < U_CB) {
      const int kv = u >> 4, ks = u & 15, j = tid & 127, half = tid >> 7;
      const float* pe = kv ? p.pe_v : p.pe_k;
      const float* w1 = kv ? p.cv_w1 : p.ck_w1;
      const int i0 = ks * 128 + half * 64;
      float a = 0.f;
#pragma unroll 8
      for (int i = 0; i < 64; ++i) a += pe[i0 + i] * w1[(size_t)(i0 + i) * 128 + j];
      p.cbias[(kv * 32 + ks * 2 + half) * 128 + j] = a;
      continue;
    }
  }
}

DEV void phase1(const Params& p) {
  const int tid = threadIdx.x;
  for (int u = blockIdx.x; u < 192; u += gridDim.x) {
    const int idx = u * 256 + tid;
    const int col = idx % 12288;
    float a = p.b_ada[col];
#pragma unroll
    for (int ks = 0; ks < 16; ++ks) a += p.mod_part[(size_t)ks * 4 * 12288 + idx];
    p.mod[idx] = a;
  }
}

DEV void rms_mod_phase(const float* __restrict__ xin, const float* __restrict__ g, const float* __restrict__ mod, int shift_idx,
                       int scale_idx, bf16_t* __restrict__ dst) {
  const int lane = threadIdx.x & 63, wid = threadIdx.x >> 6;
  for (int u = blockIdx.x; u < T / 4; u += gridDim.x) {
    const int tok = u * 4 + wid, b = tok / S;
    const float* xr = xin + (size_t)tok * D;
    f32x4 v[8];
    float ss = 0.f;
#pragma unroll
    for (int i = 0; i < 8; ++i) {
      v[i] = *(const f32x4*)(xr + i * 256 + lane * 4);
      ss += v[i][0] * v[i][0] + v[i][1] * v[i][1] + v[i][2] * v[i][2] + v[i][3] * v[i][3];
    }
    ss = wave_sum(ss);
    const float rstd = rsqrtf(ss * (1.0f / D) + 1e-6f);
    const float* sh = mod + (size_t)b * 12288 + shift_idx * D;
    const float* sc = mod + (size_t)b * 12288 + scale_idx * D;
#pragma unroll
    for (int i = 0; i < 8; ++i) {
      const int col = i * 256 + lane * 4;
      const f32x4 gg = *(const f32x4*)(g + col), s1 = *(const f32x4*)(sc + col), s0 = *(const f32x4*)(sh + col);
      float y[4];
#pragma unroll
      for (int j = 0; j < 4; ++j) y[j] = v[i][j] * rstd * gg[j] * (1.0f + s1[j]) + s0[j];
      *(u32x2*)(dst + (size_t)tok * D + col) = (u32x2){pk_bf16(y[0], y[1]), pk_bf16(y[2], y[3])};
    }
  }
}

constexpr int GL = 72;
template <class Epi>
DEV void gemm_phase(const bf16_t* __restrict__ A, const bf16_t* __restrict__ Bt, int M, int N, int K, char* lds, const Epi& epi) {
  bf16_t* sbuf = (bf16_t*)lds;
  const int ntn = N / 128, ntm = M / 128, nk = K / 64;
  const int xcd = blockIdx.x & 7, jb = blockIdx.x >> 3, bpx = (gridDim.x + 7 - xcd) >> 3;
  const int nsgn = (ntn + 7) >> 3, nsuper = (ntm >> 3) * nsgn;
  for (int sidx = xcd; sidx < nsuper; sidx += 8)
  for (int jj = jb; jj < 64; jj += bpx) {
    const int tm = (sidx / nsgn) * 8 + (jj >> 3), tn = (sidx % nsgn) * 8 + (jj & 7);
    if (tn >= ntn) continue;
    const int tid = opaque_tid(), lane = tid & 63, wid = tid >> 6, wm = wid >> 1, wn = wid & 1, lr = lane & 15, quad = lane >> 4;
    const int srow = tid >> 3, skc = (tid & 7) * 8;
    const bf16_t* Ag = A + (size_t)(tm * 128 + srow) * K + skc;
    const bf16_t* Bg = Bt + (size_t)(tn * 128 + srow) * K + skc;
    f32x4 acc[4][4];
#pragma unroll
    for (int i = 0; i < 4; ++i)
#pragma unroll
      for (int j = 0; j < 4; ++j) acc[i][j] = (f32x4){0.f, 0.f, 0.f, 0.f};
    u32x4 xa[4], xb[4], ya[4], yb[4];
#define G_LOAD(ra, rb, kt) do { _Pragma("unroll") for (int i = 0; i < 4; ++i) { \
      ra[i] = *(const u32x4*)(Ag + (size_t)(32 * i) * K + (kt) * 64); rb[i] = *(const u32x4*)(Bg + (size_t)(32 * i) * K + (kt) * 64); } } while (0)
#define G_STORE(ra, rb, buf) do { bf16_t* nA_ = sbuf + (buf) * (256 * GL); _Pragma("unroll") for (int i = 0; i < 4; ++i) { \
      *(u32x4*)(nA_ + (srow + 32 * i) * GL + skc) = ra[i]; *(u32x4*)(nA_ + 128 * GL + (srow + 32 * i) * GL + skc) = rb[i]; } } while (0)
#define G_COMPUTE(buf) do { const bf16_t* cA = sbuf + (buf) * (256 * GL); const bf16_t* cB = cA + 128 * GL; \
      _Pragma("unroll") for (int ks = 0; ks < 2; ++ks) { bf16x8 af[4], bfr[4]; \
        _Pragma("unroll") for (int i = 0; i < 4; ++i) { af[i] = ld8(cA + (wm * 64 + i * 16 + lr) * GL + ks * 32 + quad * 8); \
                                                      bfr[i] = ld8(cB + (wn * 64 + i * 16 + lr) * GL + ks * 32 + quad * 8); } \
        _Pragma("unroll") for (int i = 0; i < 4; ++i) _Pragma("unroll") for (int j = 0; j < 4; ++j) acc[i][j] = mfma16(af[i], bfr[j], acc[i][j]); \
        __builtin_amdgcn_sched_barrier(0); } } while (0)
    G_LOAD(xa, xb, 0);
    G_STORE(xa, xb, 0);
    G_LOAD(xa, xb, 1);
    G_LOAD(ya, yb, 2);
    __syncthreads();
    for (int kt = 0; kt < nk; kt += 2) {
      G_COMPUTE(0);
      G_STORE(xa, xb, 1);
      if (kt + 3 < nk) G_LOAD(xa, xb, kt + 3);
      __syncthreads();
      G_COMPUTE(1);
      if (kt + 2 < nk) G_STORE(ya, yb, 0);
      if (kt + 4 < nk) G_LOAD(ya, yb, kt + 4);
      __syncthreads();
    }
#undef G_LOAD
#undef G_STORE
#undef G_COMPUTE
    float* sC = (float*)lds;
    if (epi.rowmajor(tn)) {
#pragma unroll
      for (int i = 0; i < 4; ++i)
#pragma unroll
        for (int j = 0; j < 4; ++j)
#pragma unroll
          for (int r = 0; r < 4; ++r) sC[(wm * 64 + i * 16 + quad * 4 + r) * 132 + wn * 64 + j * 16 + lr] = acc[i][j][r];
      __syncthreads();
      epi(tm, tn, sC);
      __syncthreads();
    }
    if (epi.transposed(tn)) {
#pragma unroll
      for (int i = 0; i < 4; ++i)
#pragma unroll
        for (int j = 0; j < 4; ++j) *(f32x4*)(sC + (wn * 64 + j * 16 + lr) * 132 + wm * 64 + i * 16 + quad * 4) = acc[i][j];
      __syncthreads();
      epi.store_t(tm, tn, sC);
      __syncthreads();
    }
  }
}

struct Epi1 {
  bf16_t* Y; bf16_t* YT;
  DEV bool rowmajor(int tn) const { return !((tn == 14 || tn == 15) || (tn == 18 || tn == 19) || (tn >= 36 && tn < 44)); }
  DEV bool transposed(int tn) const { return (tn == 14 || tn == 15) || (tn == 18 || tn == 19) || (tn >= 28 && tn < 44); }
  DEV void operator()(int tm, int tn, const float* sC) const {
    const int tid = threadIdx.x;
#pragma unroll
    for (int i = 0; i < 8; ++i) {
      const int idx = tid + 256 * i, row = idx >> 4, c8 = idx & 15;
      const f32x4 a = *(const f32x4*)(sC + row * 132 + c8 * 8), b = *(const f32x4*)(sC + row * 132 + c8 * 8 + 4);
      *(u32x4*)(Y + (size_t)(tm * 128 + row) * LDY + tn * 128 + c8 * 8) =
          (u32x4){pk_bf16(a[0], a[1]), pk_bf16(a[2], a[3]), pk_bf16(b[0], b[1]), pk_bf16(b[2], b[3])};
    }
  }
  DEV void store_t(int tm, int tn, const float* sCT) const {
    const int tid = threadIdx.x;
    int r0;
    if (tn == 14 || tn == 15) r0 = R_VS + (tn - 14) * 128;
    else if (tn == 18 || tn == 19) r0 = R_VW + (tn - 18) * 128;
    else if (tn < 36) r0 = R_KR + (tn - 28) * 128;
    else r0 = R_VR + (tn - 36) * 128;
#pragma unroll
    for (int i = 0; i < 8; ++i) {
      const int idx = tid + 256 * i, col = idx >> 4, ch = idx & 15;
      const f32x4 a = *(const f32x4*)(sCT + col * 132 + ch * 8), b = *(const f32x4*)(sCT + col * 132 + ch * 8 + 4);
      *(u32x4*)(YT + (size_t)(r0 + col) * LDT + tm * 128 + ch * 8) =
          (u32x4){pk_bf16(a[0], a[1]), pk_bf16(a[2], a[3]), pk_bf16(b[0], b[1]), pk_bf16(b[2], b[3])};
    }
  }
};
struct Epi2 {
  const float* x; const float* mod; float* X1;
  DEV bool rowmajor(int) const { return true; }
  DEV bool transposed(int) const { return false; }
  DEV void store_t(int, int, const float*) const {}
  DEV void operator()(int tm, int tn, const float* sC) const {
    const int tid = threadIdx.x, b = (tm * 128) / S;
#pragma unroll
    for (int i = 0; i < 16; ++i) {
      const int idx = tid + 256 * i, row = idx >> 5, c4 = idx & 31;
      const f32x4 v = *(const f32x4*)(sC + row * 132 + c4 * 4);
      const size_t t = (size_t)tm * 128 + row;
      const int col = tn * 128 + c4 * 4;
      const f32x4 xi = *(const f32x4*)(x + t * D + col), gt = *(const f32x4*)(mod + (size_t)b * 12288 + 2 * D + col);
      *(f32x4*)(X1 + t * D + col) = xi + gt * v;
    }
  }
};
struct Epi3 {
  bf16_t* Q;
  DEV bool rowmajor(int) const { return true; }
  DEV bool transposed(int) const { return false; }
  DEV void store_t(int, int, const float*) const {}
  DEV void operator()(int tm, int tn, const float* sC) const {
    const int tid = threadIdx.x;
#pragma unroll
    for (int i = 0; i < 8; ++i) {
      const int idx = tid + 256 * i, row = idx >> 4, c8 = idx & 15;
      const f32x4 a = *(const f32x4*)(sC + row * 132 + c8 * 8), b = *(const f32x4*)(sC + row * 132 + c8 * 8 + 4);
      *(u32x4*)(Q + (size_t)(tm * 128 + row) * D + tn * 128 + c8 * 8) =
          (u32x4){pk_bf16(a[0], a[1]), pk_bf16(a[2], a[3]), pk_bf16(b[0], b[1]), pk_bf16(b[2], b[3])};
    }
  }
};

DEV float ret_lg2(int h) { return log1pf(-ex2(-5.0f - (float)h)) * LOG2E; }

DEV void ret_state_unit(const Params& p, int u) {
  const int tid_ = opaque_tid(), lane = tid_ & 63, w = tid_ >> 6, lr = lane & 15, quad = lane >> 4;
  const int es = u & 7, h = (u >> 3) & 7, b = u >> 6;
  const float lg2 = ret_lg2(h);
  const float cd = ex2(lg2 * 128.0f);
  const float kscale = 0.08838834764831845f;
  f32x4 st[2];
  st[0] = (f32x4){0.f, 0.f, 0.f, 0.f}; st[1] = st[0];
  const bf16_t* vrow = p.YT + (size_t)(R_VR + h * 128 + es * 16 + lr) * LDT + (size_t)b * S + quad * 8;
  const bf16_t* krow0 = p.YT + (size_t)(R_KR + h * 128 + w * 32 + lr) * LDT + (size_t)b * S + quad * 8;
  const bf16_t* krow1 = krow0 + (size_t)16 * LDT;
  bf16_t* rt = p.RT + ((size_t)((b * 8 + h) * 64)) * 16384 + (size_t)(es * 16 + quad * 4) * 128 + w * 32 + lr;
  for (int n = 0; n < 64; ++n) {
#pragma unroll
    for (int nt = 0; nt < 2; ++nt)
#pragma unroll
      for (int r = 0; r < 4; ++r) {
        const float v = st[nt][r];
        rt[(size_t)n * 16384 + r * 128 + nt * 16] = (bf16_t)(pk_bf16(v, v) & 0xffffu);
      }
    if (n == 63) break;
    f32x4 kv[2];
    kv[0] = (f32x4){0.f, 0.f, 0.f, 0.f}; kv[1] = kv[0];
#pragma unroll
    for (int ks = 0; ks < 4; ++ks) {
      const u32x4 vv = *(const u32x4*)(vrow + n * 128 + ks * 32);
      const bf16x8 k0 = ld8(krow0 + n * 128 + ks * 32), k1 = ld8(krow1 + n * 128 + ks * 32);
      u32x4 vs;
#pragma unroll
      for (int q2 = 0; q2 < 4; ++q2) {
        const int j = ks * 32 + quad * 8 + q2 * 2;
        const float d0 = kscale * ex2(lg2 * (float)(127 - j)), d1 = kscale * ex2(lg2 * (float)(126 - j));
        vs[q2] = pk_bf16(bf_lo(vv[q2]) * d0, bf_hi(vv[q2]) * d1);
      }
      const bf16x8 va = as_bf8(vs);
      kv[0] = mfma16(va, k0, kv[0]);
      kv[1] = mfma16(va, k1, kv[1]);
    }
    st[0] = st[0] * cd + kv[0];
    st[1] = st[1] * cd + kv[1];
  }
}

DEV void compress_unit(const Params& p, int cu, char* lds) {
  const int tid_ = opaque_tid(), lane = tid_ & 63, w = tid_ >> 6, lr = lane & 15, quad = lane >> 4;
  const int kv = cu >> 7, rem = cu & 127, b = rem >> 5, g = (rem >> 3) & 3, nb = rem & 7;
  const int srccol = (kv ? C_VC : C_KC) + g * 64;
  const bf16_t* w1T = p.w1T + (size_t)kv * 128 * 2048;
  const bf16_t* w2T = p.w2T + (size_t)kv * 64 * 128;
  const float* cb = p.cbias + kv * 32 * 128;
  bf16_t* h1 = (bf16_t*)lds;
  f32x4 acc[4][2];
#pragma unroll
  for (int m = 0; m < 4; ++m) { acc[m][0] = (f32x4){0.f, 0.f, 0.f, 0.f}; acc[m][1] = acc[m][0]; }
  const bf16_t* b0 = w1T + (size_t)(w * 32 + lr) * 2048 + quad * 8;
  const bf16_t* b1 = b0 + (size_t)16 * 2048;
  const bf16_t* ybase = p.Y + (size_t)b * S * LDY + srccol;
#pragma unroll 2
  for (int ks = 0; ks < 64; ++ks) {
    const int l = ks >> 1, dof = (ks & 1) * 32 + quad * 8;
    const bf16x8 bf0 = ld8(b0 + ks * 32), bf1 = ld8(b1 + ks * 32);
#pragma unroll
    for (int m = 0; m < 4; ++m) {
      int tok = 16 * (nb * 64 + m * 16 + lr) + l;
      tok = tok < S ? tok : S - 1;
      const bf16x8 af = ld8(ybase + (size_t)tok * LDY + dof);
      acc[m][0] = mfma16(af, bf0, acc[m][0]);
      acc[m][1] = mfma16(af, bf1, acc[m][1]);
    }
  }
#pragma unroll
  for (int nt = 0; nt < 2; ++nt) {
    const int hc = w * 32 + nt * 16 + lr;
    float bias = 0.f;
#pragma unroll
    for (int pp = 0; pp < 32; ++pp) bias += cb[pp * 128 + hc];
#pragma unroll
    for (int m = 0; m < 4; ++m)
#pragma unroll
      for (int r = 0; r < 4; ++r) {
        const float v = gelu_tanh(acc[m][nt][r] + bias);
        h1[(m * 16 + quad * 4 + r) * 136 + hc] = (bf16_t)(pk_bf16(v, v) & 0xffffu);
      }
  }
  __syncthreads();
  const int d = w * 16 + lr;
  bf16x8 bb[4];
#pragma unroll
  for (int ks = 0; ks < 4; ++ks) bb[ks] = ld8(w2T + (size_t)d * 128 + ks * 32 + quad * 8);
#pragma unroll
  for (int m = 0; m < 4; ++m) {
    f32x4 o = (f32x4){0.f, 0.f, 0.f, 0.f};
#pragma unroll
    for (int ks = 0; ks < 4; ++ks) o = mfma16(ld8(h1 + (m * 16 + lr) * 136 + ks * 32 + quad * 8), bb[ks], o);
    const int n0 = nb * 64 + m * 16 + quad * 4;
    if (kv == 0) {
#pragma unroll
      for (int r = 0; r < 4; ++r) p.Kc[((size_t)(b * 4 + g) * 512 + n0 + r) * 64 + d] = (bf16_t)(pk_bf16(o[r], o[r]) & 0xffffu);
    } else {
      *(u32x2*)(p.VcT + ((size_t)(b * 4 + g) * 64 + d) * 512 + n0) = (u32x2){pk_bf16(o[0], o[1]), pk_bf16(o[2], o[3])};
    }
  }
  __syncthreads();
}

constexpr int NCONV = 1024 + 1024 + 32 + 4096 + 4096;
DEV void conv_unit(const Params& p, int u, char* lds) {
  constexpr int U_WOUT = 1024, U_WQ = 1024, U_SK = 32, U_U = 4096;
  if (u < U_WOUT) { transpose_tile(p.w_out, 2048, 0, p.WoutT, 2048, (u >> 5) * 64, (u & 31) * 64, (float*)lds); return; }
  u -= U_WOUT;
  if (u < U_WQ) { transpose_tile(p.w_q, 2048, 0, p.WqT, 2048, (u >> 5) * 64, (u & 31) * 64, (float*)lds); return; }
  u -= U_WQ;
  if (u < U_SK) { convert_unit(p.sub_keys, p.SK, u); return; }
  u -= U_SK;
  if (u < U_U) { convert_unit_fp8(p.peer_u, p.U8, u, U8_SCALE); return; }
  u -= U_U;
  convert_unit_fp8(p.peer_v, p.V8, u, V8_SCALE);
}
DEV void conv_drain(const Params& p, char* lds) {
  unsigned* cnt = p.bar + 64 * 100;
  int* slot = (int*)(lds + LDS_BYTES - 16);
  for (;;) {
    __syncthreads();
    if (threadIdx.x == 0) *slot = (int)__hip_atomic_fetch_add(cnt, 1u, __ATOMIC_RELAXED, __HIP_MEMORY_SCOPE_AGENT);
    __syncthreads();
    const int u = *slot;
    if (u >= NCONV) break;
    conv_unit(p, u, lds);
  }
}

DEV void phase4(const Params& p, char* lds) {
  for (int u = blockIdx.x; u < 512; u += gridDim.x) {
    if (u < 256) ret_state_unit(p, u);
    else compress_unit(p, u - 256, lds);
  }
  conv_drain(p, lds);
}

DEV void ret_out_unit(const Params& p, int u) {
  const int tid_ = opaque_tid(), lane = tid_ & 63, w = tid_ >> 6, lr = lane & 15, quad = lane >> 4;
  const int n = u & 63, h = (u >> 6) & 7, b = u >> 9;
  const float lg2 = ret_lg2(h);
  const float kscale = 0.08838834764831845f;
  const size_t tk0 = (size_t)b * S + n * 128;
  f32x4 o[8][2];
#pragma unroll
  for (int i = 0; i < 8; ++i) { o[i][0] = (f32x4){0.f, 0.f, 0.f, 0.f}; o[i][1] = o[i][0]; }
  bf16x8 qf[2][4];
#pragma unroll
  for (int nt = 0; nt < 2; ++nt)
#pragma unroll
    for (int ks = 0; ks < 4; ++ks)
      qf[nt][ks] = ld8(p.Y + (tk0 + w * 32 + nt * 16 + lr) * LDY + C_QR + h * 128 + ks * 32 + quad * 8);
  const bf16_t* rt = p.RT + ((size_t)((b * 8 + h) * 64 + n)) * 16384 + (size_t)lr * 128 + quad * 8;
#pragma unroll 2
  for (int ks = 0; ks < 4; ++ks)
#pragma unroll
    for (int et = 0; et < 8; ++et) {
      const bf16x8 af = ld8(rt + et * 16 * 128 + ks * 32);
      o[et][0] = mfma16(af, qf[0][ks], o[et][0]);
      o[et][1] = mfma16(af, qf[1][ks], o[et][1]);
    }
  int ti[2];
#pragma unroll
  for (int nt = 0; nt < 2; ++nt) {
    ti[nt] = w * 32 + nt * 16 + lr;
    const float qd = ex2(lg2 * (float)(ti[nt] + 1));
#pragma unroll
    for (int et = 0; et < 8; ++et) o[et][nt] = o[et][nt] * qd;
  }
  for (int jt = 0; jt <= w; ++jt) {
    const int j0 = jt * 32;
    f32x4 s[2][2];
#pragma unroll
    for (int mt = 0; mt < 2; ++mt) { s[mt][0] = (f32x4){0.f, 0.f, 0.f, 0.f}; s[mt][1] = s[mt][0]; }
#pragma unroll
    for (int mt = 0; mt < 2; ++mt)
#pragma unroll
      for (int ks = 0; ks < 4; ++ks) {
        const bf16x8 kf = ld8(p.Y + (tk0 + j0 + mt * 16 + lr) * LDY + C_KR + h * 128 + ks * 32 + quad * 8);
        s[mt][0] = mfma16(kf, qf[0][ks], s[mt][0]);
        s[mt][1] = mfma16(kf, qf[1][ks], s[mt][1]);
      }
    bf16x8 pb[2];
#pragma unroll
    for (int nt = 0; nt < 2; ++nt) {
      float pv[2][4];
#pragma unroll
      for (int mt = 0; mt < 2; ++mt)
#pragma unroll
        for (int r = 0; r < 4; ++r) {
          const int j = j0 + mt * 16 + quad * 4 + r;
          const int dd = ti[nt] - j;
          pv[mt][r] = dd >= 0 ? s[mt][nt][r] * kscale * ex2(lg2 * (float)dd) : 0.f;
        }
      pb[nt] = as_bf8((u32x4){pk_bf16(pv[0][0], pv[0][1]), pk_bf16(pv[0][2], pv[0][3]), pk_bf16(pv[1][0], pv[1][1]), pk_bf16(pv[1][2], pv[1][3])});
    }
#pragma unroll
    for (int et = 0; et < 8; ++et) {
      const bf16_t* vp = p.YT + (size_t)(R_VR + h * 128 + et * 16 + lr) * LDT + tk0 + j0 + quad * 4;
      const u32x2 lo = *(const u32x2*)vp, hi = *(const u32x2*)(vp + 16);
      const bf16x8 vf = as_bf8((u32x4){lo[0], lo[1], hi[0], hi[1]});
      o[et][0] = mfma16(vf, pb[0], o[et][0]);
      o[et][1] = mfma16(vf, pb[1], o[et][1]);
    }
  }
#pragma unroll
  for (int nt = 0; nt < 2; ++nt) {
    float sm = 0.f;
#pragma unroll
    for (int et = 0; et < 8; ++et) sm += o[et][nt][0] + o[et][nt][1] + o[et][nt][2] + o[et][nt][3];
    sm += __shfl_xor(sm, 16); sm += __shfl_xor(sm, 32);
    const float mu = sm * (1.0f / 128.0f);
    float sq = 0.f;
#pragma unroll
    for (int et = 0; et < 8; ++et)
#pragma unroll
      for (int r = 0; r < 4; ++r) { const float dlt = o[et][nt][r] - mu; sq += dlt * dlt; }
    sq += __shfl_xor(sq, 16); sq += __shfl_xor(sq, 32);
    const float rstd = rsqrtf(sq * (1.0f / 128.0f) + 1e-6f);
    const size_t tok = tk0 + ti[nt];
#pragma unroll
    for (int et = 0; et < 8; ++et) {
      const int e = et * 16 + quad * 4;
      const u32x2 gr = *(const u32x2*)(p.Y + tok * LDY + C_GR + h * 128 + e);
      const f32x4 gw = *(const f32x4*)(p.g_ret + h * 128 + e);
      const float gv[4] = {bf_lo(gr[0]), bf_hi(gr[0]), bf_lo(gr[1]), bf_hi(gr[1])};
      float y[4];
#pragma unroll
      for (int r = 0; r < 4; ++r) y[r] = (o[et][nt][r] - mu) * rstd * gw[r] * (gv[r] * sigmoidf_(gv[r]));
      *(u32x2*)(p.Omix + tok * D + 1024 + h * 128 + e) = (u32x2){pk_bf16(y[0], y[1]), pk_bf16(y[2], y[3])};
    }
  }
}

constexpr int NQT = 2;
struct AttnSt { f32x4 o[4][NQT]; float m[NQT], l[NQT]; };

DEV void attn_reset(AttnSt& st) {
#pragma unroll
  for (int j = 0; j < NQT; ++j) {
    st.m[j] = -1e30f; st.l[j] = 0.f;
#pragma unroll
    for (int i = 0; i < 4; ++i) st.o[i][j] = (f32x4){0.f, 0.f, 0.f, 0.f};
  }
}

constexpr int TL = 72;
constexpr int TILE_BUF_BYTES = 2 * 64 * TL * 2;
constexpr int NSA_TILE_OFF = 36864;
struct KVFrag { bf16x8 k[4][2]; bf16x8 v[4][2]; };

struct TileSrc { const bf16_t* kbase; size_t krs; const bf16_t* vbase; size_t vrs; };
template <bool WITH_V>
DEV void stage_load(u32x4 (&r)[4], const TileSrc& ts, int pos, int tid) {
#pragma unroll
  for (int i = 0; i < 2; ++i) {
    const int c = tid + 256 * i, row = c >> 3, ch = c & 7;
    r[i] = *(const u32x4*)(ts.kbase + (size_t)(pos + row) * ts.krs + ch * 8);
    if (WITH_V) r[2 + i] = *(const u32x4*)(ts.vbase + (size_t)row * ts.vrs + pos + ch * 8);
  }
}
template <bool WITH_V>
DEV void stage_store(bf16_t* tb, const u32x4 (&r)[4], int tid) {
#pragma unroll
  for (int i = 0; i < 2; ++i) {
    const int c = tid + 256 * i, row = c >> 3, ch = c & 7;
    *(u32x4*)(tb + row * TL + ch * 8) = r[i];
    if (WITH_V) *(u32x4*)(tb + 64 * TL + row * TL + ch * 8) = r[2 + i];
  }
}
DEV void lds_k(KVFrag& f, const bf16_t* tb, int lr, int quad) {
#pragma unroll
  for (int mt = 0; mt < 4; ++mt)
#pragma unroll
    for (int ks = 0; ks < 2; ++ks) f.k[mt][ks] = ld8(tb + (mt * 16 + lr) * TL + ks * 32 + quad * 8);
}
DEV void lds_v(KVFrag& f, const bf16_t* tb, int lr, int quad) {
#pragma unroll
  for (int dt = 0; dt < 4; ++dt)
#pragma unroll
    for (int hf = 0; hf < 2; ++hf) {
      const bf16_t* vp = tb + 64 * TL + (dt * 16 + lr) * TL + hf * 32 + quad * 4;
      const u32x2 lo = *(const u32x2*)vp, hi = *(const u32x2*)(vp + 16);
      f.v[dt][hf] = as_bf8((u32x4){lo[0], lo[1], hi[0], hi[1]});
    }
}
template <bool WITH_V, class NextFn, class ProcFn>
DEV void tile_loop(char* lds, int tid, const TileSrc& ts, NextFn next, ProcFn proc) {
  int cur = next();
  if (cur < 0) return;
  int n1 = next(), n2 = n1 >= 0 ? next() : -1;
  u32x4 r0[4], r1[4];
  stage_load<WITH_V>(r0, ts, cur, tid);
  stage_store<WITH_V>((bf16_t*)(lds + NSA_TILE_OFF), r0, tid);
  stage_load<WITH_V>(r0, ts, n1 >= 0 ? n1 : cur, tid);
  stage_load<WITH_V>(r1, ts, n2 >= 0 ? n2 : cur, tid);
  __syncthreads();
  while (true) {
    proc(cur, (const bf16_t*)(lds + NSA_TILE_OFF));
    stage_store<WITH_V>((bf16_t*)(lds + NSA_TILE_OFF + TILE_BUF_BYTES), r0, tid);
    const int n3 = n2 >= 0 ? next() : -1;
    stage_load<WITH_V>(r0, ts, n3 >= 0 ? n3 : cur, tid);
    __syncthreads();
    if (n1 < 0) break;
    proc(n1, (const bf16_t*)(lds + NSA_TILE_OFF + TILE_BUF_BYTES));
    stage_store<WITH_V>((bf16_t*)(lds + NSA_TILE_OFF), r1, tid);
    const int n4 = n3 >= 0 ? next() : -1;
    stage_load<WITH_V>(r1, ts, n4 >= 0 ? n4 : cur, tid);
    __syncthreads();
    if (n2 < 0) break;
    cur = n2; n1 = n3; n2 = n4;
  }
}

DEV void qk_tile(f32x4 (&s)[4][NQT], const KVFrag& f, const bf16x8 (&qf)[NQT][2]) {
#pragma unroll
  for (int mt = 0; mt < 4; ++mt)
#pragma unroll
    for (int nt = 0; nt < NQT; ++nt) {
      s[mt][nt] = mfma16(f.k[mt][0], qf[nt][0], (f32x4){0.f, 0.f, 0.f, 0.f});
      s[mt][nt] = mfma16(f.k[mt][1], qf[nt][1], s[mt][nt]);
    }
}
DEV void pv_tile(AttnSt& st, const KVFrag& f, const bf16x8 (&pb)[NQT][2]) {
#pragma unroll
  for (int dt = 0; dt < 4; ++dt)
#pragma unroll
    for (int hf = 0; hf < 2; ++hf)
#pragma unroll
      for (int nt = 0; nt < NQT; ++nt) st.o[dt][nt] = mfma16(f.v[dt][hf], pb[nt][hf], st.o[dt][nt]);
}

DEV void attn_tile(AttnSt& st, const bf16x8 (&qf)[NQT][2], const bf16_t* tb, int rel0, int lr, const unsigned (&selbit)[NQT], int maxdist,
                   bool need_mask, float c1, float slope2, int quad) {
  KVFrag f;
  lds_k(f, tb, lr, quad);
  f32x4 s[4][NQT];
  qk_tile(s, f, qf);
  lds_v(f, tb, lr, quad);
  const float b0 = slope2 * (float)(rel0 + quad * 4);
  float smaxv[NQT];
#pragma unroll
  for (int nt = 0; nt < NQT; ++nt) smaxv[nt] = -1e30f;
  float rbv = b0;
  const float step13 = slope2 * 13.0f;
#pragma unroll
  for (int mt = 0; mt < 4; ++mt)
#pragma unroll
    for (int r = 0; r < 4; ++r) {
      if (r > 0) rbv += slope2; else if (mt > 0) rbv += step13;
#pragma unroll
      for (int nt = 0; nt < NQT; ++nt) {
        const float v = fmaf(s[mt][nt][r], c1, rbv);
        s[mt][nt][r] = v;
        smaxv[nt] = fmaxf(smaxv[nt], v);
      }
    }
  if (need_mask) {
#pragma unroll
    for (int nt = 0; nt < NQT; ++nt) {
      float mx = -1e30f;
      const int dq = lr + nt * 16 - rel0 - quad * 4;
#pragma unroll
      for (int mt = 0; mt < 4; ++mt)
#pragma unroll
        for (int r = 0; r < 4; ++r) {
          const int dist = dq - (mt * 16 + r);
          const bool valid = selbit[nt] && dist >= 0 && dist <= maxdist;
          const float v = valid ? s[mt][nt][r] : -1e30f;
          s[mt][nt][r] = v;
          mx = fmaxf(mx, v);
        }
      smaxv[nt] = mx;
    }
  } else {
#pragma unroll
    for (int nt = 0; nt < NQT; ++nt) smaxv[nt] = selbit[nt] ? smaxv[nt] : -1e30f;
  }
  bf16x8 pb[NQT][2];
#pragma unroll
  for (int nt = 0; nt < NQT; ++nt) {
    float smax = smaxv[nt];
    smax = fmaxf(smax, __shfl_xor(smax, 16));
    smax = fmaxf(smax, __shfl_xor(smax, 32));
    const float mnew = fmaxf(st.m[nt], smax);
    const float alpha = ex2(st.m[nt] - mnew);
    st.m[nt] = mnew;
    const float mref = selbit[nt] ? fmaxf(mnew, -1e20f) : 1e30f;
    float ls = 0.f;
    float pv[4][4];
#pragma unroll
    for (int mt = 0; mt < 4; ++mt)
#pragma unroll
      for (int r = 0; r < 4; ++r) { const float e = ex2(s[mt][nt][r] - mref); pv[mt][r] = e; ls += e; }
    st.l[nt] = st.l[nt] * alpha + ls;
#pragma unroll
    for (int hf = 0; hf < 2; ++hf)
      pb[nt][hf] = as_bf8((u32x4){pk_bf16(pv[2 * hf][0], pv[2 * hf][1]), pk_bf16(pv[2 * hf][2], pv[2 * hf][3]),
                                  pk_bf16(pv[2 * hf + 1][0], pv[2 * hf + 1][1]), pk_bf16(pv[2 * hf + 1][2], pv[2 * hf + 1][3])});
#pragma unroll
    for (int dt = 0; dt < 4; ++dt) st.o[dt][nt] = st.o[dt][nt] * alpha;
  }
  pv_tile(st, f, pb);
}

DEV void cmp_scores(f32x4 (&s)[4][NQT], int n0, int t0, int lr, int quad, float c1, float slope2, bool full) {
  float rbv = slope2 * (float)(16 * (n0 + quad * 4) + 31 - t0);
  const float step16 = slope2 * 16.0f, step208 = slope2 * 208.0f;
#pragma unroll
  for (int mt = 0; mt < 4; ++mt)
#pragma unroll
    for (int r = 0; r < 4; ++r) {
      if (r > 0) rbv += step16; else if (mt > 0) rbv += step208;
      const int rel = 16 * (n0 + mt * 16 + quad * 4 + r) + 31 - t0;
#pragma unroll
      for (int nt = 0; nt < NQT; ++nt) {
        float v = fmaf(s[mt][nt][r], c1, rbv);
        if (!full) v = (rel <= lr + nt * 16) ? v : -1e30f;
        s[mt][nt][r] = v;
      }
    }
}

DEV void nsa_unit(const Params& p, int u, char* lds) {
  const int tid = opaque_tid(), lane = tid & 63, w = tid >> 6, lr = lane & 15, quad = lane >> 4;
  const int q32 = u & 255, g = (u >> 8) & 3, b = u >> 10;
  const int h = g * 4 + w, t0 = q32 * 32, qb = t0 >> 6;
  const size_t tokbase = (size_t)b * S;
  float* imp = (float*)lds;
  float* stash = (float*)lds;
  unsigned* selmask = (unsigned*)(lds + 32768);
  unsigned* unionm = (unsigned*)(lds + 32768 + 512);
  const float slope = ex2(-0.5f * (float)(h + 1));
  const float slope2 = slope * LOG2E, c1 = 0.125f * LOG2E;
  const int tq0 = t0 + lr;
  const float skipd = 200.0f / slope2;
  const float skipd_g = 200.0f / (ex2(-0.5f * (float)(g * 4 + 4)) * LOG2E);

  for (int i = tid; i < 32 * 129; i += 256) imp[i] = 0.f;
  if (tid < 4) unionm[tid] = 0u;
  bf16x8 qf[NQT][2];
#pragma unroll
  for (int nt = 0; nt < NQT; ++nt)
#pragma unroll
    for (int ks = 0; ks < 2; ++ks) qf[nt][ks] = ld8(p.Y + (tokbase + tq0 + nt * 16) * LDY + C_QA + h * 64 + ks * 32 + quad * 8);
  __syncthreads();
  auto gate = [&](int nt, int br) -> float {
    const bf16_t* gp = p.Y + (tokbase + tq0 + nt * 16) * LDY + C_GA + h * 3 + br;
    asm volatile("" : "+v"(gp));
    return sigmoidf_(bf2f(*gp));
  };

  AttnSt st;
  int nmax = t0 / 16;
  if (nmax > 510) nmax = 510;
  TileSrc tsc;
  tsc.kbase = p.Kc + (size_t)(b * 4 + g) * 512 * 64; tsc.krs = 64;
  tsc.vbase = p.VcT + (size_t)(b * 4 + g) * 64 * 512; tsc.vrs = 512;
  float m1[NQT], l1[NQT];
#pragma unroll
  for (int nt = 0; nt < NQT; ++nt) { m1[nt] = -1e30f; l1[nt] = 0.f; }
  int nstart = 0;
  while (nstart + 64 <= nmax && (float)(t0 - (16 * (nstart + 63) + 31)) > skipd_g) nstart += 64;
  {
    int nn = nstart;
    tile_loop<false>(lds, tid, tsc, [&]() -> int { const int r = nn <= nmax ? nn : -1; nn += 64; return r; },
      [&](int n0, const bf16_t* tb) {
        if ((float)(t0 - (16 * (n0 + 63) + 31)) > skipd) return;
        KVFrag f;
        lds_k(f, tb, lr, quad);
        f32x4 s[4][NQT];
        qk_tile(s, f, qf);
        const bool full = 16 * (n0 + 63) + 31 <= t0;
        if (full) cmp_scores(s, n0, t0, lr, quad, c1, slope2, true); else cmp_scores(s, n0, t0, lr, quad, c1, slope2, false);
#pragma unroll
        for (int nt = 0; nt < NQT; ++nt) {
          float smax = -1e30f;
#pragma unroll
          for (int mt = 0; mt < 4; ++mt)
#pragma unroll
            for (int r = 0; r < 4; ++r) smax = fmaxf(smax, s[mt][nt][r]);
          smax = fmaxf(smax, __shfl_xor(smax, 16));
          smax = fmaxf(smax, __shfl_xor(smax, 32));
          const float mnew = fmaxf(m1[nt], smax);
          const float mref = fmaxf(mnew, -1e20f);
          float ls = 0.f;
#pragma unroll
          for (int mt = 0; mt < 4; ++mt)
#pragma unroll
            for (int r = 0; r < 4; ++r) ls += ex2(s[mt][nt][r] - mref);
          l1[nt] = l1[nt] * ex2(m1[nt] - mnew) + ls;
          m1[nt] = mnew;
        }
      });
  }
  float il1[NQT];
#pragma unroll
  for (int nt = 0; nt < NQT; ++nt) {
    float l = l1[nt];
    l += __shfl_xor(l, 16); l += __shfl_xor(l, 32);
    il1[nt] = l > 0.f ? 1.0f / l : 0.f;
  }
  attn_reset(st);
  {
    int nn = nstart;
    tile_loop<true>(lds, tid, tsc, [&]() -> int { const int r = nn <= nmax ? nn : -1; nn += 64; return r; },
      [&](int n0, const bf16_t* tb) {
        if ((float)(t0 - (16 * (n0 + 63) + 31)) > skipd) return;
        KVFrag f;
        lds_k(f, tb, lr, quad);
        f32x4 s[4][NQT];
        qk_tile(s, f, qf);
        lds_v(f, tb, lr, quad);
        {
          const bool full = 16 * (n0 + 63) + 31 <= t0;
          if (full) cmp_scores(s, n0, t0, lr, quad, c1, slope2, true); else cmp_scores(s, n0, t0, lr, quad, c1, slope2, false);
        }
        bf16x8 pb[NQT][2];
#pragma unroll
        for (int nt = 0; nt < NQT; ++nt) {
          const float mref = fmaxf(m1[nt], -1e20f);
          float pv[4][4];
#pragma unroll
          for (int mt = 0; mt < 4; ++mt) {
#pragma unroll
            for (int r = 0; r < 4; ++r) pv[mt][r] = ex2(s[mt][nt][r] - mref) * il1[nt];
            const int msel = (n0 + mt * 16 + quad * 4) >> 2;
            const float s4 = (pv[mt][0] + pv[mt][1]) + (pv[mt][2] + pv[mt][3]);
            float* ip = imp + (nt * 16 + lr) * 129 + msel;
            if (s4 != 0.f) {
              atomicAdd(ip, s4);
              if (msel + 1 < 128 && pv[mt][3] != 0.f) atomicAdd(ip + 1, pv[mt][3]);
            }
          }
#pragma unroll
          for (int hf = 0; hf < 2; ++hf)
            pb[nt][hf] = as_bf8((u32x4){pk_bf16(pv[2 * hf][0], pv[2 * hf][1]), pk_bf16(pv[2 * hf][2], pv[2 * hf][3]),
                                        pk_bf16(pv[2 * hf + 1][0], pv[2 * hf + 1][1]), pk_bf16(pv[2 * hf + 1][2], pv[2 * hf + 1][3])});
        }
        pv_tile(st, f, pb);
      });
  }
  {
    unsigned um0 = 0, um1 = 0, um2 = 0, um3 = 0;
    for (int qi = 0; qi < 8; ++qi) {
      const int q = w * 8 + qi;
      unsigned key[2];
#pragma unroll
      for (int j = 0; j < 2; ++j) {
        const int m = lane + 64 * j;
        const float v = imp[q * 129 + m];
        unsigned k = (__float_as_uint(v) & 0xffffff80u) + 0x80u + (unsigned)(127 - m);
        if (m == 0 || m == qb || m + 1 == qb) k = 0x7f000000u + (unsigned)(127 - m);
        if (m > qb) k = 0u;
        key[j] = k;
      }
      unsigned thr = 0u;
#pragma unroll 1
      for (int bit = 30; bit >= 0; --bit) {
        const unsigned cand = thr | (1u << bit);
        const int cnt = __popcll(__ballot(key[0] >= cand)) + __popcll(__ballot(key[1] >= cand));
        if (cnt >= 16) thr = cand;
      }
      const bool sel0 = key[0] >= thr && key[0] != 0u, sel1 = key[1] >= thr && key[1] != 0u;
      const unsigned long long b0 = __ballot(sel0), b1 = __ballot(sel1);
      const unsigned w0 = (unsigned)b0, w1 = (unsigned)(b0 >> 32), w2 = (unsigned)b1, w3 = (unsigned)(b1 >> 32);
      if (lane == 0) { selmask[q * 4 + 0] = w0; selmask[q * 4 + 1] = w1; selmask[q * 4 + 2] = w2; selmask[q * 4 + 3] = w3; }
      um0 |= w0; um1 |= w1; um2 |= w2; um3 |= w3;
    }
    if (lane == 0) { atomicOr(&unionm[0], um0); atomicOr(&unionm[1], um1); atomicOr(&unionm[2], um2); atomicOr(&unionm[3], um3); }
  }
  __syncthreads();
#pragma unroll
  for (int nt = 0; nt < NQT; ++nt) {
    const float g0 = gate(nt, 0);
#pragma unroll
    for (int dt = 0; dt < 4; ++dt)
#pragma unroll
      for (int r = 0; r < 4; ++r) stash[((dt * NQT + nt) * 4 + r) * 256 + tid] = g0 * st.o[dt][nt][r];
  }

  attn_reset(st);
  {
    TileSrc ts;
    ts.kbase = p.Y + tokbase * LDY + C_KS + g * 64; ts.krs = LDY;
    ts.vbase = p.YT + (size_t)(R_VS + g * 64) * LDT + tokbase; ts.vrs = LDT;
    const unsigned u0 = unionm[0], u1 = unionm[1], u2 = unionm[2], u3 = unionm[3];
    int wd = 0;
    unsigned um = u0;
    tile_loop<true>(lds, tid, ts,
      [&]() -> int {
        for (;;) {
          while (um == 0u && wd < 3) { ++wd; um = wd == 1 ? u1 : (wd == 2 ? u2 : u3); }
          if (um == 0u) return -1;
          const int bit = __builtin_ctz(um);
          um &= um - 1;
          const int pos = (wd * 32 + bit) * 64;
          if ((float)(t0 - pos - 63) <= skipd_g) return pos;
        }
      },
      [&](int pos0, const bf16_t* tb) {
        if ((float)(t0 - pos0 - 63) > skipd) return;
        const int m = pos0 >> 6;
        unsigned selbit[NQT];
#pragma unroll
        for (int nt = 0; nt < NQT; ++nt) selbit[nt] = (selmask[(nt * 16 + lr) * 4 + (m >> 5)] >> (m & 31)) & 1u;
        attn_tile(st, qf, tb, pos0 - t0, lr, selbit, 1 << 30, m >= qb, c1, slope2, quad);
      });
  }
#pragma unroll
  for (int nt = 0; nt < NQT; ++nt) {
    float l = st.l[nt];
    l += __shfl_xor(l, 16); l += __shfl_xor(l, 32);
    const float f = gate(nt, 1) / l;
#pragma unroll
    for (int dt = 0; dt < 4; ++dt)
#pragma unroll
      for (int r = 0; r < 4; ++r) stash[((dt * NQT + nt) * 4 + r) * 256 + tid] += f * st.o[dt][nt][r];
  }
  attn_reset(st);
  {
    unsigned one[NQT];
#pragma unroll
    for (int nt = 0; nt < NQT; ++nt) one[nt] = 1u;
    int pstart = (t0 - 512) & ~63;
    if (pstart < 0) pstart = 0;
    TileSrc ts;
    ts.kbase = p.Y + tokbase * LDY + C_KW + g * 64; ts.krs = LDY;
    ts.vbase = p.YT + (size_t)(R_VW + g * 64) * LDT + tokbase; ts.vrs = LDT;
    int pp = pstart;
    tile_loop<true>(lds, tid, ts, [&]() -> int { const int r = pp < t0 + 32 ? pp : -1; pp += 64; return r; },
      [&](int pos0, const bf16_t* tb) {
        const int rel0 = pos0 - t0;
        if ((float)(-rel0 - 63) > skipd) return;
        attn_tile(st, qf, tb, rel0, lr, one, 511, !(rel0 + 63 <= 0 && rel0 >= 31 - 511), c1, slope2, quad);
      });
  }
#pragma unroll
  for (int nt = 0; nt < NQT; ++nt) {
    float l = st.l[nt];
    l += __shfl_xor(l, 16); l += __shfl_xor(l, 32);
    const float f = gate(nt, 2) / l;
    float ss = 0.f;
#pragma unroll
    for (int dt = 0; dt < 4; ++dt)
#pragma unroll
      for (int r = 0; r < 4; ++r) {
        const float v = stash[((dt * NQT + nt) * 4 + r) * 256 + tid] + f * st.o[dt][nt][r];
        st.o[dt][nt][r] = v;
        ss += v * v;
      }
    ss += __shfl_xor(ss, 16); ss += __shfl_xor(ss, 32);
    const float rstd = rsqrtf(ss * (1.0f / 64.0f) + 1e-6f);
#pragma unroll
    for (int dt = 0; dt < 4; ++dt) {
      const int d = dt * 16 + quad * 4;
      const f32x4 gn = *(const f32x4*)(p.g_nsa + h * 64 + d);
      *(u32x2*)(p.Omix + (tokbase + tq0 + nt * 16) * D + h * 64 + d) =
          (u32x2){pk_bf16(st.o[dt][nt][0] * rstd * gn[0], st.o[dt][nt][1] * rstd * gn[1]),
                  pk_bf16(st.o[dt][nt][2] * rstd * gn[2], st.o[dt][nt][3] * rstd * gn[3])};
    }
  }
  __syncthreads();
}

DEV void phase5(const Params& p, char* lds) {
  const int G = gridDim.x, bid = blockIdx.x;
  for (int r = 0; r * G < 6144; ++r) {
    const int v = r * G + ((r & 1) ? G - 1 - bid : bid);
    if (v >= 6144) continue;
    const int step = v / 24, within = v - step * 24;
    if (within < 16) {
      const int u = ((within >> 2) << 10) | ((within & 3) << 8) | (255 - step);
      nsa_unit(p, u, lds);
#if defined(REPU) && REPU == 1
      nsa_unit(p, u, lds);
#endif
    } else {
      ret_out_unit(p, step * 8 + (within - 16));
    }
  }
}

DEV int order_key(float v, int idx) {
  int bits = __float_as_int(v);
  bits ^= (bits >> 31) & 0x7fffffff;
  return (bits & ~0x7f) | (127 - idx);
}
DEV float key_val(int key) {
  int bits = key & ~0x7f;
  bits ^= (bits >> 31) & 0x7fffffff;
  return __int_as_float(bits);
}

DEV void peer_unit(const Params& p, int u, char* lds) {
  const int tid = opaque_tid(), lane = tid & 63, w = tid >> 6, lr = lane & 15, quad = lane >> 4;
  const int t0 = u * 16;
  int* sc = (int*)lds;
  int* tk = (int*)(lds + 16384);
  float* cval = (float*)(lds + 18432);
  int* exi = (int*)(lds + 22528);
  float* exg = (float*)(lds + 30720);
  for (int h = 0; h < 8; ++h) {
    {
      const int pp = w >> 1, nt0 = (w & 1) * 4;
      bf16x8 af[4];
#pragma unroll
      for (int ks = 0; ks < 4; ++ks) af[ks] = ld8(p.Qp + (size_t)(t0 + lr) * D + h * 256 + pp * 128 + ks * 32 + quad * 8);
#pragma unroll
      for (int nn = 0; nn < 4; ++nn) {
        const int nt = nt0 + nn;
        f32x4 acc = (f32x4){0.f, 0.f, 0.f, 0.f};
#pragma unroll
        for (int ks = 0; ks < 4; ++ks)
          acc = mfma16(af[ks], ld8(p.SK + ((size_t)((h * 2 + pp) * 128 + nt * 16 + lr)) * 128 + ks * 32 + quad * 8), acc);
#pragma unroll
        for (int r = 0; r < 4; ++r) sc[(pp * 16 + quad * 4 + r) * 128 + nt * 16 + lr] = order_key(acc[r], nt * 16 + lr);
      }
    }
    __syncthreads();
    for (int rr = 0; rr < 8; rr += 2) {
      const int rowA = w * 8 + rr, rowB = rowA + 1;
      const int a0 = sc[rowA * 128 + lane], a1 = sc[rowA * 128 + 64 + lane], b0 = sc[rowB * 128 + lane], b1 = sc[rowB * 128 + 64 + lane];
      const unsigned ua0 = (unsigned)a0 ^ 0x80000000u, ua1 = (unsigned)a1 ^ 0x80000000u, ub0 = (unsigned)b0 ^ 0x80000000u, ub1 = (unsigned)b1 ^ 0x80000000u;
      unsigned thA = 0u, thB = 0u;
#pragma unroll 1
      for (int bit = 31; bit >= 0; --bit) {
        const unsigned cA = thA | (1u << bit), cB = thB | (1u << bit);
        const int nA = __popcll(__ballot(ua0 >= cA)) + __popcll(__ballot(ua1 >= cA));
        const int nB = __popcll(__ballot(ub0 >= cB)) + __popcll(__ballot(ub1 >= cB));
        if (nA >= 16) thA = cA;
        if (nB >= 16) thB = cB;
      }
      const unsigned long long lt = (1ull << lane) - 1ull;
      {
        const unsigned long long m0 = __ballot(ua0 >= thA), m1 = __ballot(ua1 >= thA);
        if (ua0 >= thA) tk[rowA * 16 + __popcll(m0 & lt)] = a0;
        if (ua1 >= thA) tk[rowA * 16 + __popcll(m0) + __popcll(m1 & lt)] = a1;
      }
      {
        const unsigned long long m0 = __ballot(ub0 >= thB), m1 = __ballot(ub1 >= thB);
        if (ub0 >= thB) tk[rowB * 16 + __popcll(m0 & lt)] = b0;
        if (ub1 >= thB) tk[rowB * 16 + __popcll(m0) + __popcll(m1 & lt)] = b1;
      }
      if (lane < 32) {
        const int row = lane < 16 ? rowA : rowB, me = lane & 15;
        const int4 q0 = *(const int4*)(tk + row * 16), q1 = *(const int4*)(tk + row * 16 + 4), q2 = *(const int4*)(tk + row * 16 + 8), q3 = *(const int4*)(tk + row * 16 + 12);
        const int mine = tk[row * 16 + me];
        const int rank = (q0.x > mine) + (q0.y > mine) + (q0.z > mine) + (q0.w > mine) + (q1.x > mine) + (q1.y > mine) + (q1.z > mine) + (q1.w > mine) +
                         (q2.x > mine) + (q2.y > mine) + (q2.z > mine) + (q2.w > mine) + (q3.x > mine) + (q3.y > mine) + (q3.z > mine) + (q3.w > mine);
        tk[row * 16 + rank] = mine;
      }
    }
    __syncthreads();
    for (int tt = 0; tt < 4; ++tt) {
      const int tok = w * 4 + tt;
      int a = -1, bq = 0;
      {
        int c = lane;
        if (c < 16) { a = 0; bq = c; }
        else if (c < 24) { a = 1; bq = c - 16; }
        else if (c < 29) { a = 2; bq = c - 24; }
        else if (c < 33) { a = 3; bq = c - 29; }
        else if (c < 36) { a = 4; bq = c - 33; }
        else if (c < 38) { a = 5; bq = c - 36; }
        else if (c < 40) { a = 6; bq = c - 38; }
        else if (c < 42) { a = 7; bq = c - 40; }
        else if (c < 50) { a = c - 34; bq = 0; }
      }
      const bool act = a >= 0;
      const int ka = tk[(0 * 16 + tok) * 16 + (act ? a : 0)], kb = tk[(1 * 16 + tok) * 16 + bq];
      const float myv = act ? key_val(ka) + key_val(kb) : -3.0e38f;
      float* cv = cval + tok * 64;
      cv[lane] = myv;
      int rank = 0;
      for (int j = 0; j < 50; ++j) {
        const float vj = cv[j];
        rank += (vj > myv) || (vj == myv && j < lane);
      }
      float mx = act && rank == 0 ? myv : -3.0e38f;
#pragma unroll
      for (int o = 32; o >= 1; o >>= 1) mx = fmaxf(mx, __shfl_xor(mx, o));
      const bool win = act && rank < 16;
      const float ev = win ? __expf(myv - mx) : 0.f;
      const float sum = wave_sum(ev);
      if (win) {
        const int i0 = 127 - (ka & 0x7f), i1 = 127 - (kb & 0x7f);
        exi[tok * 128 + h * 16 + rank] = i0 * 128 + i1;
        exg[tok * 128 + h * 16 + rank] = ev / sum;
      }
    }
    __syncthreads();
  }
  for (int tt = 0; tt < 4; ++tt) {
    const int tok = w * 4 + tt;
    const size_t gt = (size_t)t0 + tok;
    const int b = (int)(gt / S);
    float hf[32];
#pragma unroll
    for (int i = 0; i < 2; ++i)
#pragma unroll
      for (int hh = 0; hh < 2; ++hh) {
        const u32x4 hv = *(const u32x4*)(p.H2 + gt * D + (i * 64 + lane) * 16 + hh * 8);
#pragma unroll
        for (int j = 0; j < 4; ++j) { hf[i * 16 + hh * 8 + 2 * j] = bf_lo(hv[j]); hf[i * 16 + hh * 8 + 2 * j + 1] = bf_hi(hv[j]); }
      }
    auto load_rows = [&](u32x4 (&r)[8], const unsigned char* base, int e0) {
#pragma unroll
      for (int k = 0; k < 4; ++k) {
        const unsigned char* rp = base + (size_t)exi[tok * 128 + e0 + k] * D + lane * 16;
        r[2 * k] = *(const u32x4*)rp; r[2 * k + 1] = *(const u32x4*)(rp + 1024);
      }
    };
    auto dot_rows = [&](const u32x4 (&r)[8], int e0) {
      float sv[4];
#pragma unroll
      for (int k = 0; k < 4; ++k) {
        float sa = 0.f, sb = 0.f;
#pragma unroll
        for (int j = 0; j < 4; ++j) {
          const f32x2v a0 = __builtin_amdgcn_cvt_pk_f32_fp8((int)r[2 * k][j], false), a1 = __builtin_amdgcn_cvt_pk_f32_fp8((int)r[2 * k][j], true);
          const f32x2v b0 = __builtin_amdgcn_cvt_pk_f32_fp8((int)r[2 * k + 1][j], false), b1 = __builtin_amdgcn_cvt_pk_f32_fp8((int)r[2 * k + 1][j], true);
          sa += a0[0] * hf[j * 4 + 0] + a0[1] * hf[j * 4 + 1] + a1[0] * hf[j * 4 + 2] + a1[1] * hf[j * 4 + 3];
          sb += b0[0] * hf[16 + j * 4 + 0] + b0[1] * hf[16 + j * 4 + 1] + b1[0] * hf[16 + j * 4 + 2] + b1[1] * hf[16 + j * 4 + 3];
        }
        sv[k] = sa + sb;
      }
      float r2[2], r1;
      const bool h32 = (lane & 32) != 0, h16 = (lane & 16) != 0;
#pragma unroll
      for (int k = 0; k < 2; ++k) { const float mine = h32 ? sv[k + 2] : sv[k], oth = h32 ? sv[k] : sv[k + 2]; r2[k] = mine + __shfl_xor(oth, 32); }
      { const float mine = h16 ? r2[1] : r2[0], oth = h16 ? r2[0] : r2[1]; r1 = mine + __shfl_xor(oth, 16); }
      r1 += __shfl_xor(r1, 8); r1 += __shfl_xor(r1, 4); r1 += __shfl_xor(r1, 2); r1 += __shfl_xor(r1, 1);
      if ((lane & 15) == 0) {
        const int k = (h32 ? 2 : 0) + (h16 ? 1 : 0);
        const int ei = tok * 128 + e0 + k;
        exg[ei] = exg[ei] * gelu_tanh(r1 * (1.0f / U8_SCALE)) * (1.0f / V8_SCALE);
      }
    };
    u32x4 ra[8], rb[8];
    load_rows(ra, p.U8, 0);
#pragma unroll 1
    for (int e0 = 0; e0 < 128; e0 += 8) {
      load_rows(rb, p.U8, e0 + 4);
      dot_rows(ra, e0);
      load_rows(ra, p.U8, e0 + 8 < 128 ? e0 + 8 : 124);
      dot_rows(rb, e0 + 4);
    }
    float oacc[32];
#pragma unroll
    for (int i = 0; i < 32; ++i) oacc[i] = 0.f;
    auto acc_rows = [&](const u32x4 (&r)[8], int e0) {
#pragma unroll
      for (int k = 0; k < 4; ++k) {
        const float coef = exg[tok * 128 + e0 + k];
#pragma unroll
        for (int j = 0; j < 4; ++j) {
          const f32x2v a0 = __builtin_amdgcn_cvt_pk_f32_fp8((int)r[2 * k][j], false), a1 = __builtin_amdgcn_cvt_pk_f32_fp8((int)r[2 * k][j], true);
          const f32x2v b0 = __builtin_amdgcn_cvt_pk_f32_fp8((int)r[2 * k + 1][j], false), b1 = __builtin_amdgcn_cvt_pk_f32_fp8((int)r[2 * k + 1][j], true);
          oacc[j * 4 + 0] += coef * a0[0]; oacc[j * 4 + 1] += coef * a0[1]; oacc[j * 4 + 2] += coef * a1[0]; oacc[j * 4 + 3] += coef * a1[1];
          oacc[16 + j * 4 + 0] += coef * b0[0]; oacc[16 + j * 4 + 1] += coef * b0[1]; oacc[16 + j * 4 + 2] += coef * b1[0]; oacc[16 + j * 4 + 3] += coef * b1[1];
        }
      }
    };
    load_rows(ra, p.V8, 0);
#pragma unroll 1
    for (int e0 = 0; e0 < 128; e0 += 8) {
      load_rows(rb, p.V8, e0 + 4);
      acc_rows(ra, e0);
      load_rows(ra, p.V8, e0 + 8 < 128 ? e0 + 8 : 124);
      acc_rows(rb, e0 + 4);
    }
    const float* g2 = p.mod + (size_t)b * 12288 + 5 * D;
    float ss = 0.f;
#pragma unroll
    for (int i = 0; i < 2; ++i)
#pragma unroll
      for (int q4 = 0; q4 < 4; ++q4) {
        const int col = (i * 64 + lane) * 16 + q4 * 4;
        const f32x4 x1 = *(const f32x4*)(p.X1 + gt * D + col), gg = *(const f32x4*)(g2 + col);
#pragma unroll
        for (int j = 0; j < 4; ++j) {
          const float v = x1[j] + gg[j] * oacc[i * 16 + q4 * 4 + j];
          oacc[i * 16 + q4 * 4 + j] = v;
          ss += v * v;
        }
      }
    ss = wave_sum(ss);
    const float rstd = rsqrtf(ss * (1.0f / D) + 1e-6f);
#pragma unroll
    for (int i = 0; i < 2; ++i)
#pragma unroll
      for (int q4 = 0; q4 < 4; ++q4) {
        const int col = (i * 64 + lane) * 16 + q4 * 4;
        const f32x4 gf = *(const f32x4*)(p.g_final + col);
        f32x4 o;
#pragma unroll
        for (int j = 0; j < 4; ++j) o[j] = oacc[i * 16 + q4 * 4 + j] * rstd * gf[j];
        *(f32x4*)(p.out + gt * D + col) = o;
      }
  }
  __syncthreads();
}

DEV void phase9(const Params& p, char* lds) {
  for (int u = blockIdx.x; u < T / 16; u += gridDim.x) peer_unit(p, u, lds);
}

DEV void gbar(unsigned* bar, unsigned& gen) {
  asm volatile("s_waitcnt vmcnt(0) lgkmcnt(0)" ::: "memory");
  __syncthreads();
  gen += 1u;
  if (threadIdx.x == 0) {
    __builtin_amdgcn_fence(__ATOMIC_RELEASE, "agent");
    asm volatile("s_waitcnt vmcnt(0)" ::: "memory");
    const unsigned G = gridDim.x, bidx = blockIdx.x;
    if ((G & 63u) == 0u) {
      const unsigned x = bidx & 7u, j = bidx >> 3, n2 = G >> 6;
      unsigned* c1 = bar + 64 * (x * 8 + (j >> 3));
      unsigned* c2 = bar + 64 * (64 + x);
      unsigned* c3 = bar + 64 * 72;
      unsigned* flag = bar + 64 * (73 + x);
      if (__hip_atomic_fetch_add(c1, 1u, __ATOMIC_RELAXED, __HIP_MEMORY_SCOPE_AGENT) + 1u == gen * 8u)
        if (__hip_atomic_fetch_add(c2, 1u, __ATOMIC_RELAXED, __HIP_MEMORY_SCOPE_AGENT) + 1u == gen * n2)
          if (__hip_atomic_fetch_add(c3, 1u, __ATOMIC_RELAXED, __HIP_MEMORY_SCOPE_AGENT) + 1u == gen * 8u)
            for (unsigned k = 0; k < 8u; ++k) __hip_atomic_store(bar + 64 * (73 + k), gen, __ATOMIC_RELAXED, __HIP_MEMORY_SCOPE_AGENT);
      while (__hip_atomic_load(flag, __ATOMIC_RELAXED, __HIP_MEMORY_SCOPE_AGENT) < gen) __builtin_amdgcn_s_sleep(2);
    } else {
      unsigned* c = bar + 64 * 72;
      __hip_atomic_fetch_add(c, 1u, __ATOMIC_RELAXED, __HIP_MEMORY_SCOPE_AGENT);
      while (__hip_atomic_load(c, __ATOMIC_RELAXED, __HIP_MEMORY_SCOPE_AGENT) < gen * G) __builtin_amdgcn_s_sleep(2);
    }
    __builtin_amdgcn_fence(__ATOMIC_ACQUIRE, "agent");
    asm volatile("s_waitcnt vmcnt(0)" ::: "memory");
  }
  __syncthreads();
}

__global__ void __launch_bounds__(256, 2) mega(Params p_unused) {
  __shared__ __attribute__((aligned(16))) char lds[LDS_BYTES];
  cg::grid_group grid = cg::this_grid();
  const Params& p = *(const Params*)__builtin_amdgcn_kernarg_segment_ptr();
  const int lo = p.ph_lo, hi = p.ph_hi;
  unsigned gen = 0u;
  if (hi > lo) grid.sync();
#ifndef ONLY
#define ONLY -1
#endif
#ifndef REP
#define REP -1
#endif
#define PH_ON(n) ((ONLY < 0 || ONLY == (n)) && lo <= (n) && (n) <= hi)
#define RP(n) for (int rep_ = 0; rep_ < ((REP == (n)) ? 2 : 1); ++rep_)
#define SYNC_AFTER(n) if (lo <= (n) && (n) < hi) gbar(p.bar, gen);
  if (PH_ON(0)) RP(0) phase0(p, lds);
  SYNC_AFTER(0)
  if (PH_ON(1)) phase1(p);
  SYNC_AFTER(1)
  if (PH_ON(2)) RP(2) rms_mod_phase(p.x, p.g_mix, p.mod, 0, 1, p.H);
  SYNC_AFTER(2)
  if (PH_ON(3)) RP(3) { Epi1 e{p.Y, p.YT}; gemm_phase(p.H, p.WinT, T, LDY, D, lds, e); conv_drain(p, lds); }
  SYNC_AFTER(3)
  if (PH_ON(4)) RP(4) phase4(p, lds);
  SYNC_AFTER(4)
  if (PH_ON(5)) RP(5) phase5(p, lds);
  SYNC_AFTER(5)
  if (PH_ON(6)) RP(6) { Epi2 e{p.x, p.mod, p.X1}; gemm_phase(p.Omix, p.WoutT, T, D, D, lds, e); }
  SYNC_AFTER(6)
  if (PH_ON(7)) RP(7) rms_mod_phase(p.X1, p.g_ffn, p.mod, 3, 4, p.H2);
  SYNC_AFTER(7)
  if (PH_ON(8)) RP(8) { Epi3 e{p.Qp}; gemm_phase(p.H2, p.WqT, T, D, D, lds, e); }
  SYNC_AFTER(8)
  if (PH_ON(9)) RP(9) phase9(p, lds);
}

extern "C" void kernel_launch(void* const* d_in, const int* in_sizes, int n_in, void* d_out, int out_size, void* d_ws, size_t ws_size,
                              hipStream_t stream) {
  static int grid_blocks = 0;
  if (!grid_blocks) {
    int dev = 0, cus = 0, per_cu = 0;
    (void)hipGetDevice(&dev);
    (void)hipDeviceGetAttribute(&cus, hipDeviceAttributeMultiprocessorCount, dev);
    (void)hipOccupancyMaxActiveBlocksPerMultiprocessor(&per_cu, mega, 256, 0);
    if (per_cu < 1) per_cu = 1;
    if (per_cu > 2) per_cu = 2;
    grid_blocks = cus * per_cu;
  }
  Params p;
  memset(&p, 0, sizeof(p));
  const float* const* in = (const float* const*)d_in;
  p.x = in[0]; p.c = in[1]; p.w_ada = in[2]; p.b_ada = in[3]; p.g_mix = in[4]; p.g_ffn = in[5]; p.g_final = in[6]; p.w_in = in[7];
  p.pe_k = in[8]; p.pe_v = in[9]; p.ck_w1 = in[10]; p.ck_w2 = in[11]; p.cv_w1 = in[12]; p.cv_w2 = in[13]; p.g_nsa = in[14];
  p.g_ret = in[15]; p.w_out = in[16]; p.w_q = in[17]; p.sub_keys = in[18]; p.peer_u = in[19]; p.peer_v = in[20];
  p.out = (float*)d_out;
  char* ws = (char*)d_ws;
  size_t off = 0;
  auto take = [&](size_t bytes) { char* r = ws + off; off += (bytes + 255) & ~(size_t)255; return r; };
  p.bar = (unsigned*)take(32768);
  p.mod_part = (float*)take((size_t)16 * 4 * 12288 * 4);
  p.mod = (float*)take((size_t)4 * 12288 * 4);
  p.cbias = (float*)take((size_t)2 * 32 * 128 * 4);
  p.WinT = (bf16_t*)take((size_t)LDY * 2048 * 2);
  p.WoutT = (bf16_t*)take((size_t)2048 * 2048 * 2);
  p.WqT = (bf16_t*)take((size_t)2048 * 2048 * 2);
  p.SK = (bf16_t*)take((size_t)8 * 2 * 128 * 128 * 2);
  p.U8 = (unsigned char*)take((size_t)16384 * 2048);
  p.V8 = (unsigned char*)take((size_t)16384 * 2048);
  p.w1T = (bf16_t*)take((size_t)2 * 128 * 2048 * 2);
  p.w2T = (bf16_t*)take((size_t)2 * 64 * 128 * 2);
  p.Kc = (bf16_t*)take((size_t)16 * 512 * 64 * 2);
  p.VcT = (bf16_t*)take((size_t)16 * 64 * 512 * 2);
  p.RT = (bf16_t*)take((size_t)32 * 64 * 16384 * 2);
  p.H = (bf16_t*)take((size_t)T * D * 2);
  p.Omix = p.H;
  p.Y = (bf16_t*)take((size_t)T * LDY * 2);
  p.X1 = (float*)p.Y;
  p.H2 = (bf16_t*)((char*)p.Y + (size_t)T * D * 4);
  p.YT = (bf16_t*)take((size_t)NYT * LDT * 2);
  p.Qp = p.YT;
  if (off > ws_size) fprintf(stderr, "workspace too small: need %zu have %zu\n", off, ws_size);
  p.ph_lo = 0; p.ph_hi = 9;
  (void)hipMemsetAsync(p.bar, 0, 32768, stream);
  void* args[] = {&p};
  hipError_t e = hipLaunchCooperativeKernel((void*)mega, dim3(grid_blocks), dim3(256), args, 0, stream);
  if (e != hipSuccess) fprintf(stderr, "cooperative launch failed: %s (grid %d)\n", hipGetErrorString(e), grid_blocks);
}
```

```cpp
#include <hip/hip_runtime.h>
#include <hip/hip_cooperative_groups.h>
#include <stdint.h>
#include <cstdio>
#include <cstring>
namespace cg = cooperative_groups;

#define DEV __device__ __forceinline__
typedef unsigned short bf16_t;
typedef short bf16x8 __attribute__((ext_vector_type(8)));
typedef float f32x4 __attribute__((ext_vector_type(4)));
typedef unsigned u32x4 __attribute__((ext_vector_type(4)));
typedef unsigned u32x2 __attribute__((ext_vector_type(2)));

constexpr int D = 2048, NB = 4, S = 8192, T = NB * S;
constexpr int LDY = 6784;
constexpr int LDT = T + 192;
constexpr int C_QA = 0, C_KC = 1024, C_VC = 1280, C_KS = 1536, C_VS = 1792, C_KW = 2048, C_VW = 2304,
              C_QR = 2560, C_KR = 3584, C_VR = 4608, C_GR = 5632, C_GA = 6656;
constexpr int R_VS = 0, R_VW = 256, R_KR = 512, R_VR = 1536, NYT = 2560;
constexpr int LDS_BYTES = 73728;
constexpr float LOG2E = 1.4426950408889634f;

struct Params {
  const float *x, *c, *w_ada, *b_ada, *g_mix, *g_ffn, *g_final, *w_in, *pe_k, *pe_v, *ck_w1, *ck_w2, *cv_w1, *cv_w2,
      *g_nsa, *g_ret, *w_out, *w_q, *sub_keys, *peer_u, *peer_v;
  float* out;
  float *mod_part, *mod, *cbias, *X1;
  unsigned* bar;
  unsigned char *U8, *V8;
  bf16_t *WinT, *WoutT, *WqT, *SK, *w1T, *w2T, *H, *Y, *YT, *Kc, *VcT, *RT, *H2, *Qp, *Omix;
  int ph_lo, ph_hi;
};

typedef __bf16 bf16v2_t __attribute__((ext_vector_type(2)));
typedef float f32x2_t __attribute__((ext_vector_type(2)));
DEV unsigned pk_bf16(float lo, float hi) {
  const bf16v2_t r = __builtin_convertvector((f32x2_t){lo, hi}, bf16v2_t);
  return __builtin_bit_cast(unsigned, r);
}
DEV float bf_lo(unsigned w) { return __uint_as_float(w << 16); }
DEV float bf_hi(unsigned w) { return __uint_as_float(w & 0xffff0000u); }
DEV float bf2f(bf16_t h) { return __uint_as_float(((unsigned)h) << 16); }
DEV float ex2(float x) { return __builtin_amdgcn_exp2f(x); }
DEV float sigmoidf_(float x) { return 1.0f / (1.0f + __expf(-x)); }
DEV float gelu_tanh(float x) {
  float u = 0.7978845608028654f * (x + 0.044715f * x * x * x);
  float t = 1.0f - 2.0f / (__expf(2.0f * u) + 1.0f);
  return 0.5f * x * (1.0f + t);
}
DEV f32x4 mfma16(bf16x8 a, bf16x8 b, f32x4 c) { return __builtin_amdgcn_mfma_f32_16x16x32_bf16(a, b, c, 0, 0, 0); }
DEV bf16x8 ld8(const bf16_t* p) { return *(const bf16x8*)p; }
DEV bf16x8 as_bf8(u32x4 v) { return __builtin_bit_cast(bf16x8, v); }
DEV float wave_sum(float v) {
#pragma unroll
  for (int o = 32; o >= 1; o >>= 1) v += __shfl_xor(v, o);
  return v;
}


DEV int opaque_tid() { int t = threadIdx.x; asm volatile("" : "+v"(t)); return t; }

DEV void transpose_tile(const float* __restrict__ src, int ld_src, int mode, bf16_t* __restrict__ dst, int Kdim, int n0, int k0,
                        float* tile) {
  const int tid = threadIdx.x, tx = tid & 63, ty = tid >> 6;
  const int n = n0 + tx;
  int sc = n;
  bool ok = true;
  if (mode == 1) {
    if (n < 2560) sc = n;
    else if (n < 6656) sc = n + 48;
    else if (n < 6704) sc = n - 6656 + 2560;
    else { sc = 0; ok = false; }
  }
#pragma unroll
  for (int i = 0; i < 16; ++i) {
    const int kk = ty + 4 * i;
    tile[kk * 65 + tx] = ok ? src[(size_t)(k0 + kk) * ld_src + sc] : 0.f;
  }
  __syncthreads();
  const int nn = tid >> 2, kc = (tid & 3) * 16;
  unsigned w[8];
#pragma unroll
  for (int j = 0; j < 8; ++j) w[j] = pk_bf16(tile[(kc + 2 * j) * 65 + nn], tile[(kc + 2 * j + 1) * 65 + nn]);
  u32x4* d = (u32x4*)(dst + (size_t)(n0 + nn) * Kdim + k0 + kc);
  d[0] = (u32x4){w[0], w[1], w[2], w[3]};
  d[1] = (u32x4){w[4], w[5], w[6], w[7]};
  __syncthreads();
}

DEV void convert_unit(const float* __restrict__ src, bf16_t* __restrict__ dst, int unit) {
  const int tid = threadIdx.x;
#pragma unroll
  for (int i = 0; i < 4; ++i) {
    const size_t e = (size_t)unit * 8192 + i * 2048 + tid * 8;
    const f32x4 a = *(const f32x4*)(src + e), b = *(const f32x4*)(src + e + 4);
    *(u32x4*)(dst + e) = (u32x4){pk_bf16(a[0], a[1]), pk_bf16(a[2], a[3]), pk_bf16(b[0], b[1]), pk_bf16(b[2], b[3])};
  }
}

typedef float f32x2v __attribute__((ext_vector_type(2)));
DEV unsigned pk4_fp8(float a, float b, float c, float d) {
  int w = __builtin_amdgcn_cvt_pk_fp8_f32(a, b, 0, false);
  w = __builtin_amdgcn_cvt_pk_fp8_f32(c, d, w, true);
  return (unsigned)w;
}
DEV void convert_unit_fp8(const float* __restrict__ src, unsigned char* __restrict__ dst, int unit, float scale) {
  const int tid = threadIdx.x;
#pragma unroll
  for (int i = 0; i < 2; ++i) {
    const size_t e = (size_t)unit * 8192 + i * 4096 + tid * 16;
    f32x4 a[4];
#pragma unroll
    for (int j = 0; j < 4; ++j) a[j] = *(const f32x4*)(src + e + 4 * j) * scale;
    *(u32x4*)(dst + e) = (u32x4){pk4_fp8(a[0][0], a[0][1], a[0][2], a[0][3]), pk4_fp8(a[1][0], a[1][1], a[1][2], a[1][3]),
                                 pk4_fp8(a[2][0], a[2][1], a[2][2], a[2][3]), pk4_fp8(a[3][0], a[3][1], a[3][2], a[3][3])};
  }
}
constexpr float U8_SCALE = 64.0f, V8_SCALE = 4.0f;

DEV void phase0(const Params& p, char* lds) {
  float* fl = (float*)lds;
  const int tid = threadIdx.x;
  constexpr int U_MOD = 768, U_WIN = 106 * 32, U_W1 = 128, U_W2 = 4, U_CB = 32;
  constexpr int TOT = U_MOD + U_WIN + U_W1 + U_W2 + U_CB;
  for (int u0 = blockIdx.x; u0 < TOT; u0 += gridDim.x) {
    int u = u0;
    if (u < U_MOD) {
      const int colblk = u % 48, ks = u / 48;
      for (int i = tid; i < 512; i += 256) {
        const int b = i >> 7, k = i & 127;
        const float cv = p.c[b * D + ks * 128 + k];
        fl[i] = cv * sigmoidf_(cv);
      }
      __syncthreads();
      const int col = colblk * 256 + tid;
      float a0 = 0, a1 = 0, a2 = 0, a3 = 0;
      const float* wp = p.w_ada + (size_t)(ks * 128) * 12288 + col;
#pragma unroll 8
      for (int k = 0; k < 128; ++k) {
        const float w = wp[(size_t)k * 12288];
        a0 += fl[k] * w; a1 += fl[128 + k] * w; a2 += fl[256 + k] * w; a3 += fl[384 + k] * w;
      }
      float* mp = p.mod_part + (size_t)ks * 4 * 12288 + col;
      mp[0] = a0; mp[12288] = a1; mp[2 * 12288] = a2; mp[3 * 12288] = a3;
      __syncthreads();
      continue;
    }
    u -= U_MOD;
    if (u < U_WIN) { transpose_tile(p.w_in, 6704, 1, p.WinT, 2048, (u >> 5) * 64, (u & 31) * 64, fl); continue; }
    u -= U_WIN;
    if (u < U_W1) {
      const int kv = u >> 6, r = u & 63;
      transpose_tile(kv ? p.cv_w1 : p.ck_w1, 128, 0, p.w1T + (size_t)kv * 128 * 2048, 2048, (r >> 5) * 64, (r & 31) * 64, fl);
      continue;
    }
    u -= U_W1;
    if (u < U_W2) {
      const int kv = u >> 1, r = u & 1;
      transpose_tile(kv ? p.cv_w2 : p.ck_w2, 64, 0, p.w2T + (size_t)kv * 64 * 128, 128, 0, r * 64, fl);
      continue;
    }
    u -= U_W2;
    if (u < U_CB) {
      const int kv = u >> 4, ks = u & 15, j = tid & 127, half = tid >> 7;
      const float* pe = kv ? p.pe_v : p.pe_k;
      const float* w1 = kv ? p.cv_w1 : p.ck_w1;
      const int i0 = ks * 128 + half * 64;
      float a = 0.f;
#pragma unroll 8
      for (int i = 0; i < 64; ++i) a += pe[i0 + i] * w1[(size_t)(i0 + i) * 128 + j];
      p.cbias[(kv * 32 + ks * 2 + half) * 128 + j] = a;
      continue;
    }
  }
}

DEV void phase1(const Params& p) {
  const int tid = threadIdx.x;
  for (int u = blockIdx.x; u < 192; u += gridDim.x) {
    const int idx = u * 256 + tid;
    const int col = idx % 12288;
    float a = p.b_ada[col];
#pragma unroll
    for (int ks = 0; ks < 16; ++ks) a += p.mod_part[(size_t)ks * 4 * 12288 + idx];
    p.mod[idx] = a;
  }
}

DEV void rms_mod_phase(const float* __restrict__ xin, const float* __restrict__ g, const float* __restrict__ mod, int shift_idx,
                       int scale_idx, bf16_t* __restrict__ dst) {
  const int lane = threadIdx.x & 63, wid = threadIdx.x >> 6;
  for (int u = blockIdx.x; u < T / 4; u += gridDim.x) {
    const int tok = u * 4 + wid, b = tok / S;
    const float* xr = xin + (size_t)tok * D;
    f32x4 v[8];
    float ss = 0.f;
#pragma unroll
    for (int i = 0; i < 8; ++i) {
      v[i] = *(const f32x4*)(xr + i * 256 + lane * 4);
      ss += v[i][0] * v[i][0] + v[i][1] * v[i][1] + v[i][2] * v[i][2] + v[i][3] * v[i][3];
    }
    ss = wave_sum(ss);
    const float rstd = rsqrtf(ss * (1.0f / D) + 1e-6f);
    const float* sh = mod + (size_t)b * 12288 + shift_idx * D;
    const float* sc = mod + (size_t)b * 12288 + scale_idx * D;
#pragma unroll
    for (int i = 0; i < 8; ++i) {
      const int col = i * 256 + lane * 4;
      const f32x4 gg = *(const f32x4*)(g + col), s1 = *(const f32x4*)(sc + col), s0 = *(const f32x4*)(sh + col);
      float y[4];
#pragma unroll
      for (int j = 0; j < 4; ++j) y[j] = v[i][j] * rstd * gg[j] * (1.0f + s1[j]) + s0[j];
      *(u32x2*)(dst + (size_t)tok * D + col) = (u32x2){pk_bf16(y[0], y[1]), pk_bf16(y[2], y[3])};
    }
  }
}

constexpr int GL = 72;
template <class Epi>
DEV void gemm_phase(const bf16_t* __restrict__ A, const bf16_t* __restrict__ Bt, int M, int N, int K, char* lds, const Epi& epi,
                    int panel_blocks = 0, unsigned* panel_cnt = nullptr) {
  bf16_t* sbuf = (bf16_t*)lds;
  const int ntn = N / 128, ntm = M / 128, nk = K / 64;
  const int xcd = blockIdx.x & 7, jb = blockIdx.x >> 3, bpx = (gridDim.x + 7 - xcd) >> 3;
  const int nsgn = (ntn + 7) >> 3, nsuper = (ntm >> 3) * nsgn;
  const int niter = panel_blocks > 0 ? ((int)blockIdx.x < panel_blocks ? (ntm * ntn - (int)blockIdx.x + panel_blocks - 1) / panel_blocks : 0)
                                     : ((nsuper - xcd + 7) >> 3) * (jb < 64 ? (64 - jb + bpx - 1) / bpx : 0);
  const int npb = jb < 64 ? (64 - jb + bpx - 1) / bpx : 0;
  for (int it = 0; it < niter; ++it) {
    int tm, tn;
    if (panel_blocks > 0) { const int i = (int)blockIdx.x + it * panel_blocks; tm = i / ntn; tn = i - tm * ntn; }
    else {
      const int sidx = xcd + 8 * (it / npb), jj = jb + bpx * (it % npb);
      tm = (sidx / nsgn) * 8 + (jj >> 3); tn = (sidx % nsgn) * 8 + (jj & 7);
      if (tn >= ntn) continue;
    }
    const int tid = opaque_tid(), lane = tid & 63, wid = tid >> 6, wm = wid >> 1, wn = wid & 1, lr = lane & 15, quad = lane >> 4;
    const int srow = tid >> 3, skc = (tid & 7) * 8;
    const bf16_t* Ag = A + (size_t)(tm * 128 + srow) * K + skc;
    const bf16_t* Bg = Bt + (size_t)(tn * 128 + srow) * K + skc;
    f32x4 acc[4][4];
#pragma unroll
    for (int i = 0; i < 4; ++i)
#pragma unroll
      for (int j = 0; j < 4; ++j) acc[i][j] = (f32x4){0.f, 0.f, 0.f, 0.f};
    u32x4 xa[4], xb[4], ya[4], yb[4];
#define G_LOAD(ra, rb, kt) do { _Pragma("unroll") for (int i = 0; i < 4; ++i) { \
      ra[i] = *(const u32x4*)(Ag + (size_t)(32 * i) * K + (kt) * 64); rb[i] = *(const u32x4*)(Bg + (size_t)(32 * i) * K + (kt) * 64); } } while (0)
#define G_STORE(ra, rb, buf) do { bf16_t* nA_ = sbuf + (buf) * (256 * GL); _Pragma("unroll") for (int i = 0; i < 4; ++i) { \
      *(u32x4*)(nA_ + (srow + 32 * i) * GL + skc) = ra[i]; *(u32x4*)(nA_ + 128 * GL + (srow + 32 * i) * GL + skc) = rb[i]; } } while (0)
#define G_COMPUTE(buf) do { const bf16_t* cA = sbuf + (buf) * (256 * GL); const bf16_t* cB = cA + 128 * GL; \
      _Pragma("unroll") for (int ks = 0; ks < 2; ++ks) { bf16x8 af[4], bfr[4]; \
        _Pragma("unroll") for (int i = 0; i < 4; ++i) { af[i] = ld8(cA + (wm * 64 + i * 16 + lr) * GL + ks * 32 + quad * 8); \
                                                      bfr[i] = ld8(cB + (wn * 64 + i * 16 + lr) * GL + ks * 32 + quad * 8); } \
        _Pragma("unroll") for (int i = 0; i < 4; ++i) _Pragma("unroll") for (int j = 0; j < 4; ++j) acc[i][j] = mfma16(af[i], bfr[j], acc[i][j]); \
        __builtin_amdgcn_sched_barrier(0); } } while (0)
    G_LOAD(xa, xb, 0);
    G_STORE(xa, xb, 0);
    G_LOAD(xa, xb, 1);
    G_LOAD(ya, yb, 2);
    __syncthreads();
    for (int kt = 0; kt < nk; kt += 2) {
      G_COMPUTE(0);
      G_STORE(xa, xb, 1);
      if (kt + 3 < nk) G_LOAD(xa, xb, kt + 3);
      __syncthreads();
      G_COMPUTE(1);
      if (kt + 2 < nk) G_STORE(ya, yb, 0);
      if (kt + 4 < nk) G_LOAD(ya, yb, kt + 4);
      __syncthreads();
    }
#undef G_LOAD
#undef G_STORE
#undef G_COMPUTE
    float* sC = (float*)lds;
    if (epi.rowmajor(tn)) {
#pragma unroll
      for (int i = 0; i < 4; ++i)
#pragma unroll
        for (int j = 0; j < 4; ++j)
#pragma unroll
          for (int r = 0; r < 4; ++r) sC[(wm * 64 + i * 16 + quad * 4 + r) * 132 + wn * 64 + j * 16 + lr] = acc[i][j][r];
      __syncthreads();
      epi(tm, tn, sC);
      __syncthreads();
    }
    if (epi.transposed(tn)) {
#pragma unroll
      for (int i = 0; i < 4; ++i)
#pragma unroll
        for (int j = 0; j < 4; ++j) *(f32x4*)(sC + (wn * 64 + j * 16 + lr) * 132 + wm * 64 + i * 16 + quad * 4) = acc[i][j];
      __syncthreads();
      epi.store_t(tm, tn, sC);
      __syncthreads();
    }
    if (panel_blocks > 0) {
      asm volatile("s_waitcnt vmcnt(0)" ::: "memory");
      __syncthreads();
      if (threadIdx.x == 0) {
        __builtin_amdgcn_fence(__ATOMIC_RELEASE, "agent");
        asm volatile("s_waitcnt vmcnt(0)" ::: "memory");
        __hip_atomic_fetch_add(panel_cnt + 16 * tm, 1u, __ATOMIC_RELAXED, __HIP_MEMORY_SCOPE_AGENT);
      }
    }
  }
}

struct Epi1 {
  bf16_t* Y; bf16_t* YT;
  DEV bool rowmajor(int tn) const { return !((tn == 14 || tn == 15) || (tn == 18 || tn == 19) || (tn >= 36 && tn < 44)); }
  DEV bool transposed(int tn) const { return (tn == 14 || tn == 15) || (tn == 18 || tn == 19) || (tn >= 28 && tn < 44); }
  DEV void operator()(int tm, int tn, const float* sC) const {
    const int tid = threadIdx.x;
#pragma unroll
    for (int i = 0; i < 8; ++i) {
      const int idx = tid + 256 * i, row = idx >> 4, c8 = idx & 15;
      const f32x4 a = *(const f32x4*)(sC + row * 132 + c8 * 8), b = *(const f32x4*)(sC + row * 132 + c8 * 8 + 4);
      *(u32x4*)(Y + (size_t)(tm * 128 + row) * LDY + tn * 128 + c8 * 8) =
          (u32x4){pk_bf16(a[0], a[1]), pk_bf16(a[2], a[3]), pk_bf16(b[0], b[1]), pk_bf16(b[2], b[3])};
    }
  }
  DEV void store_t(int tm, int tn, const float* sCT) const {
    const int tid = threadIdx.x;
    int r0;
    if (tn == 14 || tn == 15) r0 = R_VS + (tn - 14) * 128;
    else if (tn == 18 || tn == 19) r0 = R_VW + (tn - 18) * 128;
    else if (tn < 36) r0 = R_KR + (tn - 28) * 128;
    else r0 = R_VR + (tn - 36) * 128;
#pragma unroll
    for (int i = 0; i < 8; ++i) {
      const int idx = tid + 256 * i, col = idx >> 4, ch = idx & 15;
      const f32x4 a = *(const f32x4*)(sCT + col * 132 + ch * 8), b = *(const f32x4*)(sCT + col * 132 + ch * 8 + 4);
      *(u32x4*)(YT + (size_t)(r0 + col) * LDT + tm * 128 + ch * 8) =
          (u32x4){pk_bf16(a[0], a[1]), pk_bf16(a[2], a[3]), pk_bf16(b[0], b[1]), pk_bf16(b[2], b[3])};
    }
  }
};
struct Epi2 {
  const float* x; const float* mod; float* X1;
  DEV bool rowmajor(int) const { return true; }
  DEV bool transposed(int) const { return false; }
  DEV void store_t(int, int, const float*) const {}
  DEV void operator()(int tm, int tn, const float* sC) const {
    const int tid = threadIdx.x, b = (tm * 128) / S;
#pragma unroll
    for (int i = 0; i < 16; ++i) {
      const int idx = tid + 256 * i, row = idx >> 5, c4 = idx & 31;
      const f32x4 v = *(const f32x4*)(sC + row * 132 + c4 * 4);
      const size_t t = (size_t)tm * 128 + row;
      const int col = tn * 128 + c4 * 4;
      const f32x4 xi = *(const f32x4*)(x + t * D + col), gt = *(const f32x4*)(mod + (size_t)b * 12288 + 2 * D + col);
      *(f32x4*)(X1 + t * D + col) = xi + gt * v;
    }
  }
};
struct Epi3 {
  bf16_t* Q;
  DEV bool rowmajor(int) const { return true; }
  DEV bool transposed(int) const { return false; }
  DEV void store_t(int, int, const float*) const {}
  DEV void operator()(int tm, int tn, const float* sC) const {
    const int tid = threadIdx.x;
#pragma unroll
    for (int i = 0; i < 8; ++i) {
      const int idx = tid + 256 * i, row = idx >> 4, c8 = idx & 15;
      const f32x4 a = *(const f32x4*)(sC + row * 132 + c8 * 8), b = *(const f32x4*)(sC + row * 132 + c8 * 8 + 4);
      *(u32x4*)(Q + (size_t)(tm * 128 + row) * D + tn * 128 + c8 * 8) =
          (u32x4){pk_bf16(a[0], a[1]), pk_bf16(a[2], a[3]), pk_bf16(b[0], b[1]), pk_bf16(b[2], b[3])};
    }
  }
};

DEV float ret_lg2(int h) { return log1pf(-ex2(-5.0f - (float)h)) * LOG2E; }

DEV void ret_state_unit(const Params& p, int u) {
  const int tid_ = opaque_tid(), lane = tid_ & 63, w = tid_ >> 6, lr = lane & 15, quad = lane >> 4;
  const int es = u & 7, h = (u >> 3) & 7, b = u >> 6;
  const float lg2 = ret_lg2(h);
  const float cd = ex2(lg2 * 128.0f);
  const float kscale = 0.08838834764831845f;
  f32x4 st[2];
  st[0] = (f32x4){0.f, 0.f, 0.f, 0.f}; st[1] = st[0];
  const bf16_t* vrow = p.YT + (size_t)(R_VR + h * 128 + es * 16 + lr) * LDT + (size_t)b * S + quad * 8;
  const bf16_t* krow0 = p.YT + (size_t)(R_KR + h * 128 + w * 32 + lr) * LDT + (size_t)b * S + quad * 8;
  const bf16_t* krow1 = krow0 + (size_t)16 * LDT;
  bf16_t* rt = p.RT + ((size_t)((b * 8 + h) * 64)) * 16384 + (size_t)(es * 16 + quad * 4) * 128 + w * 32 + lr;
  for (int n = 0; n < 64; ++n) {
#pragma unroll
    for (int nt = 0; nt < 2; ++nt)
#pragma unroll
      for (int r = 0; r < 4; ++r) {
        const float v = st[nt][r];
        rt[(size_t)n * 16384 + r * 128 + nt * 16] = (bf16_t)(pk_bf16(v, v) & 0xffffu);
      }
    if (n == 63) break;
    f32x4 kv[2];
    kv[0] = (f32x4){0.f, 0.f, 0.f, 0.f}; kv[1] = kv[0];
#pragma unroll
    for (int ks = 0; ks < 4; ++ks) {
      const u32x4 vv = *(const u32x4*)(vrow + n * 128 + ks * 32);
      const bf16x8 k0 = ld8(krow0 + n * 128 + ks * 32), k1 = ld8(krow1 + n * 128 + ks * 32);
      u32x4 vs;
#pragma unroll
      for (int q2 = 0; q2 < 4; ++q2) {
        const int j = ks * 32 + quad * 8 + q2 * 2;
        const float d0 = kscale * ex2(lg2 * (float)(127 - j)), d1 = kscale * ex2(lg2 * (float)(126 - j));
        vs[q2] = pk_bf16(bf_lo(vv[q2]) * d0, bf_hi(vv[q2]) * d1);
      }
      const bf16x8 va = as_bf8(vs);
      kv[0] = mfma16(va, k0, kv[0]);
      kv[1] = mfma16(va, k1, kv[1]);
    }
    st[0] = st[0] * cd + kv[0];
    st[1] = st[1] * cd + kv[1];
  }
}

DEV void compress_unit(const Params& p, int cu, char* lds) {
  const int tid_ = opaque_tid(), lane = tid_ & 63, w = tid_ >> 6, lr = lane & 15, quad = lane >> 4;
  const int kv = cu >> 7, rem = cu & 127, b = rem >> 5, g = (rem >> 3) & 3, nb = rem & 7;
  const int srccol = (kv ? C_VC : C_KC) + g * 64;
  const bf16_t* w1T = p.w1T + (size_t)kv * 128 * 2048;
  const bf16_t* w2T = p.w2T + (size_t)kv * 64 * 128;
  const float* cb = p.cbias + kv * 32 * 128;
  bf16_t* h1 = (bf16_t*)lds;
  f32x4 acc[4][2];
#pragma unroll
  for (int m = 0; m < 4; ++m) { acc[m][0] = (f32x4){0.f, 0.f, 0.f, 0.f}; acc[m][1] = acc[m][0]; }
  const bf16_t* b0 = w1T + (size_t)(w * 32 + lr) * 2048 + quad * 8;
  const bf16_t* b1 = b0 + (size_t)16 * 2048;
  const bf16_t* ybase = p.Y + (size_t)b * S * LDY + srccol;
#pragma unroll 2
  for (int ks = 0; ks < 64; ++ks) {
    const int l = ks >> 1, dof = (ks & 1) * 32 + quad * 8;
    const bf16x8 bf0 = ld8(b0 + ks * 32), bf1 = ld8(b1 + ks * 32);
#pragma unroll
    for (int m = 0; m < 4; ++m) {
      int tok = 16 * (nb * 64 + m * 16 + lr) + l;
      tok = tok < S ? tok : S - 1;
      const bf16x8 af = ld8(ybase + (size_t)tok * LDY + dof);
      acc[m][0] = mfma16(af, bf0, acc[m][0]);
      acc[m][1] = mfma16(af, bf1, acc[m][1]);
    }
  }
#pragma unroll
  for (int nt = 0; nt < 2; ++nt) {
    const int hc = w * 32 + nt * 16 + lr;
    float bias = 0.f;
#pragma unroll
    for (int pp = 0; pp < 32; ++pp) bias += cb[pp * 128 + hc];
#pragma unroll
    for (int m = 0; m < 4; ++m)
#pragma unroll
      for (int r = 0; r < 4; ++r) {
        const float v = gelu_tanh(acc[m][nt][r] + bias);
        h1[(m * 16 + quad * 4 + r) * 136 + hc] = (bf16_t)(pk_bf16(v, v) & 0xffffu);
      }
  }
  __syncthreads();
  const int d = w * 16 + lr;
  bf16x8 bb[4];
#pragma unroll
  for (int ks = 0; ks < 4; ++ks) bb[ks] = ld8(w2T + (size_t)d * 128 + ks * 32 + quad * 8);
#pragma unroll
  for (int m = 0; m < 4; ++m) {
    f32x4 o = (f32x4){0.f, 0.f, 0.f, 0.f};
#pragma unroll
    for (int ks = 0; ks < 4; ++ks) o = mfma16(ld8(h1 + (m * 16 + lr) * 136 + ks * 32 + quad * 8), bb[ks], o);
    const int n0 = nb * 64 + m * 16 + quad * 4;
    if (kv == 0) {
#pragma unroll
      for (int r = 0; r < 4; ++r) p.Kc[((size_t)(b * 4 + g) * 512 + n0 + r) * 64 + d] = (bf16_t)(pk_bf16(o[r], o[r]) & 0xffffu);
    } else {
      *(u32x2*)(p.VcT + ((size_t)(b * 4 + g) * 64 + d) * 512 + n0) = (u32x2){pk_bf16(o[0], o[1]), pk_bf16(o[2], o[3])};
    }
  }
  __syncthreads();
}

constexpr int NCONV = 1024 + 1024 + 32 + 4096 + 4096;
DEV void conv_unit(const Params& p, int u, char* lds) {
  constexpr int U_WOUT = 1024, U_WQ = 1024, U_SK = 32, U_U = 4096;
  if (u < U_WOUT) { transpose_tile(p.w_out, 2048, 0, p.WoutT, 2048, (u >> 5) * 64, (u & 31) * 64, (float*)lds); return; }
  u -= U_WOUT;
  if (u < U_WQ) { transpose_tile(p.w_q, 2048, 0, p.WqT, 2048, (u >> 5) * 64, (u & 31) * 64, (float*)lds); return; }
  u -= U_WQ;
  if (u < U_SK) { convert_unit(p.sub_keys, p.SK, u); return; }
  u -= U_SK;
  if (u < U_U) { convert_unit_fp8(p.peer_u, p.U8, u, U8_SCALE); return; }
  u -= U_U;
  convert_unit_fp8(p.peer_v, p.V8, u, V8_SCALE);
}
DEV void conv_drain(const Params& p, char* lds) {
  unsigned* cnt = p.bar + 64 * 100;
  int* slot = (int*)(lds + LDS_BYTES - 16);
  for (;;) {
    __syncthreads();
    if (threadIdx.x == 0) *slot = (int)__hip_atomic_fetch_add(cnt, 1u, __ATOMIC_RELAXED, __HIP_MEMORY_SCOPE_AGENT);
    __syncthreads();
    const int u = *slot;
    if (u >= NCONV) break;
    conv_unit(p, u, lds);
  }
}

DEV void phase4(const Params& p, char* lds) {
  for (int u = blockIdx.x; u < 512; u += gridDim.x) {
    if (u < 256) ret_state_unit(p, u);
    else compress_unit(p, u - 256, lds);
  }
  conv_drain(p, lds);
}

DEV void ret_out_unit(const Params& p, int u) {
  const int tid_ = opaque_tid(), lane = tid_ & 63, w = tid_ >> 6, lr = lane & 15, quad = lane >> 4;
  const int n = u & 63, h = (u >> 6) & 7, b = u >> 9;
  const float lg2 = ret_lg2(h);
  const float kscale = 0.08838834764831845f;
  const size_t tk0 = (size_t)b * S + n * 128;
  f32x4 o[8][2];
#pragma unroll
  for (int i = 0; i < 8; ++i) { o[i][0] = (f32x4){0.f, 0.f, 0.f, 0.f}; o[i][1] = o[i][0]; }
  bf16x8 qf[2][4];
#pragma unroll
  for (int nt = 0; nt < 2; ++nt)
#pragma unroll
    for (int ks = 0; ks < 4; ++ks)
      qf[nt][ks] = ld8(p.Y + (tk0 + w * 32 + nt * 16 + lr) * LDY + C_QR + h * 128 + ks * 32 + quad * 8);
  const bf16_t* rt = p.RT + ((size_t)((b * 8 + h) * 64 + n)) * 16384 + (size_t)lr * 128 + quad * 8;
#pragma unroll 2
  for (int ks = 0; ks < 4; ++ks)
#pragma unroll
    for (int et = 0; et < 8; ++et) {
      const bf16x8 af = ld8(rt + et * 16 * 128 + ks * 32);
      o[et][0] = mfma16(af, qf[0][ks], o[et][0]);
      o[et][1] = mfma16(af, qf[1][ks], o[et][1]);
    }
  int ti[2];
#pragma unroll
  for (int nt = 0; nt < 2; ++nt) {
    ti[nt] = w * 32 + nt * 16 + lr;
    const float qd = ex2(lg2 * (float)(ti[nt] + 1));
#pragma unroll
    for (int et = 0; et < 8; ++et) o[et][nt] = o[et][nt] * qd;
  }
  for (int jt = 0; jt <= w; ++jt) {
    const int j0 = jt * 32;
    f32x4 s[2][2];
#pragma unroll
    for (int mt = 0; mt < 2; ++mt) { s[mt][0] = (f32x4){0.f, 0.f, 0.f, 0.f}; s[mt][1] = s[mt][0]; }
#pragma unroll
    for (int mt = 0; mt < 2; ++mt)
#pragma unroll
      for (int ks = 0; ks < 4; ++ks) {
        const bf16x8 kf = ld8(p.Y + (tk0 + j0 + mt * 16 + lr) * LDY + C_KR + h * 128 + ks * 32 + quad * 8);
        s[mt][0] = mfma16(kf, qf[0][ks], s[mt][0]);
        s[mt][1] = mfma16(kf, qf[1][ks], s[mt][1]);
      }
    bf16x8 pb[2];
#pragma unroll
    for (int nt = 0; nt < 2; ++nt) {
      float pv[2][4];
#pragma unroll
      for (int mt = 0; mt < 2; ++mt)
#pragma unroll
        for (int r = 0; r < 4; ++r) {
          const int j = j0 + mt * 16 + quad * 4 + r;
          const int dd = ti[nt] - j;
          pv[mt][r] = dd >= 0 ? s[mt][nt][r] * kscale * ex2(lg2 * (float)dd) : 0.f;
        }
      pb[nt] = as_bf8((u32x4){pk_bf16(pv[0][0], pv[0][1]), pk_bf16(pv[0][2], pv[0][3]), pk_bf16(pv[1][0], pv[1][1]), pk_bf16(pv[1][2], pv[1][3])});
    }
#pragma unroll
    for (int et = 0; et < 8; ++et) {
      const bf16_t* vp = p.YT + (size_t)(R_VR + h * 128 + et * 16 + lr) * LDT + tk0 + j0 + quad * 4;
      const u32x2 lo = *(const u32x2*)vp, hi = *(const u32x2*)(vp + 16);
      const bf16x8 vf = as_bf8((u32x4){lo[0], lo[1], hi[0], hi[1]});
      o[et][0] = mfma16(vf, pb[0], o[et][0]);
      o[et][1] = mfma16(vf, pb[1], o[et][1]);
    }
  }
#pragma unroll
  for (int nt = 0; nt < 2; ++nt) {
    float sm = 0.f;
#pragma unroll
    for (int et = 0; et < 8; ++et) sm += o[et][nt][0] + o[et][nt][1] + o[et][nt][2] + o[et][nt][3];
    sm += __shfl_xor(sm, 16); sm += __shfl_xor(sm, 32);
    const float mu = sm * (1.0f / 128.0f);
    float sq = 0.f;
#pragma unroll
    for (int et = 0; et < 8; ++et)
#pragma unroll
      for (int r = 0; r < 4; ++r) { const float dlt = o[et][nt][r] - mu; sq += dlt * dlt; }
    sq += __shfl_xor(sq, 16); sq += __shfl_xor(sq, 32);
    const float rstd = rsqrtf(sq * (1.0f / 128.0f) + 1e-6f);
    const size_t tok = tk0 + ti[nt];
#pragma unroll
    for (int et = 0; et < 8; ++et) {
      const int e = et * 16 + quad * 4;
      const u32x2 gr = *(const u32x2*)(p.Y + tok * LDY + C_GR + h * 128 + e);
      const f32x4 gw = *(const f32x4*)(p.g_ret + h * 128 + e);
      const float gv[4] = {bf_lo(gr[0]), bf_hi(gr[0]), bf_lo(gr[1]), bf_hi(gr[1])};
      float y[4];
#pragma unroll
      for (int r = 0; r < 4; ++r) y[r] = (o[et][nt][r] - mu) * rstd * gw[r] * (gv[r] * sigmoidf_(gv[r]));
      *(u32x2*)(p.Omix + tok * D + 1024 + h * 128 + e) = (u32x2){pk_bf16(y[0], y[1]), pk_bf16(y[2], y[3])};
    }
  }
}

constexpr int NQT = 2;
struct AttnSt { f32x4 o[4][NQT]; float m[NQT], l[NQT]; };

DEV void attn_reset(AttnSt& st) {
#pragma unroll
  for (int j = 0; j < NQT; ++j) {
    st.m[j] = -1e30f; st.l[j] = 0.f;
#pragma unroll
    for (int i = 0; i < 4; ++i) st.o[i][j] = (f32x4){0.f, 0.f, 0.f, 0.f};
  }
}

constexpr int TL = 72;
constexpr int TILE_BUF_BYTES = 2 * 64 * TL * 2;
constexpr int NSA_TILE_OFF = 36864;
struct KVFrag { bf16x8 k[4][2]; bf16x8 v[4][2]; };

struct TileSrc { const bf16_t* kbase; size_t krs; const bf16_t* vbase; size_t vrs; };
template <bool WITH_V>
DEV void stage_load(u32x4 (&r)[4], const TileSrc& ts, int pos, int tid) {
#pragma unroll
  for (int i = 0; i < 2; ++i) {
    const int c = tid + 256 * i, row = c >> 3, ch = c & 7;
    r[i] = *(const u32x4*)(ts.kbase + (size_t)(pos + row) * ts.krs + ch * 8);
    if (WITH_V) r[2 + i] = *(const u32x4*)(ts.vbase + (size_t)row * ts.vrs + pos + ch * 8);
  }
}
template <bool WITH_V>
DEV void stage_store(bf16_t* tb, const u32x4 (&r)[4], int tid) {
#pragma unroll
  for (int i = 0; i < 2; ++i) {
    const int c = tid + 256 * i, row = c >> 3, ch = c & 7;
    *(u32x4*)(tb + row * TL + ch * 8) = r[i];
    if (WITH_V) *(u32x4*)(tb + 64 * TL + row * TL + ch * 8) = r[2 + i];
  }
}
DEV void lds_k(KVFrag& f, const bf16_t* tb, int lr, int quad) {
#pragma unroll
  for (int mt = 0; mt < 4; ++mt)
#pragma unroll
    for (int ks = 0; ks < 2; ++ks) f.k[mt][ks] = ld8(tb + (mt * 16 + lr) * TL + ks * 32 + quad * 8);
}
DEV void lds_v(KVFrag& f, const bf16_t* tb, int lr, int quad) {
#pragma unroll
  for (int dt = 0; dt < 4; ++dt)
#pragma unroll
    for (int hf = 0; hf < 2; ++hf) {
      const bf16_t* vp = tb + 64 * TL + (dt * 16 + lr) * TL + hf * 32 + quad * 4;
      const u32x2 lo = *(const u32x2*)vp, hi = *(const u32x2*)(vp + 16);
      f.v[dt][hf] = as_bf8((u32x4){lo[0], lo[1], hi[0], hi[1]});
    }
}
template <bool WITH_V, class NextFn, class ProcFn>
DEV void tile_loop(char* lds, int tid, const TileSrc& ts, NextFn next, ProcFn proc) {
  int cur = next();
  if (cur < 0) return;
  int n1 = next(), n2 = n1 >= 0 ? next() : -1;
  u32x4 r0[4], r1[4];
  stage_load<WITH_V>(r0, ts, cur, tid);
  stage_store<WITH_V>((bf16_t*)(lds + NSA_TILE_OFF), r0, tid);
  stage_load<WITH_V>(r0, ts, n1 >= 0 ? n1 : cur, tid);
  stage_load<WITH_V>(r1, ts, n2 >= 0 ? n2 : cur, tid);
  __syncthreads();
  while (true) {
    proc(cur, (const bf16_t*)(lds + NSA_TILE_OFF));
    stage_store<WITH_V>((bf16_t*)(lds + NSA_TILE_OFF + TILE_BUF_BYTES), r0, tid);
    const int n3 = n2 >= 0 ? next() : -1;
    stage_load<WITH_V>(r0, ts, n3 >= 0 ? n3 : cur, tid);
    __syncthreads();
    if (n1 < 0) break;
    proc(n1, (const bf16_t*)(lds + NSA_TILE_OFF + TILE_BUF_BYTES));
    stage_store<WITH_V>((bf16_t*)(lds + NSA_TILE_OFF), r1, tid);
    const int n4 = n3 >= 0 ? next() : -1;
    stage_load<WITH_V>(r1, ts, n4 >= 0 ? n4 : cur, tid);
    __syncthreads();
    if (n2 < 0) break;
    cur = n2; n1 = n3; n2 = n4;
  }
}

DEV void qk_tile(f32x4 (&s)[4][NQT], const KVFrag& f, const bf16x8 (&qf)[NQT][2]) {
#pragma unroll
  for (int mt = 0; mt < 4; ++mt)
#pragma unroll
    for (int nt = 0; nt < NQT; ++nt) {
      s[mt][nt] = mfma16(f.k[mt][0], qf[nt][0], (f32x4){0.f, 0.f, 0.f, 0.f});
      s[mt][nt] = mfma16(f.k[mt][1], qf[nt][1], s[mt][nt]);
    }
}
DEV void pv_tile(AttnSt& st, const KVFrag& f, const bf16x8 (&pb)[NQT][2]) {
#pragma unroll
  for (int dt = 0; dt < 4; ++dt)
#pragma unroll
    for (int hf = 0; hf < 2; ++hf)
#pragma unroll
      for (int nt = 0; nt < NQT; ++nt) st.o[dt][nt] = mfma16(f.v[dt][hf], pb[nt][hf], st.o[dt][nt]);
}

DEV void attn_tile(AttnSt& st, const bf16x8 (&qf)[NQT][2], const bf16_t* tb, int rel0, int lr, const unsigned (&selbit)[NQT], int maxdist,
                   bool need_mask, float c1, float slope2, int quad) {
  KVFrag f;
  lds_k(f, tb, lr, quad);
  f32x4 s[4][NQT];
  qk_tile(s, f, qf);
  lds_v(f, tb, lr, quad);
  const float b0 = slope2 * (float)(rel0 + quad * 4);
  float smaxv[NQT];
#pragma unroll
  for (int nt = 0; nt < NQT; ++nt) smaxv[nt] = -1e30f;
  float rbv = b0;
  const float step13 = slope2 * 13.0f;
#pragma unroll
  for (int mt = 0; mt < 4; ++mt)
#pragma unroll
    for (int r = 0; r < 4; ++r) {
      if (r > 0) rbv += slope2; else if (mt > 0) rbv += step13;
#pragma unroll
      for (int nt = 0; nt < NQT; ++nt) {
        const float v = fmaf(s[mt][nt][r], c1, rbv);
        s[mt][nt][r] = v;
        smaxv[nt] = fmaxf(smaxv[nt], v);
      }
    }
  if (need_mask) {
#pragma unroll
    for (int nt = 0; nt < NQT; ++nt) {
      float mx = -1e30f;
      const int dq = lr + nt * 16 - rel0 - quad * 4;
#pragma unroll
      for (int mt = 0; mt < 4; ++mt)
#pragma unroll
        for (int r = 0; r < 4; ++r) {
          const int dist = dq - (mt * 16 + r);
          const bool valid = selbit[nt] && dist >= 0 && dist <= maxdist;
          const float v = valid ? s[mt][nt][r] : -1e30f;
          s[mt][nt][r] = v;
          mx = fmaxf(mx, v);
        }
      smaxv[nt] = mx;
    }
  } else {
#pragma unroll
    for (int nt = 0; nt < NQT; ++nt) smaxv[nt] = selbit[nt] ? smaxv[nt] : -1e30f;
  }
  bf16x8 pb[NQT][2];
#pragma unroll
  for (int nt = 0; nt < NQT; ++nt) {
    float smax = smaxv[nt];
    smax = fmaxf(smax, __shfl_xor(smax, 16));
    smax = fmaxf(smax, __shfl_xor(smax, 32));
    const float mnew = fmaxf(st.m[nt], smax);
    const float alpha = ex2(st.m[nt] - mnew);
    st.m[nt] = mnew;
    const float mref = selbit[nt] ? fmaxf(mnew, -1e20f) : 1e30f;
    float ls = 0.f;
    float pv[4][4];
#pragma unroll
    for (int mt = 0; mt < 4; ++mt)
#pragma unroll
      for (int r = 0; r < 4; ++r) { const float e = ex2(s[mt][nt][r] - mref); pv[mt][r] = e; ls += e; }
    st.l[nt] = st.l[nt] * alpha + ls;
#pragma unroll
    for (int hf = 0; hf < 2; ++hf)
      pb[nt][hf] = as_bf8((u32x4){pk_bf16(pv[2 * hf][0], pv[2 * hf][1]), pk_bf16(pv[2 * hf][2], pv[2 * hf][3]),
                                  pk_bf16(pv[2 * hf + 1][0], pv[2 * hf + 1][1]), pk_bf16(pv[2 * hf + 1][2], pv[2 * hf + 1][3])});
#pragma unroll
    for (int dt = 0; dt < 4; ++dt) st.o[dt][nt] = st.o[dt][nt] * alpha;
  }
  pv_tile(st, f, pb);
}

DEV void cmp_scores(f32x4 (&s)[4][NQT], int n0, int t0, int lr, int quad, float c1, float slope2, bool full) {
  float rbv = slope2 * (float)(16 * (n0 + quad * 4) + 31 - t0);
  const float step16 = slope2 * 16.0f, step208 = slope2 * 208.0f;
#pragma unroll
  for (int mt = 0; mt < 4; ++mt)
#pragma unroll
    for (int r = 0; r < 4; ++r) {
      if (r > 0) rbv += step16; else if (mt > 0) rbv += step208;
      const int rel = 16 * (n0 + mt * 16 + quad * 4 + r) + 31 - t0;
#pragma unroll
      for (int nt = 0; nt < NQT; ++nt) {
        float v = fmaf(s[mt][nt][r], c1, rbv);
        if (!full) v = (rel <= lr + nt * 16) ? v : -1e30f;
        s[mt][nt][r] = v;
      }
    }
}

DEV void nsa_unit(const Params& p, int u, char* lds) {
  const int tid = opaque_tid(), lane = tid & 63, w = tid >> 6, lr = lane & 15, quad = lane >> 4;
  const int q32 = u & 255, g = (u >> 8) & 3, b = u >> 10;
  const int h = g * 4 + w, t0 = q32 * 32, qb = t0 >> 6;
  const size_t tokbase = (size_t)b * S;
  float* imp = (float*)lds;
  float* stash = (float*)lds;
  unsigned* selmask = (unsigned*)(lds + 32768);
  unsigned* unionm = (unsigned*)(lds + 32768 + 512);
  const float slope = ex2(-0.5f * (float)(h + 1));
  const float slope2 = slope * LOG2E, c1 = 0.125f * LOG2E;
  const int tq0 = t0 + lr;
  const float skipd = 200.0f / slope2;
  const float skipd_g = 200.0f / (ex2(-0.5f * (float)(g * 4 + 4)) * LOG2E);

  for (int i = tid; i < 32 * 129; i += 256) imp[i] = 0.f;
  if (tid < 4) unionm[tid] = 0u;
  bf16x8 qf[NQT][2];
#pragma unroll
  for (int nt = 0; nt < NQT; ++nt)
#pragma unroll
    for (int ks = 0; ks < 2; ++ks) qf[nt][ks] = ld8(p.Y + (tokbase + tq0 + nt * 16) * LDY + C_QA + h * 64 + ks * 32 + quad * 8);
  __syncthreads();
  auto gate = [&](int nt, int br) -> float {
    const bf16_t* gp = p.Y + (tokbase + tq0 + nt * 16) * LDY + C_GA + h * 3 + br;
    asm volatile("" : "+v"(gp));
    return sigmoidf_(bf2f(*gp));
  };

  AttnSt st;
  int nmax = t0 / 16;
  if (nmax > 510) nmax = 510;
  TileSrc tsc;
  tsc.kbase = p.Kc + (size_t)(b * 4 + g) * 512 * 64; tsc.krs = 64;
  tsc.vbase = p.VcT + (size_t)(b * 4 + g) * 64 * 512; tsc.vrs = 512;
  float m1[NQT], l1[NQT];
#pragma unroll
  for (int nt = 0; nt < NQT; ++nt) { m1[nt] = -1e30f; l1[nt] = 0.f; }
  int nstart = 0;
  while (nstart + 64 <= nmax && (float)(t0 - (16 * (nstart + 63) + 31)) > skipd_g) nstart += 64;
  {
    int nn = nstart;
    tile_loop<false>(lds, tid, tsc, [&]() -> int { const int r = nn <= nmax ? nn : -1; nn += 64; return r; },
      [&](int n0, const bf16_t* tb) {
        if ((float)(t0 - (16 * (n0 + 63) + 31)) > skipd) return;
        KVFrag f;
        lds_k(f, tb, lr, quad);
        f32x4 s[4][NQT];
        qk_tile(s, f, qf);
        const bool full = 16 * (n0 + 63) + 31 <= t0;
        if (full) cmp_scores(s, n0, t0, lr, quad, c1, slope2, true); else cmp_scores(s, n0, t0, lr, quad, c1, slope2, false);
#pragma unroll
        for (int nt = 0; nt < NQT; ++nt) {
          float smax = -1e30f;
#pragma unroll
          for (int mt = 0; mt < 4; ++mt)
#pragma unroll
            for (int r = 0; r < 4; ++r) smax = fmaxf(smax, s[mt][nt][r]);
          smax = fmaxf(smax, __shfl_xor(smax, 16));
          smax = fmaxf(smax, __shfl_xor(smax, 32));
          const float mnew = fmaxf(m1[nt], smax);
          const float mref = fmaxf(mnew, -1e20f);
          float ls = 0.f;
#pragma unroll
          for (int mt = 0; mt < 4; ++mt)
#pragma unroll
            for (int r = 0; r < 4; ++r) ls += ex2(s[mt][nt][r] - mref);
          l1[nt] = l1[nt] * ex2(m1[nt] - mnew) + ls;
          m1[nt] = mnew;
        }
      });
  }
  float il1[NQT];
#pragma unroll
  for (int nt = 0; nt < NQT; ++nt) {
    float l = l1[nt];
    l += __shfl_xor(l, 16); l += __shfl_xor(l, 32);
    il1[nt] = l > 0.f ? 1.0f / l : 0.f;
  }
  attn_reset(st);
  {
    int nn = nstart;
    tile_loop<true>(lds, tid, tsc, [&]() -> int { const int r = nn <= nmax ? nn : -1; nn += 64; return r; },
      [&](int n0, const bf16_t* tb) {
        if ((float)(t0 - (16 * (n0 + 63) + 31)) > skipd) return;
        KVFrag f;
        lds_k(f, tb, lr, quad);
        f32x4 s[4][NQT];
        qk_tile(s, f, qf);
        lds_v(f, tb, lr, quad);
        {
          const bool full = 16 * (n0 + 63) + 31 <= t0;
          if (full) cmp_scores(s, n0, t0, lr, quad, c1, slope2, true); else cmp_scores(s, n0, t0, lr, quad, c1, slope2, false);
        }
        bf16x8 pb[NQT][2];
#pragma unroll
        for (int nt = 0; nt < NQT; ++nt) {
          const float mref = fmaxf(m1[nt], -1e20f);
          float pv[4][4];
#pragma unroll
          for (int mt = 0; mt < 4; ++mt) {
#pragma unroll
            for (int r = 0; r < 4; ++r) pv[mt][r] = ex2(s[mt][nt][r] - mref) * il1[nt];
            const int msel = (n0 + mt * 16 + quad * 4) >> 2;
            const float s4 = (pv[mt][0] + pv[mt][1]) + (pv[mt][2] + pv[mt][3]);
            float* ip = imp + (nt * 16 + lr) * 129 + msel;
            if (s4 != 0.f) {
              atomicAdd(ip, s4);
              if (msel + 1 < 128 && pv[mt][3] != 0.f) atomicAdd(ip + 1, pv[mt][3]);
            }
          }
#pragma unroll
          for (int hf = 0; hf < 2; ++hf)
            pb[nt][hf] = as_bf8((u32x4){pk_bf16(pv[2 * hf][0], pv[2 * hf][1]), pk_bf16(pv[2 * hf][2], pv[2 * hf][3]),
                                        pk_bf16(pv[2 * hf + 1][0], pv[2 * hf + 1][1]), pk_bf16(pv[2 * hf + 1][2], pv[2 * hf + 1][3])});
        }
        pv_tile(st, f, pb);
      });
  }
  {
    unsigned um0 = 0, um1 = 0, um2 = 0, um3 = 0;
    for (int qi = 0; qi < 8; ++qi) {
      const int q = w * 8 + qi;
      unsigned key[2];
#pragma unroll
      for (int j = 0; j < 2; ++j) {
        const int m = lane + 64 * j;
        const float v = imp[q * 129 + m];
        unsigned k = (__float_as_uint(v) & 0xffffff80u) + 0x80u + (unsigned)(127 - m);
        if (m == 0 || m == qb || m + 1 == qb) k = 0x7f000000u + (unsigned)(127 - m);
        if (m > qb) k = 0u;
        key[j] = k;
      }
      unsigned thr = 0u;
#pragma unroll 1
      for (int bit = 30; bit >= 0; --bit) {
        const unsigned cand = thr | (1u << bit);
        const int cnt = __popcll(__ballot(key[0] >= cand)) + __popcll(__ballot(key[1] >= cand));
        if (cnt >= 16) thr = cand;
      }
      const bool sel0 = key[0] >= thr && key[0] != 0u, sel1 = key[1] >= thr && key[1] != 0u;
      const unsigned long long b0 = __ballot(sel0), b1 = __ballot(sel1);
      const unsigned w0 = (unsigned)b0, w1 = (unsigned)(b0 >> 32), w2 = (unsigned)b1, w3 = (unsigned)(b1 >> 32);
      if (lane == 0) { selmask[q * 4 + 0] = w0; selmask[q * 4 + 1] = w1; selmask[q * 4 + 2] = w2; selmask[q * 4 + 3] = w3; }
      um0 |= w0; um1 |= w1; um2 |= w2; um3 |= w3;
    }
    if (lane == 0) { atomicOr(&unionm[0], um0); atomicOr(&unionm[1], um1); atomicOr(&unionm[2], um2); atomicOr(&unionm[3], um3); }
  }
  __syncthreads();
#pragma unroll
  for (int nt = 0; nt < NQT; ++nt) {
    const float g0 = gate(nt, 0);
#pragma unroll
    for (int dt = 0; dt < 4; ++dt)
#pragma unroll
      for (int r = 0; r < 4; ++r) stash[((dt * NQT + nt) * 4 + r) * 256 + tid] = g0 * st.o[dt][nt][r];
  }

  attn_reset(st);
  {
    TileSrc ts;
    ts.kbase = p.Y + tokbase * LDY + C_KS + g * 64; ts.krs = LDY;
    ts.vbase = p.YT + (size_t)(R_VS + g * 64) * LDT + tokbase; ts.vrs = LDT;
    const unsigned u0 = unionm[0], u1 = unionm[1], u2 = unionm[2], u3 = unionm[3];
    int wd = 0;
    unsigned um = u0;
    tile_loop<true>(lds, tid, ts,
      [&]() -> int {
        for (;;) {
          while (um == 0u && wd < 3) { ++wd; um = wd == 1 ? u1 : (wd == 2 ? u2 : u3); }
          if (um == 0u) return -1;
          const int bit = __builtin_ctz(um);
          um &= um - 1;
          const int pos = (wd * 32 + bit) * 64;
          if ((float)(t0 - pos - 63) <= skipd_g) return pos;
        }
      },
      [&](int pos0, const bf16_t* tb) {
        if ((float)(t0 - pos0 - 63) > skipd) return;
        const int m = pos0 >> 6;
        unsigned selbit[NQT];
#pragma unroll
        for (int nt = 0; nt < NQT; ++nt) selbit[nt] = (selmask[(nt * 16 + lr) * 4 + (m >> 5)] >> (m & 31)) & 1u;
        attn_tile(st, qf, tb, pos0 - t0, lr, selbit, 1 << 30, m >= qb, c1, slope2, quad);
      });
  }
#pragma unroll
  for (int nt = 0; nt < NQT; ++nt) {
    float l = st.l[nt];
    l += __shfl_xor(l, 16); l += __shfl_xor(l, 32);
    const float f = gate(nt, 1) / l;
#pragma unroll
    for (int dt = 0; dt < 4; ++dt)
#pragma unroll
      for (int r = 0; r < 4; ++r) stash[((dt * NQT + nt) * 4 + r) * 256 + tid] += f * st.o[dt][nt][r];
  }
  attn_reset(st);
  {
    unsigned one[NQT];
#pragma unroll
    for (int nt = 0; nt < NQT; ++nt) one[nt] = 1u;
    int pstart = (t0 - 512) & ~63;
    if (pstart < 0) pstart = 0;
    TileSrc ts;
    ts.kbase = p.Y + tokbase * LDY + C_KW + g * 64; ts.krs = LDY;
    ts.vbase = p.YT + (size_t)(R_VW + g * 64) * LDT + tokbase; ts.vrs = LDT;
    int pp = pstart;
    tile_loop<true>(lds, tid, ts, [&]() -> int { const int r = pp < t0 + 32 ? pp : -1; pp += 64; return r; },
      [&](int pos0, const bf16_t* tb) {
        const int rel0 = pos0 - t0;
        if ((float)(-rel0 - 63) > skipd) return;
        attn_tile(st, qf, tb, rel0, lr, one, 511, !(rel0 + 63 <= 0 && rel0 >= 31 - 511), c1, slope2, quad);
      });
  }
#pragma unroll
  for (int nt = 0; nt < NQT; ++nt) {
    float l = st.l[nt];
    l += __shfl_xor(l, 16); l += __shfl_xor(l, 32);
    const float f = gate(nt, 2) / l;
    float ss = 0.f;
#pragma unroll
    for (int dt = 0; dt < 4; ++dt)
#pragma unroll
      for (int r = 0; r < 4; ++r) {
        const float v = stash[((dt * NQT + nt) * 4 + r) * 256 + tid] + f * st.o[dt][nt][r];
        st.o[dt][nt][r] = v;
        ss += v * v;
      }
    ss += __shfl_xor(ss, 16); ss += __shfl_xor(ss, 32);
    const float rstd = rsqrtf(ss * (1.0f / 64.0f) + 1e-6f);
#pragma unroll
    for (int dt = 0; dt < 4; ++dt) {
      const int d = dt * 16 + quad * 4;
      const f32x4 gn = *(const f32x4*)(p.g_nsa + h * 64 + d);
      *(u32x2*)(p.Omix + (tokbase + tq0 + nt * 16) * D + h * 64 + d) =
          (u32x2){pk_bf16(st.o[dt][nt][0] * rstd * gn[0], st.o[dt][nt][1] * rstd * gn[1]),
                  pk_bf16(st.o[dt][nt][2] * rstd * gn[2], st.o[dt][nt][3] * rstd * gn[3])};
    }
  }
  __syncthreads();
}

DEV void phase5(const Params& p, char* lds) {
  const int G = gridDim.x, bid = blockIdx.x;
  for (int r = 0; r * G < 6144; ++r) {
    const int v = r * G + ((r & 1) ? G - 1 - bid : bid);
    if (v >= 6144) continue;
    const int step = v / 24, within = v - step * 24;
    if (within < 16) {
      const int u = ((within >> 2) << 10) | ((within & 3) << 8) | (255 - step);
      nsa_unit(p, u, lds);
#if defined(REPU) && REPU == 1
      nsa_unit(p, u, lds);
#endif
    } else {
      ret_out_unit(p, step * 8 + (within - 16));
    }
  }
}

DEV int order_key(float v, int idx) {
  int bits = __float_as_int(v);
  bits ^= (bits >> 31) & 0x7fffffff;
  return (bits & ~0x7f) | (127 - idx);
}
DEV float key_val(int key) {
  int bits = key & ~0x7f;
  bits ^= (bits >> 31) & 0x7fffffff;
  return __int_as_float(bits);
}

DEV void peer_unit(const Params& p, int u, char* lds) {
  const int tid = opaque_tid(), lane = tid & 63, w = tid >> 6, lr = lane & 15, quad = lane >> 4;
  const int t0 = u * 16;
  int* sc = (int*)lds;
  int* tk = (int*)(lds + 16384);
  float* cval = (float*)(lds + 18432);
  int* exi = (int*)(lds + 22528);
  float* exg = (float*)(lds + 30720);
  for (int h = 0; h < 8; ++h) {
    {
      const int pp = w >> 1, nt0 = (w & 1) * 4;
      bf16x8 af[4];
#pragma unroll
      for (int ks = 0; ks < 4; ++ks) af[ks] = ld8(p.Qp + (size_t)(t0 + lr) * D + h * 256 + pp * 128 + ks * 32 + quad * 8);
#pragma unroll
      for (int nn = 0; nn < 4; ++nn) {
        const int nt = nt0 + nn;
        f32x4 acc = (f32x4){0.f, 0.f, 0.f, 0.f};
#pragma unroll
        for (int ks = 0; ks < 4; ++ks)
          acc = mfma16(af[ks], ld8(p.SK + ((size_t)((h * 2 + pp) * 128 + nt * 16 + lr)) * 128 + ks * 32 + quad * 8), acc);
#pragma unroll
        for (int r = 0; r < 4; ++r) sc[(pp * 16 + quad * 4 + r) * 128 + nt * 16 + lr] = order_key(acc[r], nt * 16 + lr);
      }
    }
    __syncthreads();
    for (int rr = 0; rr < 8; rr += 2) {
      const int rowA = w * 8 + rr, rowB = rowA + 1;
      const int a0 = sc[rowA * 128 + lane], a1 = sc[rowA * 128 + 64 + lane], b0 = sc[rowB * 128 + lane], b1 = sc[rowB * 128 + 64 + lane];
      const unsigned ua0 = (unsigned)a0 ^ 0x80000000u, ua1 = (unsigned)a1 ^ 0x80000000u, ub0 = (unsigned)b0 ^ 0x80000000u, ub1 = (unsigned)b1 ^ 0x80000000u;
      unsigned thA = 0u, thB = 0u;
#pragma unroll 1
      for (int bit = 31; bit >= 0; --bit) {
        const unsigned cA = thA | (1u << bit), cB = thB | (1u << bit);
        const int nA = __popcll(__ballot(ua0 >= cA)) + __popcll(__ballot(ua1 >= cA));
        const int nB = __popcll(__ballot(ub0 >= cB)) + __popcll(__ballot(ub1 >= cB));
        if (nA >= 16) thA = cA;
        if (nB >= 16) thB = cB;
      }
      const unsigned long long lt = (1ull << lane) - 1ull;
      {
        const unsigned long long m0 = __ballot(ua0 >= thA), m1 = __ballot(ua1 >= thA);
        if (ua0 >= thA) tk[rowA * 16 + __popcll(m0 & lt)] = a0;
        if (ua1 >= thA) tk[rowA * 16 + __popcll(m0) + __popcll(m1 & lt)] = a1;
      }
      {
        const unsigned long long m0 = __ballot(ub0 >= thB), m1 = __ballot(ub1 >= thB);
        if (ub0 >= thB) tk[rowB * 16 + __popcll(m0 & lt)] = b0;
        if (ub1 >= thB) tk[rowB * 16 + __popcll(m0) + __popcll(m1 & lt)] = b1;
      }
      if (lane < 32) {
        const int row = lane < 16 ? rowA : rowB, me = lane & 15;
        const int4 q0 = *(const int4*)(tk + row * 16), q1 = *(const int4*)(tk + row * 16 + 4), q2 = *(const int4*)(tk + row * 16 + 8), q3 = *(const int4*)(tk + row * 16 + 12);
        const int mine = tk[row * 16 + me];
        const int rank = (q0.x > mine) + (q0.y > mine) + (q0.z > mine) + (q0.w > mine) + (q1.x > mine) + (q1.y > mine) + (q1.z > mine) + (q1.w > mine) +
                         (q2.x > mine) + (q2.y > mine) + (q2.z > mine) + (q2.w > mine) + (q3.x > mine) + (q3.y > mine) + (q3.z > mine) + (q3.w > mine);
        tk[row * 16 + rank] = mine;
      }
    }
    __syncthreads();
    for (int tt = 0; tt < 4; ++tt) {
      const int tok = w * 4 + tt;
      int a = -1, bq = 0;
      {
        int c = lane;
        if (c < 16) { a = 0; bq = c; }
        else if (c < 24) { a = 1; bq = c - 16; }
        else if (c < 29) { a = 2; bq = c - 24; }
        else if (c < 33) { a = 3; bq = c - 29; }
        else if (c < 36) { a = 4; bq = c - 33; }
        else if (c < 38) { a = 5; bq = c - 36; }
        else if (c < 40) { a = 6; bq = c - 38; }
        else if (c < 42) { a = 7; bq = c - 40; }
        else if (c < 50) { a = c - 34; bq = 0; }
      }
      const bool act = a >= 0;
      const int ka = tk[(0 * 16 + tok) * 16 + (act ? a : 0)], kb = tk[(1 * 16 + tok) * 16 + bq];
      const float myv = act ? key_val(ka) + key_val(kb) : -3.0e38f;
      float* cv = cval + tok * 64;
      cv[lane] = myv;
      int rank = 0;
      for (int j = 0; j < 50; ++j) {
        const float vj = cv[j];
        rank += (vj > myv) || (vj == myv && j < lane);
      }
      float mx = act && rank == 0 ? myv : -3.0e38f;
#pragma unroll
      for (int o = 32; o >= 1; o >>= 1) mx = fmaxf(mx, __shfl_xor(mx, o));
      const bool win = act && rank < 16;
      const float ev = win ? __expf(myv - mx) : 0.f;
      const float sum = wave_sum(ev);
      if (win) {
        const int i0 = 127 - (ka & 0x7f), i1 = 127 - (kb & 0x7f);
        exi[tok * 128 + h * 16 + rank] = i0 * 128 + i1;
        exg[tok * 128 + h * 16 + rank] = ev / sum;
      }
    }
    __syncthreads();
  }
  for (int tt = 0; tt < 4; ++tt) {
    const int tok = w * 4 + tt;
    const size_t gt = (size_t)t0 + tok;
    const int b = (int)(gt / S);
    float hf[32];
#pragma unroll
    for (int i = 0; i < 2; ++i)
#pragma unroll
      for (int hh = 0; hh < 2; ++hh) {
        const u32x4 hv = *(const u32x4*)(p.H2 + gt * D + (i * 64 + lane) * 16 + hh * 8);
#pragma unroll
        for (int j = 0; j < 4; ++j) { hf[i * 16 + hh * 8 + 2 * j] = bf_lo(hv[j]); hf[i * 16 + hh * 8 + 2 * j + 1] = bf_hi(hv[j]); }
      }
    auto load_rows = [&](u32x4 (&r)[8], const unsigned char* base, int e0) {
#pragma unroll
      for (int k = 0; k < 4; ++k) {
        const unsigned char* rp = base + (size_t)exi[tok * 128 + e0 + k] * D + lane * 16;
        r[2 * k] = *(const u32x4*)rp; r[2 * k + 1] = *(const u32x4*)(rp + 1024);
      }
    };
    auto dot_rows = [&](const u32x4 (&r)[8], int e0) {
      float sv[4];
#pragma unroll
      for (int k = 0; k < 4; ++k) {
        float sa = 0.f, sb = 0.f;
#pragma unroll
        for (int j = 0; j < 4; ++j) {
          const f32x2v a0 = __builtin_amdgcn_cvt_pk_f32_fp8((int)r[2 * k][j], false), a1 = __builtin_amdgcn_cvt_pk_f32_fp8((int)r[2 * k][j], true);
          const f32x2v b0 = __builtin_amdgcn_cvt_pk_f32_fp8((int)r[2 * k + 1][j], false), b1 = __builtin_amdgcn_cvt_pk_f32_fp8((int)r[2 * k + 1][j], true);
          sa += a0[0] * hf[j * 4 + 0] + a0[1] * hf[j * 4 + 1] + a1[0] * hf[j * 4 + 2] + a1[1] * hf[j * 4 + 3];
          sb += b0[0] * hf[16 + j * 4 + 0] + b0[1] * hf[16 + j * 4 + 1] + b1[0] * hf[16 + j * 4 + 2] + b1[1] * hf[16 + j * 4 + 3];
        }
        sv[k] = sa + sb;
      }
      float r2[2], r1;
      const bool h32 = (lane & 32) != 0, h16 = (lane & 16) != 0;
#pragma unroll
      for (int k = 0; k < 2; ++k) { const float mine = h32 ? sv[k + 2] : sv[k], oth = h32 ? sv[k] : sv[k + 2]; r2[k] = mine + __shfl_xor(oth, 32); }
      { const float mine = h16 ? r2[1] : r2[0], oth = h16 ? r2[0] : r2[1]; r1 = mine + __shfl_xor(oth, 16); }
      r1 += __shfl_xor(r1, 8); r1 += __shfl_xor(r1, 4); r1 += __shfl_xor(r1, 2); r1 += __shfl_xor(r1, 1);
      if ((lane & 15) == 0) {
        const int k = (h32 ? 2 : 0) + (h16 ? 1 : 0);
        const int ei = tok * 128 + e0 + k;
        exg[ei] = exg[ei] * gelu_tanh(r1 * (1.0f / U8_SCALE)) * (1.0f / V8_SCALE);
      }
    };
    u32x4 ra[8], rb[8];
    load_rows(ra, p.U8, 0);
#pragma unroll 1
    for (int e0 = 0; e0 < 128; e0 += 8) {
      load_rows(rb, p.U8, e0 + 4);
      dot_rows(ra, e0);
      load_rows(ra, p.U8, e0 + 8 < 128 ? e0 + 8 : 124);
      dot_rows(rb, e0 + 4);
    }
    float oacc[32];
#pragma unroll
    for (int i = 0; i < 32; ++i) oacc[i] = 0.f;
    auto acc_rows = [&](const u32x4 (&r)[8], int e0) {
#pragma unroll
      for (int k = 0; k < 4; ++k) {
        const float coef = exg[tok * 128 + e0 + k];
#pragma unroll
        for (int j = 0; j < 4; ++j) {
          const f32x2v a0 = __builtin_amdgcn_cvt_pk_f32_fp8((int)r[2 * k][j], false), a1 = __builtin_amdgcn_cvt_pk_f32_fp8((int)r[2 * k][j], true);
          const f32x2v b0 = __builtin_amdgcn_cvt_pk_f32_fp8((int)r[2 * k + 1][j], false), b1 = __builtin_amdgcn_cvt_pk_f32_fp8((int)r[2 * k + 1][j], true);
          oacc[j * 4 + 0] += coef * a0[0]; oacc[j * 4 + 1] += coef * a0[1]; oacc[j * 4 + 2] += coef * a1[0]; oacc[j * 4 + 3] += coef * a1[1];
          oacc[16 + j * 4 + 0] += coef * b0[0]; oacc[16 + j * 4 + 1] += coef * b0[1]; oacc[16 + j * 4 + 2] += coef * b1[0]; oacc[16 + j * 4 + 3] += coef * b1[1];
        }
      }
    };
    load_rows(ra, p.V8, 0);
#pragma unroll 1
    for (int e0 = 0; e0 < 128; e0 += 8) {
      load_rows(rb, p.V8, e0 + 4);
      acc_rows(ra, e0);
      load_rows(ra, p.V8, e0 + 8 < 128 ? e0 + 8 : 124);
      acc_rows(rb, e0 + 4);
    }
    const float* g2 = p.mod + (size_t)b * 12288 + 5 * D;
    float ss = 0.f;
#pragma unroll
    for (int i = 0; i < 2; ++i)
#pragma unroll
      for (int q4 = 0; q4 < 4; ++q4) {
        const int col = (i * 64 + lane) * 16 + q4 * 4;
        const f32x4 x1 = *(const f32x4*)(p.X1 + gt * D + col), gg = *(const f32x4*)(g2 + col);
#pragma unroll
        for (int j = 0; j < 4; ++j) {
          const float v = x1[j] + gg[j] * oacc[i * 16 + q4 * 4 + j];
          oacc[i * 16 + q4 * 4 + j] = v;
          ss += v * v;
        }
      }
    ss = wave_sum(ss);
    const float rstd = rsqrtf(ss * (1.0f / D) + 1e-6f);
#pragma unroll
    for (int i = 0; i < 2; ++i)
#pragma unroll
      for (int q4 = 0; q4 < 4; ++q4) {
        const int col = (i * 64 + lane) * 16 + q4 * 4;
        const f32x4 gf = *(const f32x4*)(p.g_final + col);
        f32x4 o;
#pragma unroll
        for (int j = 0; j < 4; ++j) o[j] = oacc[i * 16 + q4 * 4 + j] * rstd * gf[j];
        *(f32x4*)(p.out + gt * D + col) = o;
      }
  }
  __syncthreads();
}

DEV void phase9(const Params& p, char* lds) {
  for (int u = blockIdx.x; u < T / 16; u += gridDim.x) peer_unit(p, u, lds);
}
DEV void phase9_dynamic(const Params& p, char* lds, unsigned* unit_cnt, unsigned* panel_cnt) {
  int* slot = (int*)(lds + LDS_BYTES - 16);
  for (;;) {
    __syncthreads();
    if (threadIdx.x == 0) {
      const int u = (int)__hip_atomic_fetch_add(unit_cnt, 1u, __ATOMIC_RELAXED, __HIP_MEMORY_SCOPE_AGENT);
      if (u < T / 16) {
        while (__hip_atomic_load(panel_cnt + 16 * (u >> 3), __ATOMIC_RELAXED, __HIP_MEMORY_SCOPE_AGENT) < 16u) __builtin_amdgcn_s_sleep(8);
        __builtin_amdgcn_fence(__ATOMIC_ACQUIRE, "agent");
        asm volatile("s_waitcnt vmcnt(0)" ::: "memory");
      }
      *slot = u;
    }
    __syncthreads();
    const int u = *slot;
    if (u >= T / 16) break;
    peer_unit(p, u, lds);
  }
}

DEV void gbar(unsigned* bar, unsigned& gen) {
  asm volatile("s_waitcnt vmcnt(0) lgkmcnt(0)" ::: "memory");
  __syncthreads();
  gen += 1u;
  if (threadIdx.x == 0) {
    __builtin_amdgcn_fence(__ATOMIC_RELEASE, "agent");
    asm volatile("s_waitcnt vmcnt(0)" ::: "memory");
    const unsigned G = gridDim.x, bidx = blockIdx.x;
    if ((G & 63u) == 0u) {
      const unsigned x = bidx & 7u, j = bidx >> 3, n2 = G >> 6;
      unsigned* c1 = bar + 64 * (x * 8 + (j >> 3));
      unsigned* c2 = bar + 64 * (64 + x);
      unsigned* c3 = bar + 64 * 72;
      unsigned* flag = bar + 64 * (73 + x);
      if (__hip_atomic_fetch_add(c1, 1u, __ATOMIC_RELAXED, __HIP_MEMORY_SCOPE_AGENT) + 1u == gen * 8u)
        if (__hip_atomic_fetch_add(c2, 1u, __ATOMIC_RELAXED, __HIP_MEMORY_SCOPE_AGENT) + 1u == gen * n2)
          if (__hip_atomic_fetch_add(c3, 1u, __ATOMIC_RELAXED, __HIP_MEMORY_SCOPE_AGENT) + 1u == gen * 8u)
            for (unsigned k = 0; k < 8u; ++k) __hip_atomic_store(bar + 64 * (73 + k), gen, __ATOMIC_RELAXED, __HIP_MEMORY_SCOPE_AGENT);
      while (__hip_atomic_load(flag, __ATOMIC_RELAXED, __HIP_MEMORY_SCOPE_AGENT) < gen) __builtin_amdgcn_s_sleep(2);
    } else {
      unsigned* c = bar + 64 * 72;
      __hip_atomic_fetch_add(c, 1u, __ATOMIC_RELAXED, __HIP_MEMORY_SCOPE_AGENT);
      while (__hip_atomic_load(c, __ATOMIC_RELAXED, __HIP_MEMORY_SCOPE_AGENT) < gen * G) __builtin_amdgcn_s_sleep(2);
    }
    __builtin_amdgcn_fence(__ATOMIC_ACQUIRE, "agent");
    asm volatile("s_waitcnt vmcnt(0)" ::: "memory");
  }
  __syncthreads();
}

__global__ void __launch_bounds__(256, 2) mega(Params p_unused) {
  __shared__ __attribute__((aligned(16))) char lds[LDS_BYTES];
  cg::grid_group grid = cg::this_grid();
  const Params& p = *(const Params*)__builtin_amdgcn_kernarg_segment_ptr();
  const int lo = p.ph_lo, hi = p.ph_hi;
  unsigned gen = 0u;
  if (hi > lo) grid.sync();
#ifndef ONLY
#define ONLY -1
#endif
#ifndef REP
#define REP -1
#endif
#define PH_ON(n) ((ONLY < 0 || ONLY == (n)) && lo <= (n) && (n) <= hi)
#define RP(n) for (int rep_ = 0; rep_ < ((REP == (n)) ? 2 : 1); ++rep_)
#define SYNC_AFTER(n) if (lo <= (n) && (n) < hi) gbar(p.bar, gen);
  if (PH_ON(0)) RP(0) phase0(p, lds);
  SYNC_AFTER(0)
  if (PH_ON(1)) phase1(p);
  SYNC_AFTER(1)
  if (PH_ON(2)) RP(2) rms_mod_phase(p.x, p.g_mix, p.mod, 0, 1, p.H);
  SYNC_AFTER(2)
  if (PH_ON(3)) RP(3) { Epi1 e{p.Y, p.YT}; gemm_phase(p.H, p.WinT, T, LDY, D, lds, e); conv_drain(p, lds); }
  SYNC_AFTER(3)
  if (PH_ON(4)) RP(4) phase4(p, lds);
  SYNC_AFTER(4)
  if (PH_ON(5)) RP(5) phase5(p, lds);
  SYNC_AFTER(5)
  if (PH_ON(6)) RP(6) { Epi2 e{p.x, p.mod, p.X1}; gemm_phase(p.Omix, p.WoutT, T, D, D, lds, e); }
  SYNC_AFTER(6)
  if (PH_ON(7)) RP(7) rms_mod_phase(p.X1, p.g_ffn, p.mod, 3, 4, p.H2);
  SYNC_AFTER(7)
  if (PH_ON(8)) {
    Epi3 e{p.Qp};
    unsigned* panel_cnt = p.bar + 8192;
    gemm_phase(p.H2, p.WqT, T, D, D, lds, e, (int)gridDim.x >= 256 ? 128 : (int)gridDim.x, panel_cnt);
    phase9_dynamic(p, lds, p.bar + 64 * 101, panel_cnt);
  }
}

extern "C" void kernel_launch(void* const* d_in, const int* in_sizes, int n_in, void* d_out, int out_size, void* d_ws, size_t ws_size,
                              hipStream_t stream) {
  static int grid_blocks = 0;
  if (!grid_blocks) {
    int dev = 0, cus = 0, per_cu = 0;
    (void)hipGetDevice(&dev);
    (void)hipDeviceGetAttribute(&cus, hipDeviceAttributeMultiprocessorCount, dev);
    (void)hipOccupancyMaxActiveBlocksPerMultiprocessor(&per_cu, mega, 256, 0);
    if (per_cu < 1) per_cu = 1;
    if (per_cu > 2) per_cu = 2;
    grid_blocks = cus * per_cu;
  }
  Params p;
  memset(&p, 0, sizeof(p));
  const float* const* in = (const float* const*)d_in;
  p.x = in[0]; p.c = in[1]; p.w_ada = in[2]; p.b_ada = in[3]; p.g_mix = in[4]; p.g_ffn = in[5]; p.g_final = in[6]; p.w_in = in[7];
  p.pe_k = in[8]; p.pe_v = in[9]; p.ck_w1 = in[10]; p.ck_w2 = in[11]; p.cv_w1 = in[12]; p.cv_w2 = in[13]; p.g_nsa = in[14];
  p.g_ret = in[15]; p.w_out = in[16]; p.w_q = in[17]; p.sub_keys = in[18]; p.peer_u = in[19]; p.peer_v = in[20];
  p.out = (float*)d_out;
  char* ws = (char*)d_ws;
  size_t off = 0;
  auto take = [&](size_t bytes) { char* r = ws + off; off += (bytes + 255) & ~(size_t)255; return r; };
  p.bar = (unsigned*)take(65536);
  p.mod_part = (float*)take((size_t)16 * 4 * 12288 * 4);
  p.mod = (float*)take((size_t)4 * 12288 * 4);
  p.cbias = (float*)take((size_t)2 * 32 * 128 * 4);
  p.WinT = (bf16_t*)take((size_t)LDY * 2048 * 2);
  p.WoutT = (bf16_t*)take((size_t)2048 * 2048 * 2);
  p.WqT = (bf16_t*)take((size_t)2048 * 2048 * 2);
  p.SK = (bf16_t*)take((size_t)8 * 2 * 128 * 128 * 2);
  p.U8 = (unsigned char*)take((size_t)16384 * 2048);
  p.V8 = (unsigned char*)take((size_t)16384 * 2048);
  p.w1T = (bf16_t*)take((size_t)2 * 128 * 2048 * 2);
  p.w2T = (bf16_t*)take((size_t)2 * 64 * 128 * 2);
  p.Kc = (bf16_t*)take((size_t)16 * 512 * 64 * 2);
  p.VcT = (bf16_t*)take((size_t)16 * 64 * 512 * 2);
  p.RT = (bf16_t*)take((size_t)32 * 64 * 16384 * 2);
  p.H = (bf16_t*)take((size_t)T * D * 2);
  p.Omix = p.H;
  p.Y = (bf16_t*)take((size_t)T * LDY * 2);
  p.X1 = (float*)p.Y;
  p.H2 = (bf16_t*)((char*)p.Y + (size_t)T * D * 4);
  p.YT = (bf16_t*)take((size_t)NYT * LDT * 2);
  p.Qp = p.YT;
  if (off > ws_size) fprintf(stderr, "workspace too small: need %zu have %zu\n", off, ws_size);
  p.ph_lo = 0; p.ph_hi = 9;
  (void)hipMemsetAsync(p.bar, 0, 65536, stream);
  void* args[] = {&p};
  hipError_t e = hipLaunchCooperativeKernel((void*)mega, dim3(grid_blocks), dim3(256), args, 0, stream);
  if (e != hipSuccess) fprintf(stderr, "cooperative launch failed: %s (grid %d)\n", hipGetErrorString(e), grid_blocks);
}
```

```cpp
#include <hip/hip_runtime.h>
#include <hip/hip_cooperative_groups.h>
#include <stdint.h>
#include <cstdio>
#include <cstring>
namespace cg = cooperative_groups;

#define DEV __device__ __forceinline__
typedef unsigned short bf16_t;
typedef short bf16x8 __attribute__((ext_vector_type(8)));
typedef float f32x4 __attribute__((ext_vector_type(4)));
typedef unsigned u32x4 __attribute__((ext_vector_type(4)));
typedef unsigned u32x2 __attribute__((ext_vector_type(2)));

constexpr int D = 2048, NB = 4, S = 8192, T = NB * S;
constexpr int LDY = 6784;
constexpr int LDT = T + 192;
constexpr int C_QA = 0, C_KC = 1024, C_VC = 1280, C_KS = 1536, C_VS = 1792, C_KW = 2048, C_VW = 2304,
              C_QR = 2560, C_KR = 3584, C_VR = 4608, C_GR = 5632, C_GA = 6656;
constexpr int R_VS = 0, R_VW = 256, R_KR = 512, R_VR = 1536, NYT = 2560;
constexpr int LDS_BYTES = 73728;
constexpr float LOG2E = 1.4426950408889634f;

struct Params {
  const float *x, *c, *w_ada, *b_ada, *g_mix, *g_ffn, *g_final, *w_in, *pe_k, *pe_v, *ck_w1, *ck_w2, *cv_w1, *cv_w2,
      *g_nsa, *g_ret, *w_out, *w_q, *sub_keys, *peer_u, *peer_v;
  float* out;
  float *mod_part, *mod, *cbias, *X1;
  unsigned* bar;
  unsigned char *U8, *V8;
  bf16_t *WinT, *WoutT, *WqT, *SK, *w1T, *w2T, *H, *Y, *YT, *Kc, *VcT, *RT, *H2, *Qp, *Omix;
  int ph_lo, ph_hi;
};

typedef __bf16 bf16v2_t __attribute__((ext_vector_type(2)));
typedef float f32x2_t __attribute__((ext_vector_type(2)));
DEV unsigned pk_bf16(float lo, float hi) {
  const bf16v2_t r = __builtin_convertvector((f32x2_t){lo, hi}, bf16v2_t);
  return __builtin_bit_cast(unsigned, r);
}
DEV float bf_lo(unsigned w) { return __uint_as_float(w << 16); }
DEV float bf_hi(unsigned w) { return __uint_as_float(w & 0xffff0000u); }
DEV float bf2f(bf16_t h) { return __uint_as_float(((unsigned)h) << 16); }
DEV float ex2(float x) { return __builtin_amdgcn_exp2f(x); }
DEV float sigmoidf_(float x) { return 1.0f / (1.0f + __expf(-x)); }
DEV float gelu_tanh(float x) {
  float u = 0.7978845608028654f * (x + 0.044715f * x * x * x);
  float t = 1.0f - 2.0f / (__expf(2.0f * u) + 1.0f);
  return 0.5f * x * (1.0f + t);
}
DEV f32x4 mfma16(bf16x8 a, bf16x8 b, f32x4 c) { return __builtin_amdgcn_mfma_f32_16x16x32_bf16(a, b, c, 0, 0, 0); }
DEV bf16x8 ld8(const bf16_t* p) { return *(const bf16x8*)p; }
DEV bf16x8 as_bf8(u32x4 v) { return __builtin_bit_cast(bf16x8, v); }
DEV float wave_sum(float v) {
#pragma unroll
  for (int o = 32; o >= 1; o >>= 1) v += __shfl_xor(v, o);
  return v;
}


DEV int opaque_tid() { int t = threadIdx.x; asm volatile("" : "+v"(t)); return t; }

DEV void transpose_tile(const float* __restrict__ src, int ld_src, int mode, bf16_t* __restrict__ dst, int Kdim, int n0, int k0,
                        float* tile) {
  const int tid = threadIdx.x, tx = tid & 63, ty = tid >> 6;
  const int n = n0 + tx;
  int sc = n;
  bool ok = true;
  if (mode == 1) {
    if (n < 2560) sc = n;
    else if (n < 6656) sc = n + 48;
    else if (n < 6704) sc = n - 6656 + 2560;
    else { sc = 0; ok = false; }
  }
#pragma unroll
  for (int i = 0; i < 16; ++i) {
    const int kk = ty + 4 * i;
    tile[kk * 65 + tx] = ok ? src[(size_t)(k0 + kk) * ld_src + sc] : 0.f;
  }
  __syncthreads();
  const int nn = tid >> 2, kc = (tid & 3) * 16;
  unsigned w[8];
#pragma unroll
  for (int j = 0; j < 8; ++j) w[j] = pk_bf16(tile[(kc + 2 * j) * 65 + nn], tile[(kc + 2 * j + 1) * 65 + nn]);
  u32x4* d = (u32x4*)(dst + (size_t)(n0 + nn) * Kdim + k0 + kc);
  d[0] = (u32x4){w[0], w[1], w[2], w[3]};
  d[1] = (u32x4){w[4], w[5], w[6], w[7]};
  __syncthreads();
}

DEV void convert_unit(const float* __restrict__ src, bf16_t* __restrict__ dst, int unit) {
  const int tid = threadIdx.x;
#pragma unroll
  for (int i = 0; i < 4; ++i) {
    const size_t e = (size_t)unit * 8192 + i * 2048 + tid * 8;
    const f32x4 a = *(const f32x4*)(src + e), b = *(const f32x4*)(src + e + 4);
    *(u32x4*)(dst + e) = (u32x4){pk_bf16(a[0], a[1]), pk_bf16(a[2], a[3]), pk_bf16(b[0], b[1]), pk_bf16(b[2], b[3])};
  }
}

typedef float f32x2v __attribute__((ext_vector_type(2)));
DEV unsigned pk4_fp8(float a, float b, float c, float d) {
  int w = __builtin_amdgcn_cvt_pk_fp8_f32(a, b, 0, false);
  w = __builtin_amdgcn_cvt_pk_fp8_f32(c, d, w, true);
  return (unsigned)w;
}
DEV void convert_unit_fp8(const float* __restrict__ src, unsigned char* __restrict__ dst, int unit, float scale) {
  const int tid = threadIdx.x;
#pragma unroll
  for (int i = 0; i < 2; ++i) {
    const size_t e = (size_t)unit * 8192 + i * 4096 + tid * 16;
    f32x4 a[4];
#pragma unroll
    for (int j = 0; j < 4; ++j) a[j] = *(const f32x4*)(src + e + 4 * j) * scale;
    *(u32x4*)(dst + e) = (u32x4){pk4_fp8(a[0][0], a[0][1], a[0][2], a[0][3]), pk4_fp8(a[1][0], a[1][1], a[1][2], a[1][3]),
                                 pk4_fp8(a[2][0], a[2][1], a[2][2], a[2][3]), pk4_fp8(a[3][0], a[3][1], a[3][2], a[3][3])};
  }
}
constexpr float U8_SCALE = 64.0f, V8_SCALE = 4.0f;

DEV void phase0(const Params& p, char* lds) {
  float* fl = (float*)lds;
  const int tid = threadIdx.x;
  constexpr int U_MOD = 768, U_WIN = 106 * 32, U_W1 = 128, U_W2 = 4, U_CB = 32;
  constexpr int TOT = U_MOD + U_WIN + U_W1 + U_W2 + U_CB;
  for (int u0 = blockIdx.x; u0 < TOT; u0 += gridDim.x) {
    int u = u0;
    if (u < U_MOD) {
      const int colblk = u % 48, ks = u / 48;
      for (int i = tid; i < 512; i += 256) {
        const int b = i >> 7, k = i & 127;
        const float cv = p.c[b * D + ks * 128 + k];
        fl[i] = cv * sigmoidf_(cv);
      }
      __syncthreads();
      const int col = colblk * 256 + tid;
      float a0 = 0, a1 = 0, a2 = 0, a3 = 0;
      const float* wp = p.w_ada + (size_t)(ks * 128) * 12288 + col;
#pragma unroll 8
      for (int k = 0; k < 128; ++k) {
        const float w = wp[(size_t)k * 12288];
        a0 += fl[k] * w; a1 += fl[128 + k] * w; a2 += fl[256 + k] * w; a3 += fl[384 + k] * w;
      }
      float* mp = p.mod_part + (size_t)ks * 4 * 12288 + col;
      mp[0] = a0; mp[12288] = a1; mp[2 * 12288] = a2; mp[3 * 12288] = a3;
      __syncthreads();
      continue;
    }
    u -= U_MOD;
    if (u < U_WIN) { transpose_tile(p.w_in, 6704, 1, p.WinT, 2048, (u >> 5) * 64, (u & 31) * 64, fl); continue; }
    u -= U_WIN;
    if (u < U_W1) {
      const int kv = u >> 6, r = u & 63;
      transpose_tile(kv ? p.cv_w1 : p.ck_w1, 128, 0, p.w1T + (size_t)kv * 128 * 2048, 2048, (r >> 5) * 64, (r & 31) * 64, fl);
      continue;
    }
    u -= U_W1;
    if (u < U_W2) {
      const int kv = u >> 1, r = u & 1;
      transpose_tile(kv ? p.cv_w2 : p.ck_w2, 64, 0, p.w2T + (size_t)kv * 64 * 128, 128, 0, r * 64, fl);
      continue;
    }
    u -= U_W2;
    if (u < U_CB) {
      const int kv = u >> 4, ks = u & 15, j = tid & 127, half = tid >> 7;
      const float* pe = kv ? p.pe_v : p.pe_k;
      const float* w1 = kv ? p.cv_w1 : p.ck_w1;
      const int i0 = ks * 128 + half * 64;
      float a = 0.f;
#pragma unroll 8
      for (int i = 0; i < 64; ++i) a += pe[i0 + i] * w1[(size_t)(i0 + i) * 128 + j];
      p.cbias[(kv * 32 + ks * 2 + half) * 128 + j] = a;
      continue;
    }
  }
}

DEV void phase1(const Params& p) {
  const int tid = threadIdx.x;
  for (int u = blockIdx.x; u < 192; u += gridDim.x) {
    const int idx = u * 256 + tid;
    const int col = idx % 12288;
    float a = p.b_ada[col];
#pragma unroll
    for (int ks = 0; ks < 16; ++ks) a += p.mod_part[(size_t)ks * 4 * 12288 + idx];
    p.mod[idx] = a;
  }
}

DEV void rms_mod_phase(const float* __restrict__ xin, const float* __restrict__ g, const float* __restrict__ mod, int shift_idx,
                       int scale_idx, bf16_t* __restrict__ dst) {
  const int lane = threadIdx.x & 63, wid = threadIdx.x >> 6;
  for (int u = blockIdx.x; u < T / 4; u += gridDim.x) {
    const int tok = u * 4 + wid, b = tok / S;
    const float* xr = xin + (size_t)tok * D;
    f32x4 v[8];
    float ss = 0.f;
#pragma unroll
    for (int i = 0; i < 8; ++i) {
      v[i] = *(const f32x4*)(xr + i * 256 + lane * 4);
      ss += v[i][0] * v[i][0] + v[i][1] * v[i][1] + v[i][2] * v[i][2] + v[i][3] * v[i][3];
    }
    ss = wave_sum(ss);
    const float rstd = rsqrtf(ss * (1.0f / D) + 1e-6f);
    const float* sh = mod + (size_t)b * 12288 + shift_idx * D;
    const float* sc = mod + (size_t)b * 12288 + scale_idx * D;
#pragma unroll
    for (int i = 0; i < 8; ++i) {
      const int col = i * 256 + lane * 4;
      const f32x4 gg = *(const f32x4*)(g + col), s1 = *(const f32x4*)(sc + col), s0 = *(const f32x4*)(sh + col);
      float y[4];
#pragma unroll
      for (int j = 0; j < 4; ++j) y[j] = v[i][j] * rstd * gg[j] * (1.0f + s1[j]) + s0[j];
      *(u32x2*)(dst + (size_t)tok * D + col) = (u32x2){pk_bf16(y[0], y[1]), pk_bf16(y[2], y[3])};
    }
  }
}

constexpr int GL = 72;
template <class Epi>
DEV void gemm_phase(const bf16_t* __restrict__ A, const bf16_t* __restrict__ Bt, int M, int N, int K, char* lds, const Epi& epi,
                    int panel_blocks = 0, unsigned* panel_cnt = nullptr, unsigned* claim_cnt = nullptr, unsigned* ready_cnt = nullptr,
                    unsigned ready_need = 0u) {
  bf16_t* sbuf = (bf16_t*)lds;
  const int ntn = N / 128, ntm = M / 128, nk = K / 64;
  const int xcd = blockIdx.x & 7, jb = blockIdx.x >> 3, bpx = (gridDim.x + 7 - xcd) >> 3;
  const int nsgn = (ntn + 7) >> 3, nsuper = (ntm >> 3) * nsgn;
  const int niter = panel_blocks > 0 ? ((int)blockIdx.x < panel_blocks ? (ntm * ntn - (int)blockIdx.x + panel_blocks - 1) / panel_blocks : 0)
                                     : ((nsuper - xcd + 7) >> 3) * (jb < 64 ? (64 - jb + bpx - 1) / bpx : 0);
  const int npb = jb < 64 ? (64 - jb + bpx - 1) / bpx : 0;
  for (int it = 0; claim_cnt != nullptr || it < niter; ++it) {
    int tm, tn;
    if (claim_cnt != nullptr) {
      int* slot = (int*)(lds + LDS_BYTES - 16);
      __syncthreads();
      if (threadIdx.x == 0) {
        const int i = (int)__hip_atomic_fetch_add(claim_cnt, 1u, __ATOMIC_RELAXED, __HIP_MEMORY_SCOPE_AGENT);
        if (i < ntm * ntn) {
          const int k = i / ntn, tmw = (k & 3) * 64 + (63 - (k >> 2));
          while (__hip_atomic_load(ready_cnt + 16 * tmw, __ATOMIC_RELAXED, __HIP_MEMORY_SCOPE_AGENT) < ready_need) __builtin_amdgcn_s_sleep(8);
          __builtin_amdgcn_fence(__ATOMIC_ACQUIRE, "agent");
          asm volatile("s_waitcnt vmcnt(0)" ::: "memory");
        }
        *slot = i;
      }
      __syncthreads();
      const int i = *slot;
      if (i >= ntm * ntn) break;
      const int k = i / ntn;
      tm = (k & 3) * 64 + (63 - (k >> 2)); tn = i - k * ntn;
    } else if (panel_blocks > 0) { const int i = (int)blockIdx.x + it * panel_blocks; tm = i / ntn; tn = i - tm * ntn; }
    else {
      const int sidx = xcd + 8 * (it / npb), jj = jb + bpx * (it % npb);
      tm = (sidx / nsgn) * 8 + (jj >> 3); tn = (sidx % nsgn) * 8 + (jj & 7);
      if (tn >= ntn) continue;
    }
    const int tid = opaque_tid(), lane = tid & 63, wid = tid >> 6, wm = wid >> 1, wn = wid & 1, lr = lane & 15, quad = lane >> 4;
    const int srow = tid >> 3, skc = (tid & 7) * 8;
    const bf16_t* Ag = A + (size_t)(tm * 128 + srow) * K + skc;
    const bf16_t* Bg = Bt + (size_t)(tn * 128 + srow) * K + skc;
    f32x4 acc[4][4];
#pragma unroll
    for (int i = 0; i < 4; ++i)
#pragma unroll
      for (int j = 0; j < 4; ++j) acc[i][j] = (f32x4){0.f, 0.f, 0.f, 0.f};
    u32x4 xa[4], xb[4], ya[4], yb[4];
#define G_LOAD(ra, rb, kt) do { _Pragma("unroll") for (int i = 0; i < 4; ++i) { \
      ra[i] = *(const u32x4*)(Ag + (size_t)(32 * i) * K + (kt) * 64); rb[i] = *(const u32x4*)(Bg + (size_t)(32 * i) * K + (kt) * 64); } } while (0)
#define G_STORE(ra, rb, buf) do { bf16_t* nA_ = sbuf + (buf) * (256 * GL); _Pragma("unroll") for (int i = 0; i < 4; ++i) { \
      *(u32x4*)(nA_ + (srow + 32 * i) * GL + skc) = ra[i]; *(u32x4*)(nA_ + 128 * GL + (srow + 32 * i) * GL + skc) = rb[i]; } } while (0)
#define G_COMPUTE(buf) do { const bf16_t* cA = sbuf + (buf) * (256 * GL); const bf16_t* cB = cA + 128 * GL; \
      _Pragma("unroll") for (int ks = 0; ks < 2; ++ks) { bf16x8 af[4], bfr[4]; \
        _Pragma("unroll") for (int i = 0; i < 4; ++i) { af[i] = ld8(cA + (wm * 64 + i * 16 + lr) * GL + ks * 32 + quad * 8); \
                                                      bfr[i] = ld8(cB + (wn * 64 + i * 16 + lr) * GL + ks * 32 + quad * 8); } \
        _Pragma("unroll") for (int i = 0; i < 4; ++i) _Pragma("unroll") for (int j = 0; j < 4; ++j) acc[i][j] = mfma16(af[i], bfr[j], acc[i][j]); \
        __builtin_amdgcn_sched_barrier(0); } } while (0)
    G_LOAD(xa, xb, 0);
    G_STORE(xa, xb, 0);
    G_LOAD(xa, xb, 1);
    G_LOAD(ya, yb, 2);
    __syncthreads();
    for (int kt = 0; kt < nk; kt += 2) {
      G_COMPUTE(0);
      G_STORE(xa, xb, 1);
      if (kt + 3 < nk) G_LOAD(xa, xb, kt + 3);
      __syncthreads();
      G_COMPUTE(1);
      if (kt + 2 < nk) G_STORE(ya, yb, 0);
      if (kt + 4 < nk) G_LOAD(ya, yb, kt + 4);
      __syncthreads();
    }
#undef G_LOAD
#undef G_STORE
#undef G_COMPUTE
    float* sC = (float*)lds;
    if (epi.rowmajor(tn)) {
#pragma unroll
      for (int i = 0; i < 4; ++i)
#pragma unroll
        for (int j = 0; j < 4; ++j)
#pragma unroll
          for (int r = 0; r < 4; ++r) sC[(wm * 64 + i * 16 + quad * 4 + r) * 132 + wn * 64 + j * 16 + lr] = acc[i][j][r];
      __syncthreads();
      epi(tm, tn, sC);
      __syncthreads();
    }
    if (epi.transposed(tn)) {
#pragma unroll
      for (int i = 0; i < 4; ++i)
#pragma unroll
        for (int j = 0; j < 4; ++j) *(f32x4*)(sC + (wn * 64 + j * 16 + lr) * 132 + wm * 64 + i * 16 + quad * 4) = acc[i][j];
      __syncthreads();
      epi.store_t(tm, tn, sC);
      __syncthreads();
    }
    if (panel_blocks > 0) {
      asm volatile("s_waitcnt vmcnt(0)" ::: "memory");
      __syncthreads();
      if (threadIdx.x == 0) {
        __builtin_amdgcn_fence(__ATOMIC_RELEASE, "agent");
        asm volatile("s_waitcnt vmcnt(0)" ::: "memory");
        __hip_atomic_fetch_add(panel_cnt + 16 * tm, 1u, __ATOMIC_RELAXED, __HIP_MEMORY_SCOPE_AGENT);
      }
    }
  }
}

struct Epi1 {
  bf16_t* Y; bf16_t* YT;
  DEV bool rowmajor(int tn) const { return !((tn == 14 || tn == 15) || (tn == 18 || tn == 19) || (tn >= 36 && tn < 44)); }
  DEV bool transposed(int tn) const { return (tn == 14 || tn == 15) || (tn == 18 || tn == 19) || (tn >= 28 && tn < 44); }
  DEV void operator()(int tm, int tn, const float* sC) const {
    const int tid = threadIdx.x;
#pragma unroll
    for (int i = 0; i < 8; ++i) {
      const int idx = tid + 256 * i, row = idx >> 4, c8 = idx & 15;
      const f32x4 a = *(const f32x4*)(sC + row * 132 + c8 * 8), b = *(const f32x4*)(sC + row * 132 + c8 * 8 + 4);
      *(u32x4*)(Y + (size_t)(tm * 128 + row) * LDY + tn * 128 + c8 * 8) =
          (u32x4){pk_bf16(a[0], a[1]), pk_bf16(a[2], a[3]), pk_bf16(b[0], b[1]), pk_bf16(b[2], b[3])};
    }
  }
  DEV void store_t(int tm, int tn, const float* sCT) const {
    const int tid = threadIdx.x;
    int r0;
    if (tn == 14 || tn == 15) r0 = R_VS + (tn - 14) * 128;
    else if (tn == 18 || tn == 19) r0 = R_VW + (tn - 18) * 128;
    else if (tn < 36) r0 = R_KR + (tn - 28) * 128;
    else r0 = R_VR + (tn - 36) * 128;
#pragma unroll
    for (int i = 0; i < 8; ++i) {
      const int idx = tid + 256 * i, col = idx >> 4, ch = idx & 15;
      const f32x4 a = *(const f32x4*)(sCT + col * 132 + ch * 8), b = *(const f32x4*)(sCT + col * 132 + ch * 8 + 4);
      *(u32x4*)(YT + (size_t)(r0 + col) * LDT + tm * 128 + ch * 8) =
          (u32x4){pk_bf16(a[0], a[1]), pk_bf16(a[2], a[3]), pk_bf16(b[0], b[1]), pk_bf16(b[2], b[3])};
    }
  }
};
struct Epi2 {
  const float* x; const float* mod; float* X1;
  DEV bool rowmajor(int) const { return true; }
  DEV bool transposed(int) const { return false; }
  DEV void store_t(int, int, const float*) const {}
  DEV void operator()(int tm, int tn, const float* sC) const {
    const int tid = threadIdx.x, b = (tm * 128) / S;
#pragma unroll
    for (int i = 0; i < 16; ++i) {
      const int idx = tid + 256 * i, row = idx >> 5, c4 = idx & 31;
      const f32x4 v = *(const f32x4*)(sC + row * 132 + c4 * 4);
      const size_t t = (size_t)tm * 128 + row;
      const int col = tn * 128 + c4 * 4;
      const f32x4 xi = *(const f32x4*)(x + t * D + col), gt = *(const f32x4*)(mod + (size_t)b * 12288 + 2 * D + col);
      *(f32x4*)(X1 + t * D + col) = xi + gt * v;
    }
  }
};
struct Epi3 {
  bf16_t* Q;
  DEV bool rowmajor(int) const { return true; }
  DEV bool transposed(int) const { return false; }
  DEV void store_t(int, int, const float*) const {}
  DEV void operator()(int tm, int tn, const float* sC) const {
    const int tid = threadIdx.x;
#pragma unroll
    for (int i = 0; i < 8; ++i) {
      const int idx = tid + 256 * i, row = idx >> 4, c8 = idx & 15;
      const f32x4 a = *(const f32x4*)(sC + row * 132 + c8 * 8), b = *(const f32x4*)(sC + row * 132 + c8 * 8 + 4);
      *(u32x4*)(Q + (size_t)(tm * 128 + row) * D + tn * 128 + c8 * 8) =
          (u32x4){pk_bf16(a[0], a[1]), pk_bf16(a[2], a[3]), pk_bf16(b[0], b[1]), pk_bf16(b[2], b[3])};
    }
  }
};

DEV float ret_lg2(int h) { return log1pf(-ex2(-5.0f - (float)h)) * LOG2E; }

DEV void ret_state_unit(const Params& p, int u) {
  const int tid_ = opaque_tid(), lane = tid_ & 63, w = tid_ >> 6, lr = lane & 15, quad = lane >> 4;
  const int es = u & 7, h = (u >> 3) & 7, b = u >> 6;
  const float lg2 = ret_lg2(h);
  const float cd = ex2(lg2 * 128.0f);
  const float kscale = 0.08838834764831845f;
  f32x4 st[2];
  st[0] = (f32x4){0.f, 0.f, 0.f, 0.f}; st[1] = st[0];
  const bf16_t* vrow = p.YT + (size_t)(R_VR + h * 128 + es * 16 + lr) * LDT + (size_t)b * S + quad * 8;
  const bf16_t* krow0 = p.YT + (size_t)(R_KR + h * 128 + w * 32 + lr) * LDT + (size_t)b * S + quad * 8;
  const bf16_t* krow1 = krow0 + (size_t)16 * LDT;
  bf16_t* rt = p.RT + ((size_t)((b * 8 + h) * 64)) * 16384 + (size_t)(es * 16 + quad * 4) * 128 + w * 32 + lr;
  for (int n = 0; n < 64; ++n) {
#pragma unroll
    for (int nt = 0; nt < 2; ++nt)
#pragma unroll
      for (int r = 0; r < 4; ++r) {
        const float v = st[nt][r];
        rt[(size_t)n * 16384 + r * 128 + nt * 16] = (bf16_t)(pk_bf16(v, v) & 0xffffu);
      }
    if (n == 63) break;
    f32x4 kv[2];
    kv[0] = (f32x4){0.f, 0.f, 0.f, 0.f}; kv[1] = kv[0];
#pragma unroll
    for (int ks = 0; ks < 4; ++ks) {
      const u32x4 vv = *(const u32x4*)(vrow + n * 128 + ks * 32);
      const bf16x8 k0 = ld8(krow0 + n * 128 + ks * 32), k1 = ld8(krow1 + n * 128 + ks * 32);
      u32x4 vs;
#pragma unroll
      for (int q2 = 0; q2 < 4; ++q2) {
        const int j = ks * 32 + quad * 8 + q2 * 2;
        const float d0 = kscale * ex2(lg2 * (float)(127 - j)), d1 = kscale * ex2(lg2 * (float)(126 - j));
        vs[q2] = pk_bf16(bf_lo(vv[q2]) * d0, bf_hi(vv[q2]) * d1);
      }
      const bf16x8 va = as_bf8(vs);
      kv[0] = mfma16(va, k0, kv[0]);
      kv[1] = mfma16(va, k1, kv[1]);
    }
    st[0] = st[0] * cd + kv[0];
    st[1] = st[1] * cd + kv[1];
  }
}

DEV void compress_unit(const Params& p, int cu, char* lds) {
  const int tid_ = opaque_tid(), lane = tid_ & 63, w = tid_ >> 6, lr = lane & 15, quad = lane >> 4;
  const int kv = cu >> 7, rem = cu & 127, b = rem >> 5, g = (rem >> 3) & 3, nb = rem & 7;
  const int srccol = (kv ? C_VC : C_KC) + g * 64;
  const bf16_t* w1T = p.w1T + (size_t)kv * 128 * 2048;
  const bf16_t* w2T = p.w2T + (size_t)kv * 64 * 128;
  const float* cb = p.cbias + kv * 32 * 128;
  bf16_t* h1 = (bf16_t*)lds;
  f32x4 acc[4][2];
#pragma unroll
  for (int m = 0; m < 4; ++m) { acc[m][0] = (f32x4){0.f, 0.f, 0.f, 0.f}; acc[m][1] = acc[m][0]; }
  const bf16_t* b0 = w1T + (size_t)(w * 32 + lr) * 2048 + quad * 8;
  const bf16_t* b1 = b0 + (size_t)16 * 2048;
  const bf16_t* ybase = p.Y + (size_t)b * S * LDY + srccol;
#pragma unroll 2
  for (int ks = 0; ks < 64; ++ks) {
    const int l = ks >> 1, dof = (ks & 1) * 32 + quad * 8;
    const bf16x8 bf0 = ld8(b0 + ks * 32), bf1 = ld8(b1 + ks * 32);
#pragma unroll
    for (int m = 0; m < 4; ++m) {
      int tok = 16 * (nb * 64 + m * 16 + lr) + l;
      tok = tok < S ? tok : S - 1;
      const bf16x8 af = ld8(ybase + (size_t)tok * LDY + dof);
      acc[m][0] = mfma16(af, bf0, acc[m][0]);
      acc[m][1] = mfma16(af, bf1, acc[m][1]);
    }
  }
#pragma unroll
  for (int nt = 0; nt < 2; ++nt) {
    const int hc = w * 32 + nt * 16 + lr;
    float bias = 0.f;
#pragma unroll
    for (int pp = 0; pp < 32; ++pp) bias += cb[pp * 128 + hc];
#pragma unroll
    for (int m = 0; m < 4; ++m)
#pragma unroll
      for (int r = 0; r < 4; ++r) {
        const float v = gelu_tanh(acc[m][nt][r] + bias);
        h1[(m * 16 + quad * 4 + r) * 136 + hc] = (bf16_t)(pk_bf16(v, v) & 0xffffu);
      }
  }
  __syncthreads();
  const int d = w * 16 + lr;
  bf16x8 bb[4];
#pragma unroll
  for (int ks = 0; ks < 4; ++ks) bb[ks] = ld8(w2T + (size_t)d * 128 + ks * 32 + quad * 8);
#pragma unroll
  for (int m = 0; m < 4; ++m) {
    f32x4 o = (f32x4){0.f, 0.f, 0.f, 0.f};
#pragma unroll
    for (int ks = 0; ks < 4; ++ks) o = mfma16(ld8(h1 + (m * 16 + lr) * 136 + ks * 32 + quad * 8), bb[ks], o);
    const int n0 = nb * 64 + m * 16 + quad * 4;
    if (kv == 0) {
#pragma unroll
      for (int r = 0; r < 4; ++r) p.Kc[((size_t)(b * 4 + g) * 512 + n0 + r) * 64 + d] = (bf16_t)(pk_bf16(o[r], o[r]) & 0xffffu);
    } else {
      *(u32x2*)(p.VcT + ((size_t)(b * 4 + g) * 64 + d) * 512 + n0) = (u32x2){pk_bf16(o[0], o[1]), pk_bf16(o[2], o[3])};
    }
  }
  __syncthreads();
}

constexpr int NCONV = 1024 + 1024 + 32 + 4096 + 4096;
DEV void conv_unit(const Params& p, int u, char* lds) {
  constexpr int U_WOUT = 1024, U_WQ = 1024, U_SK = 32, U_U = 4096;
  if (u < U_WOUT) { transpose_tile(p.w_out, 2048, 0, p.WoutT, 2048, (u >> 5) * 64, (u & 31) * 64, (float*)lds); return; }
  u -= U_WOUT;
  if (u < U_WQ) { transpose_tile(p.w_q, 2048, 0, p.WqT, 2048, (u >> 5) * 64, (u & 31) * 64, (float*)lds); return; }
  u -= U_WQ;
  if (u < U_SK) { convert_unit(p.sub_keys, p.SK, u); return; }
  u -= U_SK;
  if (u < U_U) { convert_unit_fp8(p.peer_u, p.U8, u, U8_SCALE); return; }
  u -= U_U;
  convert_unit_fp8(p.peer_v, p.V8, u, V8_SCALE);
}
DEV void conv_drain(const Params& p, char* lds) {
  unsigned* cnt = p.bar + 64 * 100;
  int* slot = (int*)(lds + LDS_BYTES - 16);
  for (;;) {
    __syncthreads();
    if (threadIdx.x == 0) *slot = (int)__hip_atomic_fetch_add(cnt, 1u, __ATOMIC_RELAXED, __HIP_MEMORY_SCOPE_AGENT);
    __syncthreads();
    const int u = *slot;
    if (u >= NCONV) break;
    conv_unit(p, u, lds);
  }
}

DEV void phase4(const Params& p, char* lds) {
  for (int u = blockIdx.x; u < 512; u += gridDim.x) {
    if (u < 256) ret_state_unit(p, u);
    else compress_unit(p, u - 256, lds);
  }
  conv_drain(p, lds);
}

DEV void ret_out_unit(const Params& p, int u) {
  const int tid_ = opaque_tid(), lane = tid_ & 63, w = tid_ >> 6, lr = lane & 15, quad = lane >> 4;
  const int n = u & 63, h = (u >> 6) & 7, b = u >> 9;
  const float lg2 = ret_lg2(h);
  const float kscale = 0.08838834764831845f;
  const size_t tk0 = (size_t)b * S + n * 128;
  f32x4 o[8][2];
#pragma unroll
  for (int i = 0; i < 8; ++i) { o[i][0] = (f32x4){0.f, 0.f, 0.f, 0.f}; o[i][1] = o[i][0]; }
  bf16x8 qf[2][4];
#pragma unroll
  for (int nt = 0; nt < 2; ++nt)
#pragma unroll
    for (int ks = 0; ks < 4; ++ks)
      qf[nt][ks] = ld8(p.Y + (tk0 + w * 32 + nt * 16 + lr) * LDY + C_QR + h * 128 + ks * 32 + quad * 8);
  const bf16_t* rt = p.RT + ((size_t)((b * 8 + h) * 64 + n)) * 16384 + (size_t)lr * 128 + quad * 8;
#pragma unroll 2
  for (int ks = 0; ks < 4; ++ks)
#pragma unroll
    for (int et = 0; et < 8; ++et) {
      const bf16x8 af = ld8(rt + et * 16 * 128 + ks * 32);
      o[et][0] = mfma16(af, qf[0][ks], o[et][0]);
      o[et][1] = mfma16(af, qf[1][ks], o[et][1]);
    }
  int ti[2];
#pragma unroll
  for (int nt = 0; nt < 2; ++nt) {
    ti[nt] = w * 32 + nt * 16 + lr;
    const float qd = ex2(lg2 * (float)(ti[nt] + 1));
#pragma unroll
    for (int et = 0; et < 8; ++et) o[et][nt] = o[et][nt] * qd;
  }
  for (int jt = 0; jt <= w; ++jt) {
    const int j0 = jt * 32;
    f32x4 s[2][2];
#pragma unroll
    for (int mt = 0; mt < 2; ++mt) { s[mt][0] = (f32x4){0.f, 0.f, 0.f, 0.f}; s[mt][1] = s[mt][0]; }
#pragma unroll
    for (int mt = 0; mt < 2; ++mt)
#pragma unroll
      for (int ks = 0; ks < 4; ++ks) {
        const bf16x8 kf = ld8(p.Y + (tk0 + j0 + mt * 16 + lr) * LDY + C_KR + h * 128 + ks * 32 + quad * 8);
        s[mt][0] = mfma16(kf, qf[0][ks], s[mt][0]);
        s[mt][1] = mfma16(kf, qf[1][ks], s[mt][1]);
      }
    bf16x8 pb[2];
#pragma unroll
    for (int nt = 0; nt < 2; ++nt) {
      float pv[2][4];
#pragma unroll
      for (int mt = 0; mt < 2; ++mt)
#pragma unroll
        for (int r = 0; r < 4; ++r) {
          const int j = j0 + mt * 16 + quad * 4 + r;
          const int dd = ti[nt] - j;
          pv[mt][r] = dd >= 0 ? s[mt][nt][r] * kscale * ex2(lg2 * (float)dd) : 0.f;
        }
      pb[nt] = as_bf8((u32x4){pk_bf16(pv[0][0], pv[0][1]), pk_bf16(pv[0][2], pv[0][3]), pk_bf16(pv[1][0], pv[1][1]), pk_bf16(pv[1][2], pv[1][3])});
    }
#pragma unroll
    for (int et = 0; et < 8; ++et) {
      const bf16_t* vp = p.YT + (size_t)(R_VR + h * 128 + et * 16 + lr) * LDT + tk0 + j0 + quad * 4;
      const u32x2 lo = *(const u32x2*)vp, hi = *(const u32x2*)(vp + 16);
      const bf16x8 vf = as_bf8((u32x4){lo[0], lo[1], hi[0], hi[1]});
      o[et][0] = mfma16(vf, pb[0], o[et][0]);
      o[et][1] = mfma16(vf, pb[1], o[et][1]);
    }
  }
#pragma unroll
  for (int nt = 0; nt < 2; ++nt) {
    float sm = 0.f;
#pragma unroll
    for (int et = 0; et < 8; ++et) sm += o[et][nt][0] + o[et][nt][1] + o[et][nt][2] + o[et][nt][3];
    sm += __shfl_xor(sm, 16); sm += __shfl_xor(sm, 32);
    const float mu = sm * (1.0f / 128.0f);
    float sq = 0.f;
#pragma unroll
    for (int et = 0; et < 8; ++et)
#pragma unroll
      for (int r = 0; r < 4; ++r) { const float dlt = o[et][nt][r] - mu; sq += dlt * dlt; }
    sq += __shfl_xor(sq, 16); sq += __shfl_xor(sq, 32);
    const float rstd = rsqrtf(sq * (1.0f / 128.0f) + 1e-6f);
    const size_t tok = tk0 + ti[nt];
#pragma unroll
    for (int et = 0; et < 8; ++et) {
      const int e = et * 16 + quad * 4;
      const u32x2 gr = *(const u32x2*)(p.Y + tok * LDY + C_GR + h * 128 + e);
      const f32x4 gw = *(const f32x4*)(p.g_ret + h * 128 + e);
      const float gv[4] = {bf_lo(gr[0]), bf_hi(gr[0]), bf_lo(gr[1]), bf_hi(gr[1])};
      float y[4];
#pragma unroll
      for (int r = 0; r < 4; ++r) y[r] = (o[et][nt][r] - mu) * rstd * gw[r] * (gv[r] * sigmoidf_(gv[r]));
      *(u32x2*)(p.Omix + tok * D + 1024 + h * 128 + e) = (u32x2){pk_bf16(y[0], y[1]), pk_bf16(y[2], y[3])};
    }
  }
}

constexpr int NQT = 2;
struct AttnSt { f32x4 o[4][NQT]; float m[NQT], l[NQT]; };

DEV void attn_reset(AttnSt& st) {
#pragma unroll
  for (int j = 0; j < NQT; ++j) {
    st.m[j] = -1e30f; st.l[j] = 0.f;
#pragma unroll
    for (int i = 0; i < 4; ++i) st.o[i][j] = (f32x4){0.f, 0.f, 0.f, 0.f};
  }
}

constexpr int TL = 72;
constexpr int TILE_BUF_BYTES = 2 * 64 * TL * 2;
constexpr int NSA_TILE_OFF = 36864;
struct KVFrag { bf16x8 k[4][2]; bf16x8 v[4][2]; };

struct TileSrc { const bf16_t* kbase; size_t krs; const bf16_t* vbase; size_t vrs; };
template <bool WITH_V>
DEV void stage_load(u32x4 (&r)[4], const TileSrc& ts, int pos, int tid) {
#pragma unroll
  for (int i = 0; i < 2; ++i) {
    const int c = tid + 256 * i, row = c >> 3, ch = c & 7;
    r[i] = *(const u32x4*)(ts.kbase + (size_t)(pos + row) * ts.krs + ch * 8);
    if (WITH_V) r[2 + i] = *(const u32x4*)(ts.vbase + (size_t)row * ts.vrs + pos + ch * 8);
  }
}
template <bool WITH_V>
DEV void stage_store(bf16_t* tb, const u32x4 (&r)[4], int tid) {
#pragma unroll
  for (int i = 0; i < 2; ++i) {
    const int c = tid + 256 * i, row = c >> 3, ch = c & 7;
    *(u32x4*)(tb + row * TL + ch * 8) = r[i];
    if (WITH_V) *(u32x4*)(tb + 64 * TL + row * TL + ch * 8) = r[2 + i];
  }
}
DEV void lds_k(KVFrag& f, const bf16_t* tb, int lr, int quad) {
#pragma unroll
  for (int mt = 0; mt < 4; ++mt)
#pragma unroll
    for (int ks = 0; ks < 2; ++ks) f.k[mt][ks] = ld8(tb + (mt * 16 + lr) * TL + ks * 32 + quad * 8);
}
DEV void lds_v(KVFrag& f, const bf16_t* tb, int lr, int quad) {
#pragma unroll
  for (int dt = 0; dt < 4; ++dt)
#pragma unroll
    for (int hf = 0; hf < 2; ++hf) {
      const bf16_t* vp = tb + 64 * TL + (dt * 16 + lr) * TL + hf * 32 + quad * 4;
      const u32x2 lo = *(const u32x2*)vp, hi = *(const u32x2*)(vp + 16);
      f.v[dt][hf] = as_bf8((u32x4){lo[0], lo[1], hi[0], hi[1]});
    }
}
template <bool WITH_V, class NextFn, class ProcFn>
DEV void tile_loop(char* lds, int tid, const TileSrc& ts, NextFn next, ProcFn proc) {
  int cur = next();
  if (cur < 0) return;
  int n1 = next(), n2 = n1 >= 0 ? next() : -1;
  u32x4 r0[4], r1[4];
  stage_load<WITH_V>(r0, ts, cur, tid);
  stage_store<WITH_V>((bf16_t*)(lds + NSA_TILE_OFF), r0, tid);
  stage_load<WITH_V>(r0, ts, n1 >= 0 ? n1 : cur, tid);
  stage_load<WITH_V>(r1, ts, n2 >= 0 ? n2 : cur, tid);
  __syncthreads();
  while (true) {
    proc(cur, (const bf16_t*)(lds + NSA_TILE_OFF));
    stage_store<WITH_V>((bf16_t*)(lds + NSA_TILE_OFF + TILE_BUF_BYTES), r0, tid);
    const int n3 = n2 >= 0 ? next() : -1;
    stage_load<WITH_V>(r0, ts, n3 >= 0 ? n3 : cur, tid);
    __syncthreads();
    if (n1 < 0) break;
    proc(n1, (const bf16_t*)(lds + NSA_TILE_OFF + TILE_BUF_BYTES));
    stage_store<WITH_V>((bf16_t*)(lds + NSA_TILE_OFF), r1, tid);
    const int n4 = n3 >= 0 ? next() : -1;
    stage_load<WITH_V>(r1, ts, n4 >= 0 ? n4 : cur, tid);
    __syncthreads();
    if (n2 < 0) break;
    cur = n2; n1 = n3; n2 = n4;
  }
}

DEV void qk_tile(f32x4 (&s)[4][NQT], const KVFrag& f, const bf16x8 (&qf)[NQT][2]) {
#pragma unroll
  for (int mt = 0; mt < 4; ++mt)
#pragma unroll
    for (int nt = 0; nt < NQT; ++nt) {
      s[mt][nt] = mfma16(f.k[mt][0], qf[nt][0], (f32x4){0.f, 0.f, 0.f, 0.f});
      s[mt][nt] = mfma16(f.k[mt][1], qf[nt][1], s[mt][nt]);
    }
}
DEV void pv_tile(AttnSt& st, const KVFrag& f, const bf16x8 (&pb)[NQT][2]) {
#pragma unroll
  for (int dt = 0; dt < 4; ++dt)
#pragma unroll
    for (int hf = 0; hf < 2; ++hf)
#pragma unroll
      for (int nt = 0; nt < NQT; ++nt) st.o[dt][nt] = mfma16(f.v[dt][hf], pb[nt][hf], st.o[dt][nt]);
}

DEV void attn_tile(AttnSt& st, const bf16x8 (&qf)[NQT][2], const bf16_t* tb, int rel0, int lr, const unsigned (&selbit)[NQT], int maxdist,
                   bool need_mask, float c1, float slope2, int quad) {
  KVFrag f;
  lds_k(f, tb, lr, quad);
  f32x4 s[4][NQT];
  qk_tile(s, f, qf);
  lds_v(f, tb, lr, quad);
  const float b0 = slope2 * (float)(rel0 + quad * 4);
  float smaxv[NQT];
#pragma unroll
  for (int nt = 0; nt < NQT; ++nt) smaxv[nt] = -1e30f;
  float rbv = b0;
  const float step13 = slope2 * 13.0f;
#pragma unroll
  for (int mt = 0; mt < 4; ++mt)
#pragma unroll
    for (int r = 0; r < 4; ++r) {
      if (r > 0) rbv += slope2; else if (mt > 0) rbv += step13;
#pragma unroll
      for (int nt = 0; nt < NQT; ++nt) {
        const float v = fmaf(s[mt][nt][r], c1, rbv);
        s[mt][nt][r] = v;
        smaxv[nt] = fmaxf(smaxv[nt], v);
      }
    }
  if (need_mask) {
#pragma unroll
    for (int nt = 0; nt < NQT; ++nt) {
      float mx = -1e30f;
      const int dq = lr + nt * 16 - rel0 - quad * 4;
#pragma unroll
      for (int mt = 0; mt < 4; ++mt)
#pragma unroll
        for (int r = 0; r < 4; ++r) {
          const int dist = dq - (mt * 16 + r);
          const bool valid = selbit[nt] && dist >= 0 && dist <= maxdist;
          const float v = valid ? s[mt][nt][r] : -1e30f;
          s[mt][nt][r] = v;
          mx = fmaxf(mx, v);
        }
      smaxv[nt] = mx;
    }
  } else {
#pragma unroll
    for (int nt = 0; nt < NQT; ++nt) smaxv[nt] = selbit[nt] ? smaxv[nt] : -1e30f;
  }
  bf16x8 pb[NQT][2];
#pragma unroll
  for (int nt = 0; nt < NQT; ++nt) {
    float smax = smaxv[nt];
    smax = fmaxf(smax, __shfl_xor(smax, 16));
    smax = fmaxf(smax, __shfl_xor(smax, 32));
    const float mnew = fmaxf(st.m[nt], smax);
    const float alpha = ex2(st.m[nt] - mnew);
    st.m[nt] = mnew;
    const float mref = selbit[nt] ? fmaxf(mnew, -1e20f) : 1e30f;
    float ls = 0.f;
    float pv[4][4];
#pragma unroll
    for (int mt = 0; mt < 4; ++mt)
#pragma unroll
      for (int r = 0; r < 4; ++r) { const float e = ex2(s[mt][nt][r] - mref); pv[mt][r] = e; ls += e; }
    st.l[nt] = st.l[nt] * alpha + ls;
#pragma unroll
    for (int hf = 0; hf < 2; ++hf)
      pb[nt][hf] = as_bf8((u32x4){pk_bf16(pv[2 * hf][0], pv[2 * hf][1]), pk_bf16(pv[2 * hf][2], pv[2 * hf][3]),
                                  pk_bf16(pv[2 * hf + 1][0], pv[2 * hf + 1][1]), pk_bf16(pv[2 * hf + 1][2], pv[2 * hf + 1][3])});
#pragma unroll
    for (int dt = 0; dt < 4; ++dt) st.o[dt][nt] = st.o[dt][nt] * alpha;
  }
  pv_tile(st, f, pb);
}

DEV void cmp_scores(f32x4 (&s)[4][NQT], int n0, int t0, int lr, int quad, float c1, float slope2, bool full) {
  float rbv = slope2 * (float)(16 * (n0 + quad * 4) + 31 - t0);
  const float step16 = slope2 * 16.0f, step208 = slope2 * 208.0f;
#pragma unroll
  for (int mt = 0; mt < 4; ++mt)
#pragma unroll
    for (int r = 0; r < 4; ++r) {
      if (r > 0) rbv += step16; else if (mt > 0) rbv += step208;
      const int rel = 16 * (n0 + mt * 16 + quad * 4 + r) + 31 - t0;
#pragma unroll
      for (int nt = 0; nt < NQT; ++nt) {
        float v = fmaf(s[mt][nt][r], c1, rbv);
        if (!full) v = (rel <= lr + nt * 16) ? v : -1e30f;
        s[mt][nt][r] = v;
      }
    }
}

DEV void nsa_unit(const Params& p, int u, char* lds) {
  const int tid = opaque_tid(), lane = tid & 63, w = tid >> 6, lr = lane & 15, quad = lane >> 4;
  const int q32 = u & 255, g = (u >> 8) & 3, b = u >> 10;
  const int h = g * 4 + w, t0 = q32 * 32, qb = t0 >> 6;
  const size_t tokbase = (size_t)b * S;
  float* imp = (float*)lds;
  float* stash = (float*)lds;
  unsigned* selmask = (unsigned*)(lds + 32768);
  unsigned* unionm = (unsigned*)(lds + 32768 + 512);
  const float slope = ex2(-0.5f * (float)(h + 1));
  const float slope2 = slope * LOG2E, c1 = 0.125f * LOG2E;
  const int tq0 = t0 + lr;
  const float skipd = 200.0f / slope2;
  const float skipd_g = 200.0f / (ex2(-0.5f * (float)(g * 4 + 4)) * LOG2E);

  for (int i = tid; i < 32 * 129; i += 256) imp[i] = 0.f;
  if (tid < 4) unionm[tid] = 0u;
  bf16x8 qf[NQT][2];
#pragma unroll
  for (int nt = 0; nt < NQT; ++nt)
#pragma unroll
    for (int ks = 0; ks < 2; ++ks) qf[nt][ks] = ld8(p.Y + (tokbase + tq0 + nt * 16) * LDY + C_QA + h * 64 + ks * 32 + quad * 8);
  __syncthreads();
  auto gate = [&](int nt, int br) -> float {
    const bf16_t* gp = p.Y + (tokbase + tq0 + nt * 16) * LDY + C_GA + h * 3 + br;
    asm volatile("" : "+v"(gp));
    return sigmoidf_(bf2f(*gp));
  };

  AttnSt st;
  int nmax = t0 / 16;
  if (nmax > 510) nmax = 510;
  TileSrc tsc;
  tsc.kbase = p.Kc + (size_t)(b * 4 + g) * 512 * 64; tsc.krs = 64;
  tsc.vbase = p.VcT + (size_t)(b * 4 + g) * 64 * 512; tsc.vrs = 512;
  float m1[NQT], l1[NQT];
#pragma unroll
  for (int nt = 0; nt < NQT; ++nt) { m1[nt] = -1e30f; l1[nt] = 0.f; }
  int nstart = 0;
  while (nstart + 64 <= nmax && (float)(t0 - (16 * (nstart + 63) + 31)) > skipd_g) nstart += 64;
  {
    int nn = nstart;
    tile_loop<false>(lds, tid, tsc, [&]() -> int { const int r = nn <= nmax ? nn : -1; nn += 64; return r; },
      [&](int n0, const bf16_t* tb) {
        if ((float)(t0 - (16 * (n0 + 63) + 31)) > skipd) return;
        KVFrag f;
        lds_k(f, tb, lr, quad);
        f32x4 s[4][NQT];
        qk_tile(s, f, qf);
        const bool full = 16 * (n0 + 63) + 31 <= t0;
        if (full) cmp_scores(s, n0, t0, lr, quad, c1, slope2, true); else cmp_scores(s, n0, t0, lr, quad, c1, slope2, false);
#pragma unroll
        for (int nt = 0; nt < NQT; ++nt) {
          float smax = -1e30f;
#pragma unroll
          for (int mt = 0; mt < 4; ++mt)
#pragma unroll
            for (int r = 0; r < 4; ++r) smax = fmaxf(smax, s[mt][nt][r]);
          smax = fmaxf(smax, __shfl_xor(smax, 16));
          smax = fmaxf(smax, __shfl_xor(smax, 32));
          const float mnew = fmaxf(m1[nt], smax);
          const float mref = fmaxf(mnew, -1e20f);
          float ls = 0.f;
#pragma unroll
          for (int mt = 0; mt < 4; ++mt)
#pragma unroll
            for (int r = 0; r < 4; ++r) ls += ex2(s[mt][nt][r] - mref);
          l1[nt] = l1[nt] * ex2(m1[nt] - mnew) + ls;
          m1[nt] = mnew;
        }
      });
  }
  float il1[NQT];
#pragma unroll
  for (int nt = 0; nt < NQT; ++nt) {
    float l = l1[nt];
    l += __shfl_xor(l, 16); l += __shfl_xor(l, 32);
    il1[nt] = l > 0.f ? 1.0f / l : 0.f;
  }
  attn_reset(st);
  {
    int nn = nstart;
    tile_loop<true>(lds, tid, tsc, [&]() -> int { const int r = nn <= nmax ? nn : -1; nn += 64; return r; },
      [&](int n0, const bf16_t* tb) {
        if ((float)(t0 - (16 * (n0 + 63) + 31)) > skipd) return;
        KVFrag f;
        lds_k(f, tb, lr, quad);
        f32x4 s[4][NQT];
        qk_tile(s, f, qf);
        lds_v(f, tb, lr, quad);
        {
          const bool full = 16 * (n0 + 63) + 31 <= t0;
          if (full) cmp_scores(s, n0, t0, lr, quad, c1, slope2, true); else cmp_scores(s, n0, t0, lr, quad, c1, slope2, false);
        }
        bf16x8 pb[NQT][2];
#pragma unroll
        for (int nt = 0; nt < NQT; ++nt) {
          const float mref = fmaxf(m1[nt], -1e20f);
          float pv[4][4];
#pragma unroll
          for (int mt = 0; mt < 4; ++mt) {
#pragma unroll
            for (int r = 0; r < 4; ++r) pv[mt][r] = ex2(s[mt][nt][r] - mref) * il1[nt];
            const int msel = (n0 + mt * 16 + quad * 4) >> 2;
            const float s4 = (pv[mt][0] + pv[mt][1]) + (pv[mt][2] + pv[mt][3]);
            float* ip = imp + (nt * 16 + lr) * 129 + msel;
            if (s4 != 0.f) {
              atomicAdd(ip, s4);
              if (msel + 1 < 128 && pv[mt][3] != 0.f) atomicAdd(ip + 1, pv[mt][3]);
            }
          }
#pragma unroll
          for (int hf = 0; hf < 2; ++hf)
            pb[nt][hf] = as_bf8((u32x4){pk_bf16(pv[2 * hf][0], pv[2 * hf][1]), pk_bf16(pv[2 * hf][2], pv[2 * hf][3]),
                                        pk_bf16(pv[2 * hf + 1][0], pv[2 * hf + 1][1]), pk_bf16(pv[2 * hf + 1][2], pv[2 * hf + 1][3])});
        }
        pv_tile(st, f, pb);
      });
  }
  {
    unsigned um0 = 0, um1 = 0, um2 = 0, um3 = 0;
    for (int qi = 0; qi < 8; ++qi) {
      const int q = w * 8 + qi;
      unsigned key[2];
#pragma unroll
      for (int j = 0; j < 2; ++j) {
        const int m = lane + 64 * j;
        const float v = imp[q * 129 + m];
        unsigned k = (__float_as_uint(v) & 0xffffff80u) + 0x80u + (unsigned)(127 - m);
        if (m == 0 || m == qb || m + 1 == qb) k = 0x7f000000u + (unsigned)(127 - m);
        if (m > qb) k = 0u;
        key[j] = k;
      }
      unsigned thr = 0u;
#pragma unroll 1
      for (int bit = 30; bit >= 0; --bit) {
        const unsigned cand = thr | (1u << bit);
        const int cnt = __popcll(__ballot(key[0] >= cand)) + __popcll(__ballot(key[1] >= cand));
        if (cnt >= 16) thr = cand;
      }
      const bool sel0 = key[0] >= thr && key[0] != 0u, sel1 = key[1] >= thr && key[1] != 0u;
      const unsigned long long b0 = __ballot(sel0), b1 = __ballot(sel1);
      const unsigned w0 = (unsigned)b0, w1 = (unsigned)(b0 >> 32), w2 = (unsigned)b1, w3 = (unsigned)(b1 >> 32);
      if (lane == 0) { selmask[q * 4 + 0] = w0; selmask[q * 4 + 1] = w1; selmask[q * 4 + 2] = w2; selmask[q * 4 + 3] = w3; }
      um0 |= w0; um1 |= w1; um2 |= w2; um3 |= w3;
    }
    if (lane == 0) { atomicOr(&unionm[0], um0); atomicOr(&unionm[1], um1); atomicOr(&unionm[2], um2); atomicOr(&unionm[3], um3); }
  }
  __syncthreads();
#pragma unroll
  for (int nt = 0; nt < NQT; ++nt) {
    const float g0 = gate(nt, 0);
#pragma unroll
    for (int dt = 0; dt < 4; ++dt)
#pragma unroll
      for (int r = 0; r < 4; ++r) stash[((dt * NQT + nt) * 4 + r) * 256 + tid] = g0 * st.o[dt][nt][r];
  }

  attn_reset(st);
  {
    TileSrc ts;
    ts.kbase = p.Y + tokbase * LDY + C_KS + g * 64; ts.krs = LDY;
    ts.vbase = p.YT + (size_t)(R_VS + g * 64) * LDT + tokbase; ts.vrs = LDT;
    const unsigned u0 = unionm[0], u1 = unionm[1], u2 = unionm[2], u3 = unionm[3];
    int wd = 0;
    unsigned um = u0;
    tile_loop<true>(lds, tid, ts,
      [&]() -> int {
        for (;;) {
          while (um == 0u && wd < 3) { ++wd; um = wd == 1 ? u1 : (wd == 2 ? u2 : u3); }
          if (um == 0u) return -1;
          const int bit = __builtin_ctz(um);
          um &= um - 1;
          const int pos = (wd * 32 + bit) * 64;
          if ((float)(t0 - pos - 63) <= skipd_g) return pos;
        }
      },
      [&](int pos0, const bf16_t* tb) {
        if ((float)(t0 - pos0 - 63) > skipd) return;
        const int m = pos0 >> 6;
        unsigned selbit[NQT];
#pragma unroll
        for (int nt = 0; nt < NQT; ++nt) selbit[nt] = (selmask[(nt * 16 + lr) * 4 + (m >> 5)] >> (m & 31)) & 1u;
        attn_tile(st, qf, tb, pos0 - t0, lr, selbit, 1 << 30, m >= qb, c1, slope2, quad);
      });
  }
#pragma unroll
  for (int nt = 0; nt < NQT; ++nt) {
    float l = st.l[nt];
    l += __shfl_xor(l, 16); l += __shfl_xor(l, 32);
    const float f = gate(nt, 1) / l;
#pragma unroll
    for (int dt = 0; dt < 4; ++dt)
#pragma unroll
      for (int r = 0; r < 4; ++r) stash[((dt * NQT + nt) * 4 + r) * 256 + tid] += f * st.o[dt][nt][r];
  }
  attn_reset(st);
  {
    unsigned one[NQT];
#pragma unroll
    for (int nt = 0; nt < NQT; ++nt) one[nt] = 1u;
    int pstart = (t0 - 512) & ~63;
    if (pstart < 0) pstart = 0;
    TileSrc ts;
    ts.kbase = p.Y + tokbase * LDY + C_KW + g * 64; ts.krs = LDY;
    ts.vbase = p.YT + (size_t)(R_VW + g * 64) * LDT + tokbase; ts.vrs = LDT;
    int pp = pstart;
    tile_loop<true>(lds, tid, ts, [&]() -> int { const int r = pp < t0 + 32 ? pp : -1; pp += 64; return r; },
      [&](int pos0, const bf16_t* tb) {
        const int rel0 = pos0 - t0;
        if ((float)(-rel0 - 63) > skipd) return;
        attn_tile(st, qf, tb, rel0, lr, one, 511, !(rel0 + 63 <= 0 && rel0 >= 31 - 511), c1, slope2, quad);
      });
  }
#pragma unroll
  for (int nt = 0; nt < NQT; ++nt) {
    float l = st.l[nt];
    l += __shfl_xor(l, 16); l += __shfl_xor(l, 32);
    const float f = gate(nt, 2) / l;
    float ss = 0.f;
#pragma unroll
    for (int dt = 0; dt < 4; ++dt)
#pragma unroll
      for (int r = 0; r < 4; ++r) {
        const float v = stash[((dt * NQT + nt) * 4 + r) * 256 + tid] + f * st.o[dt][nt][r];
        st.o[dt][nt][r] = v;
        ss += v * v;
      }
    ss += __shfl_xor(ss, 16); ss += __shfl_xor(ss, 32);
    const float rstd = rsqrtf(ss * (1.0f / 64.0f) + 1e-6f);
#pragma unroll
    for (int dt = 0; dt < 4; ++dt) {
      const int d = dt * 16 + quad * 4;
      const f32x4 gn = *(const f32x4*)(p.g_nsa + h * 64 + d);
      *(u32x2*)(p.Omix + (tokbase + tq0 + nt * 16) * D + h * 64 + d) =
          (u32x2){pk_bf16(st.o[dt][nt][0] * rstd * gn[0], st.o[dt][nt][1] * rstd * gn[1]),
                  pk_bf16(st.o[dt][nt][2] * rstd * gn[2], st.o[dt][nt][3] * rstd * gn[3])};
    }
  }
  __syncthreads();
}

DEV void publish_unit(unsigned* cnt) {
  asm volatile("s_waitcnt vmcnt(0)" ::: "memory");
  __syncthreads();
  if (threadIdx.x == 0) {
    __builtin_amdgcn_fence(__ATOMIC_RELEASE, "agent");
    asm volatile("s_waitcnt vmcnt(0)" ::: "memory");
    __hip_atomic_fetch_add(cnt, 1u, __ATOMIC_RELAXED, __HIP_MEMORY_SCOPE_AGENT);
  }
}
DEV void phase5(const Params& p, char* lds, int GP, unsigned* ready_cnt) {
  const int bid = blockIdx.x;
  if (bid >= GP) return;
  for (int r = 0; r * GP < 6144; ++r) {
    const int v = r * GP + ((r & 1) ? GP - 1 - bid : bid);
    if (v >= 6144) continue;
    const int step = v / 24, within = v - step * 24, q32 = 255 - step, chunk = q32 >> 2;
    if (within < 16) {
      const int bb = within >> 2;
      nsa_unit(p, (bb << 10) | ((within & 3) << 8) | q32, lds);
      publish_unit(ready_cnt + 16 * (bb * 64 + chunk));
    } else {
      const int j = (step & 3) * 8 + (within - 16), bb = j >> 3, hh = j & 7;
      ret_out_unit(p, (bb << 9) | (hh << 6) | chunk);
      publish_unit(ready_cnt + 16 * (bb * 64 + chunk));
    }
  }
}

DEV int order_key(float v, int idx) {
  int bits = __float_as_int(v);
  bits ^= (bits >> 31) & 0x7fffffff;
  return (bits & ~0x7f) | (127 - idx);
}
DEV float key_val(int key) {
  int bits = key & ~0x7f;
  bits ^= (bits >> 31) & 0x7fffffff;
  return __int_as_float(bits);
}

DEV void peer_unit(const Params& p, int u, char* lds) {
  const int tid = opaque_tid(), lane = tid & 63, w = tid >> 6, lr = lane & 15, quad = lane >> 4;
  const int t0 = u * 16;
  int* sc = (int*)lds;
  int* tk = (int*)(lds + 16384);
  float* cval = (float*)(lds + 18432);
  int* exi = (int*)(lds + 22528);
  float* exg = (float*)(lds + 30720);
  for (int h = 0; h < 8; ++h) {
    {
      const int pp = w >> 1, nt0 = (w & 1) * 4;
      bf16x8 af[4];
#pragma unroll
      for (int ks = 0; ks < 4; ++ks) af[ks] = ld8(p.Qp + (size_t)(t0 + lr) * D + h * 256 + pp * 128 + ks * 32 + quad * 8);
#pragma unroll
      for (int nn = 0; nn < 4; ++nn) {
        const int nt = nt0 + nn;
        f32x4 acc = (f32x4){0.f, 0.f, 0.f, 0.f};
#pragma unroll
        for (int ks = 0; ks < 4; ++ks)
          acc = mfma16(af[ks], ld8(p.SK + ((size_t)((h * 2 + pp) * 128 + nt * 16 + lr)) * 128 + ks * 32 + quad * 8), acc);
#pragma unroll
        for (int r = 0; r < 4; ++r) sc[(pp * 16 + quad * 4 + r) * 128 + nt * 16 + lr] = order_key(acc[r], nt * 16 + lr);
      }
    }
    __syncthreads();
    for (int rr = 0; rr < 8; rr += 2) {
      const int rowA = w * 8 + rr, rowB = rowA + 1;
      const int a0 = sc[rowA * 128 + lane], a1 = sc[rowA * 128 + 64 + lane], b0 = sc[rowB * 128 + lane], b1 = sc[rowB * 128 + 64 + lane];
      const unsigned ua0 = (unsigned)a0 ^ 0x80000000u, ua1 = (unsigned)a1 ^ 0x80000000u, ub0 = (unsigned)b0 ^ 0x80000000u, ub1 = (unsigned)b1 ^ 0x80000000u;
      unsigned thA = 0u, thB = 0u;
#pragma unroll 1
      for (int bit = 31; bit >= 0; --bit) {
        const unsigned cA = thA | (1u << bit), cB = thB | (1u << bit);
        const int nA = __popcll(__ballot(ua0 >= cA)) + __popcll(__ballot(ua1 >= cA));
        const int nB = __popcll(__ballot(ub0 >= cB)) + __popcll(__ballot(ub1 >= cB));
        if (nA >= 16) thA = cA;
        if (nB >= 16) thB = cB;
      }
      const unsigned long long lt = (1ull << lane) - 1ull;
      {
        const unsigned long long m0 = __ballot(ua0 >= thA), m1 = __ballot(ua1 >= thA);
        if (ua0 >= thA) tk[rowA * 16 + __popcll(m0 & lt)] = a0;
        if (ua1 >= thA) tk[rowA * 16 + __popcll(m0) + __popcll(m1 & lt)] = a1;
      }
      {
        const unsigned long long m0 = __ballot(ub0 >= thB), m1 = __ballot(ub1 >= thB);
        if (ub0 >= thB) tk[rowB * 16 + __popcll(m0 & lt)] = b0;
        if (ub1 >= thB) tk[rowB * 16 + __popcll(m0) + __popcll(m1 & lt)] = b1;
      }
      if (lane < 32) {
        const int row = lane < 16 ? rowA : rowB, me = lane & 15;
        const int4 q0 = *(const int4*)(tk + row * 16), q1 = *(const int4*)(tk + row * 16 + 4), q2 = *(const int4*)(tk + row * 16 + 8), q3 = *(const int4*)(tk + row * 16 + 12);
        const int mine = tk[row * 16 + me];
        const int rank = (q0.x > mine) + (q0.y > mine) + (q0.z > mine) + (q0.w > mine) + (q1.x > mine) + (q1.y > mine) + (q1.z > mine) + (q1.w > mine) +
                         (q2.x > mine) + (q2.y > mine) + (q2.z > mine) + (q2.w > mine) + (q3.x > mine) + (q3.y > mine) + (q3.z > mine) + (q3.w > mine);
        tk[row * 16 + rank] = mine;
      }
    }
    __syncthreads();
    for (int tt = 0; tt < 4; ++tt) {
      const int tok = w * 4 + tt;
      int a = -1, bq = 0;
      {
        int c = lane;
        if (c < 16) { a = 0; bq = c; }
        else if (c < 24) { a = 1; bq = c - 16; }
        else if (c < 29) { a = 2; bq = c - 24; }
        else if (c < 33) { a = 3; bq = c - 29; }
        else if (c < 36) { a = 4; bq = c - 33; }
        else if (c < 38) { a = 5; bq = c - 36; }
        else if (c < 40) { a = 6; bq = c - 38; }
        else if (c < 42) { a = 7; bq = c - 40; }
        else if (c < 50) { a = c - 34; bq = 0; }
      }
      const bool act = a >= 0;
      const int ka = tk[(0 * 16 + tok) * 16 + (act ? a : 0)], kb = tk[(1 * 16 + tok) * 16 + bq];
      const float myv = act ? key_val(ka) + key_val(kb) : -3.0e38f;
      float* cv = cval + tok * 64;
      cv[lane] = myv;
      int rank = 0;
      for (int j = 0; j < 50; ++j) {
        const float vj = cv[j];
        rank += (vj > myv) || (vj == myv && j < lane);
      }
      float mx = act && rank == 0 ? myv : -3.0e38f;
#pragma unroll
      for (int o = 32; o >= 1; o >>= 1) mx = fmaxf(mx, __shfl_xor(mx, o));
      const bool win = act && rank < 16;
      const float ev = win ? __expf(myv - mx) : 0.f;
      const float sum = wave_sum(ev);
      if (win) {
        const int i0 = 127 - (ka & 0x7f), i1 = 127 - (kb & 0x7f);
        exi[tok * 128 + h * 16 + rank] = i0 * 128 + i1;
        exg[tok * 128 + h * 16 + rank] = ev / sum;
      }
    }
    __syncthreads();
  }
  for (int tt = 0; tt < 4; ++tt) {
    const int tok = w * 4 + tt;
    const size_t gt = (size_t)t0 + tok;
    const int b = (int)(gt / S);
    float hf[32];
#pragma unroll
    for (int i = 0; i < 2; ++i)
#pragma unroll
      for (int hh = 0; hh < 2; ++hh) {
        const u32x4 hv = *(const u32x4*)(p.H2 + gt * D + (i * 64 + lane) * 16 + hh * 8);
#pragma unroll
        for (int j = 0; j < 4; ++j) { hf[i * 16 + hh * 8 + 2 * j] = bf_lo(hv[j]); hf[i * 16 + hh * 8 + 2 * j + 1] = bf_hi(hv[j]); }
      }
    auto load_rows = [&](u32x4 (&r)[8], const unsigned char* base, int e0) {
#pragma unroll
      for (int k = 0; k < 4; ++k) {
        const unsigned char* rp = base + (size_t)exi[tok * 128 + e0 + k] * D + lane * 16;
        r[2 * k] = *(const u32x4*)rp; r[2 * k + 1] = *(const u32x4*)(rp + 1024);
      }
    };
    auto dot_rows = [&](const u32x4 (&r)[8], int e0) {
      float sv[4];
#pragma unroll
      for (int k = 0; k < 4; ++k) {
        float sa = 0.f, sb = 0.f;
#pragma unroll
        for (int j = 0; j < 4; ++j) {
          const f32x2v a0 = __builtin_amdgcn_cvt_pk_f32_fp8((int)r[2 * k][j], false), a1 = __builtin_amdgcn_cvt_pk_f32_fp8((int)r[2 * k][j], true);
          const f32x2v b0 = __builtin_amdgcn_cvt_pk_f32_fp8((int)r[2 * k + 1][j], false), b1 = __builtin_amdgcn_cvt_pk_f32_fp8((int)r[2 * k + 1][j], true);
          sa += a0[0] * hf[j * 4 + 0] + a0[1] * hf[j * 4 + 1] + a1[0] * hf[j * 4 + 2] + a1[1] * hf[j * 4 + 3];
          sb += b0[0] * hf[16 + j * 4 + 0] + b0[1] * hf[16 + j * 4 + 1] + b1[0] * hf[16 + j * 4 + 2] + b1[1] * hf[16 + j * 4 + 3];
        }
        sv[k] = sa + sb;
      }
      float r2[2], r1;
      const bool h32 = (lane & 32) != 0, h16 = (lane & 16) != 0;
#pragma unroll
      for (int k = 0; k < 2; ++k) { const float mine = h32 ? sv[k + 2] : sv[k], oth = h32 ? sv[k] : sv[k + 2]; r2[k] = mine + __shfl_xor(oth, 32); }
      { const float mine = h16 ? r2[1] : r2[0], oth = h16 ? r2[0] : r2[1]; r1 = mine + __shfl_xor(oth, 16); }
      r1 += __shfl_xor(r1, 8); r1 += __shfl_xor(r1, 4); r1 += __shfl_xor(r1, 2); r1 += __shfl_xor(r1, 1);
      if ((lane & 15) == 0) {
        const int k = (h32 ? 2 : 0) + (h16 ? 1 : 0);
        const int ei = tok * 128 + e0 + k;
        exg[ei] = exg[ei] * gelu_tanh(r1 * (1.0f / U8_SCALE)) * (1.0f / V8_SCALE);
      }
    };
    u32x4 ra[8], rb[8];
    load_rows(ra, p.U8, 0);
#pragma unroll 1
    for (int e0 = 0; e0 < 128; e0 += 8) {
      load_rows(rb, p.U8, e0 + 4);
      dot_rows(ra, e0);
      load_rows(ra, p.U8, e0 + 8 < 128 ? e0 + 8 : 124);
      dot_rows(rb, e0 + 4);
    }
    float oacc[32];
#pragma unroll
    for (int i = 0; i < 32; ++i) oacc[i] = 0.f;
    auto acc_rows = [&](const u32x4 (&r)[8], int e0) {
#pragma unroll
      for (int k = 0; k < 4; ++k) {
        const float coef = exg[tok * 128 + e0 + k];
#pragma unroll
        for (int j = 0; j < 4; ++j) {
          const f32x2v a0 = __builtin_amdgcn_cvt_pk_f32_fp8((int)r[2 * k][j], false), a1 = __builtin_amdgcn_cvt_pk_f32_fp8((int)r[2 * k][j], true);
          const f32x2v b0 = __builtin_amdgcn_cvt_pk_f32_fp8((int)r[2 * k + 1][j], false), b1 = __builtin_amdgcn_cvt_pk_f32_fp8((int)r[2 * k + 1][j], true);
          oacc[j * 4 + 0] += coef * a0[0]; oacc[j * 4 + 1] += coef * a0[1]; oacc[j * 4 + 2] += coef * a1[0]; oacc[j * 4 + 3] += coef * a1[1];
          oacc[16 + j * 4 + 0] += coef * b0[0]; oacc[16 + j * 4 + 1] += coef * b0[1]; oacc[16 + j * 4 + 2] += coef * b1[0]; oacc[16 + j * 4 + 3] += coef * b1[1];
        }
      }
    };
    load_rows(ra, p.V8, 0);
#pragma unroll 1
    for (int e0 = 0; e0 < 128; e0 += 8) {
      load_rows(rb, p.V8, e0 + 4);
      acc_rows(ra, e0);
      load_rows(ra, p.V8, e0 + 8 < 128 ? e0 + 8 : 124);
      acc_rows(rb, e0 + 4);
    }
    const float* g2 = p.mod + (size_t)b * 12288 + 5 * D;
    float ss = 0.f;
#pragma unroll
    for (int i = 0; i < 2; ++i)
#pragma unroll
      for (int q4 = 0; q4 < 4; ++q4) {
        const int col = (i * 64 + lane) * 16 + q4 * 4;
        const f32x4 x1 = *(const f32x4*)(p.X1 + gt * D + col), gg = *(const f32x4*)(g2 + col);
#pragma unroll
        for (int j = 0; j < 4; ++j) {
          const float v = x1[j] + gg[j] * oacc[i * 16 + q4 * 4 + j];
          oacc[i * 16 + q4 * 4 + j] = v;
          ss += v * v;
        }
      }
    ss = wave_sum(ss);
    const float rstd = rsqrtf(ss * (1.0f / D) + 1e-6f);
#pragma unroll
    for (int i = 0; i < 2; ++i)
#pragma unroll
      for (int q4 = 0; q4 < 4; ++q4) {
        const int col = (i * 64 + lane) * 16 + q4 * 4;
        const f32x4 gf = *(const f32x4*)(p.g_final + col);
        f32x4 o;
#pragma unroll
        for (int j = 0; j < 4; ++j) o[j] = oacc[i * 16 + q4 * 4 + j] * rstd * gf[j];
        *(f32x4*)(p.out + gt * D + col) = o;
      }
  }
  __syncthreads();
}

DEV void phase9(const Params& p, char* lds) {
  for (int u = blockIdx.x; u < T / 16; u += gridDim.x) peer_unit(p, u, lds);
}
DEV void phase9_dynamic(const Params& p, char* lds, unsigned* unit_cnt, unsigned* panel_cnt) {
  int* slot = (int*)(lds + LDS_BYTES - 16);
  for (;;) {
    __syncthreads();
    if (threadIdx.x == 0) {
      const int u = (int)__hip_atomic_fetch_add(unit_cnt, 1u, __ATOMIC_RELAXED, __HIP_MEMORY_SCOPE_AGENT);
      if (u < T / 16) {
        while (__hip_atomic_load(panel_cnt + 16 * (u >> 3), __ATOMIC_RELAXED, __HIP_MEMORY_SCOPE_AGENT) < 16u) __builtin_amdgcn_s_sleep(8);
        __builtin_amdgcn_fence(__ATOMIC_ACQUIRE, "agent");
        asm volatile("s_waitcnt vmcnt(0)" ::: "memory");
      }
      *slot = u;
    }
    __syncthreads();
    const int u = *slot;
    if (u >= T / 16) break;
    peer_unit(p, u, lds);
  }
}

DEV void gbar(unsigned* bar, unsigned& gen) {
  asm volatile("s_waitcnt vmcnt(0) lgkmcnt(0)" ::: "memory");
  __syncthreads();
  gen += 1u;
  if (threadIdx.x == 0) {
    __builtin_amdgcn_fence(__ATOMIC_RELEASE, "agent");
    asm volatile("s_waitcnt vmcnt(0)" ::: "memory");
    const unsigned G = gridDim.x, bidx = blockIdx.x;
    if ((G & 63u) == 0u) {
      const unsigned x = bidx & 7u, j = bidx >> 3, n2 = G >> 6;
      unsigned* c1 = bar + 64 * (x * 8 + (j >> 3));
      unsigned* c2 = bar + 64 * (64 + x);
      unsigned* c3 = bar + 64 * 72;
      unsigned* flag = bar + 64 * (73 + x);
      if (__hip_atomic_fetch_add(c1, 1u, __ATOMIC_RELAXED, __HIP_MEMORY_SCOPE_AGENT) + 1u == gen * 8u)
        if (__hip_atomic_fetch_add(c2, 1u, __ATOMIC_RELAXED, __HIP_MEMORY_SCOPE_AGENT) + 1u == gen * n2)
          if (__hip_atomic_fetch_add(c3, 1u, __ATOMIC_RELAXED, __HIP_MEMORY_SCOPE_AGENT) + 1u == gen * 8u)
            for (unsigned k = 0; k < 8u; ++k) __hip_atomic_store(bar + 64 * (73 + k), gen, __ATOMIC_RELAXED, __HIP_MEMORY_SCOPE_AGENT);
      while (__hip_atomic_load(flag, __ATOMIC_RELAXED, __HIP_MEMORY_SCOPE_AGENT) < gen) __builtin_amdgcn_s_sleep(2);
    } else {
      unsigned* c = bar + 64 * 72;
      __hip_atomic_fetch_add(c, 1u, __ATOMIC_RELAXED, __HIP_MEMORY_SCOPE_AGENT);
      while (__hip_atomic_load(c, __ATOMIC_RELAXED, __HIP_MEMORY_SCOPE_AGENT) < gen * G) __builtin_amdgcn_s_sleep(2);
    }
    __builtin_amdgcn_fence(__ATOMIC_ACQUIRE, "agent");
    asm volatile("s_waitcnt vmcnt(0)" ::: "memory");
  }
  __syncthreads();
}

__global__ void __launch_bounds__(256, 2) mega(Params p_unused) {
  __shared__ __attribute__((aligned(16))) char lds[LDS_BYTES];
  cg::grid_group grid = cg::this_grid();
  const Params& p = *(const Params*)__builtin_amdgcn_kernarg_segment_ptr();
  const int lo = p.ph_lo, hi = p.ph_hi;
  unsigned gen = 0u;
  if (hi > lo) grid.sync();
#ifndef ONLY
#define ONLY -1
#endif
#ifndef REP
#define REP -1
#endif
#define PH_ON(n) ((ONLY < 0 || ONLY == (n)) && lo <= (n) && (n) <= hi)
#define RP(n) for (int rep_ = 0; rep_ < ((REP == (n)) ? 2 : 1); ++rep_)
#define SYNC_AFTER(n) if (lo <= (n) && (n) < hi) gbar(p.bar, gen);
  if (PH_ON(0)) RP(0) phase0(p, lds);
  SYNC_AFTER(0)
  if (PH_ON(1)) phase1(p);
  SYNC_AFTER(1)
  if (PH_ON(2)) RP(2) rms_mod_phase(p.x, p.g_mix, p.mod, 0, 1, p.H);
  SYNC_AFTER(2)
  if (PH_ON(3)) RP(3) { Epi1 e{p.Y, p.YT}; gemm_phase(p.H, p.WinT, T, LDY, D, lds, e); conv_drain(p, lds); }
  SYNC_AFTER(3)
  if (PH_ON(4)) RP(4) phase4(p, lds);
  SYNC_AFTER(4)
  if (PH_ON(5)) {
    const int G = gridDim.x, NC = G >= 512 ? 64 : 0;
    unsigned* ready = p.bar + 12288;
    phase5(p, lds, G - NC, ready);
    Epi2 e{p.x, p.mod, p.X1};
    gemm_phase(p.Omix, p.WoutT, T, D, D, lds, e, 0, nullptr, p.bar + 64 * 102, ready, 24u);
  }
  SYNC_AFTER(6)
  if (PH_ON(7)) RP(7) rms_mod_phase(p.X1, p.g_ffn, p.mod, 3, 4, p.H2);
  SYNC_AFTER(7)
  if (PH_ON(8)) {
    Epi3 e{p.Qp};
    unsigned* panel_cnt = p.bar + 8192;
    gemm_phase(p.H2, p.WqT, T, D, D, lds, e, (int)gridDim.x >= 256 ? 128 : (int)gridDim.x, panel_cnt);
    phase9_dynamic(p, lds, p.bar + 64 * 101, panel_cnt);
  }
}

extern "C" void kernel_launch(void* const* d_in, const int* in_sizes, int n_in, void* d_out, int out_size, void* d_ws, size_t ws_size,
                              hipStream_t stream) {
  static int grid_blocks = 0;
  if (!grid_blocks) {
    int dev = 0, cus = 0, per_cu = 0;
    (void)hipGetDevice(&dev);
    (void)hipDeviceGetAttribute(&cus, hipDeviceAttributeMultiprocessorCount, dev);
    (void)hipOccupancyMaxActiveBlocksPerMultiprocessor(&per_cu, mega, 256, 0);
    if (per_cu < 1) per_cu = 1;
    if (per_cu > 2) per_cu = 2;
    grid_blocks = cus * per_cu;
  }
  Params p;
  memset(&p, 0, sizeof(p));
  const float* const* in = (const float* const*)d_in;
  p.x = in[0]; p.c = in[1]; p.w_ada = in[2]; p.b_ada = in[3]; p.g_mix = in[4]; p.g_ffn = in[5]; p.g_final = in[6]; p.w_in = in[7];
  p.pe_k = in[8]; p.pe_v = in[9]; p.ck_w1 = in[10]; p.ck_w2 = in[11]; p.cv_w1 = in[12]; p.cv_w2 = in[13]; p.g_nsa = in[14];
  p.g_ret = in[15]; p.w_out = in[16]; p.w_q = in[17]; p.sub_keys = in[18]; p.peer_u = in[19]; p.peer_v = in[20];
  p.out = (float*)d_out;
  char* ws = (char*)d_ws;
  size_t off = 0;
  auto take = [&](size_t bytes) { char* r = ws + off; off += (bytes + 255) & ~(size_t)255; return r; };
  p.bar = (unsigned*)take(65536);
  p.mod_part = (float*)take((size_t)16 * 4 * 12288 * 4);
  p.mod = (float*)take((size_t)4 * 12288 * 4);
  p.cbias = (float*)take((size_t)2 * 32 * 128 * 4);
  p.WinT = (bf16_t*)take((size_t)LDY * 2048 * 2);
  p.WoutT = (bf16_t*)take((size_t)2048 * 2048 * 2);
  p.WqT = (bf16_t*)take((size_t)2048 * 2048 * 2);
  p.SK = (bf16_t*)take((size_t)8 * 2 * 128 * 128 * 2);
  p.U8 = (unsigned char*)take((size_t)16384 * 2048);
  p.V8 = (unsigned char*)take((size_t)16384 * 2048);
  p.w1T = (bf16_t*)take((size_t)2 * 128 * 2048 * 2);
  p.w2T = (bf16_t*)take((size_t)2 * 64 * 128 * 2);
  p.Kc = (bf16_t*)take((size_t)16 * 512 * 64 * 2);
  p.VcT = (bf16_t*)take((size_t)16 * 64 * 512 * 2);
  p.RT = (bf16_t*)take((size_t)32 * 64 * 16384 * 2);
  p.H = (bf16_t*)take((size_t)T * D * 2);
  p.Omix = p.H;
  p.Y = (bf16_t*)take((size_t)T * LDY * 2);
  p.X1 = (float*)d_out;
  p.H2 = (bf16_t*)p.Y;
  p.YT = (bf16_t*)take((size_t)NYT * LDT * 2);
  p.Qp = p.YT;
  if (off > ws_size) fprintf(stderr, "workspace too small: need %zu have %zu\n", off, ws_size);
  p.ph_lo = 0; p.ph_hi = 9;
  (void)hipMemsetAsync(p.bar, 0, 65536, stream);
  void* args[] = {&p};
  hipError_t e = hipLaunchCooperativeKernel((void*)mega, dim3(grid_blocks), dim3(256), args, 0, stream);
  if (e != hipSuccess) fprintf(stderr, "cooperative launch failed: %s (grid %d)\n", hipGetErrorString(e), grid_blocks);
}
```

```cpp
#include <hip/hip_runtime.h>
#include <hip/hip_cooperative_groups.h>
#include <stdint.h>
#include <cstdio>
#include <cstring>
namespace cg = cooperative_groups;

#define DEV __device__ __forceinline__
typedef unsigned short bf16_t;
typedef short bf16x8 __attribute__((ext_vector_type(8)));
typedef float f32x4 __attribute__((ext_vector_type(4)));
typedef unsigned u32x4 __attribute__((ext_vector_type(4)));
typedef unsigned u32x2 __attribute__((ext_vector_type(2)));

constexpr int D = 2048, NB = 4, S = 8192, T = NB * S;
constexpr int LDY = 6784;
constexpr int LDT = T + 192;
constexpr int C_QA = 0, C_KC = 1024, C_VC = 1280, C_KS = 1536, C_VS = 1792, C_KW = 2048, C_VW = 2304,
              C_QR = 2560, C_KR = 3584, C_VR = 4608, C_GR = 5632, C_GA = 6656;
constexpr int R_VS = 0, R_VW = 256, R_KR = 512, R_VR = 1536, NYT = 2560;
constexpr int LDS_BYTES = 73728;
constexpr float LOG2E = 1.4426950408889634f;

struct Params {
  const float *x, *c, *w_ada, *b_ada, *g_mix, *g_ffn, *g_final, *w_in, *pe_k, *pe_v, *ck_w1, *ck_w2, *cv_w1, *cv_w2,
      *g_nsa, *g_ret, *w_out, *w_q, *sub_keys, *peer_u, *peer_v;
  float* out;
  float *mod_part, *mod, *cbias, *X1;
  unsigned* bar;
  unsigned char *U8, *V8;
  bf16_t *WinT, *WoutT, *WqT, *SK, *w1T, *w2T, *H, *Y, *YT, *Kc, *VcT, *RT, *H2, *Qp, *Omix;
  int ph_lo, ph_hi;
};

typedef __bf16 bf16v2_t __attribute__((ext_vector_type(2)));
typedef float f32x2_t __attribute__((ext_vector_type(2)));
DEV unsigned pk_bf16(float lo, float hi) {
  const bf16v2_t r = __builtin_convertvector((f32x2_t){lo, hi}, bf16v2_t);
  return __builtin_bit_cast(unsigned, r);
}
DEV float bf_lo(unsigned w) { return __uint_as_float(w << 16); }
DEV float bf_hi(unsigned w) { return __uint_as_float(w & 0xffff0000u); }
DEV float bf2f(bf16_t h) { return __uint_as_float(((unsigned)h) << 16); }
DEV float ex2(float x) { return __builtin_amdgcn_exp2f(x); }
DEV float sigmoidf_(float x) { return 1.0f / (1.0f + __expf(-x)); }
DEV float gelu_tanh(float x) {
  float u = 0.7978845608028654f * (x + 0.044715f * x * x * x);
  float t = 1.0f - 2.0f / (__expf(2.0f * u) + 1.0f);
  return 0.5f * x * (1.0f + t);
}
DEV f32x4 mfma16(bf16x8 a, bf16x8 b, f32x4 c) { return __builtin_amdgcn_mfma_f32_16x16x32_bf16(a, b, c, 0, 0, 0); }
DEV bf16x8 ld8(const bf16_t* p) { return *(const bf16x8*)p; }
DEV bf16x8 as_bf8(u32x4 v) { return __builtin_bit_cast(bf16x8, v); }
DEV float wave_sum(float v) {
#pragma unroll
  for (int o = 32; o >= 1; o >>= 1) v += __shfl_xor(v, o);
  return v;
}


DEV int opaque_tid() { int t = threadIdx.x; asm volatile("" : "+v"(t)); return t; }

DEV void transpose_tile(const float* __restrict__ src, int ld_src, int mode, bf16_t* __restrict__ dst, int Kdim, int n0, int k0,
                        float* tile) {
  const int tid = threadIdx.x, tx = tid & 63, ty = tid >> 6;
  const int n = n0 + tx;
  int sc = n;
  bool ok = true;
  if (mode == 1) {
    if (n < 2560) sc = n;
    else if (n < 6656) sc = n + 48;
    else if (n < 6704) sc = n - 6656 + 2560;
    else { sc = 0; ok = false; }
  }
#pragma unroll
  for (int i = 0; i < 16; ++i) {
    const int kk = ty + 4 * i;
    tile[kk * 65 + tx] = ok ? src[(size_t)(k0 + kk) * ld_src + sc] : 0.f;
  }
  __syncthreads();
  const int nn = tid >> 2, kc = (tid & 3) * 16;
  unsigned w[8];
#pragma unroll
  for (int j = 0; j < 8; ++j) w[j] = pk_bf16(tile[(kc + 2 * j) * 65 + nn], tile[(kc + 2 * j + 1) * 65 + nn]);
  u32x4* d = (u32x4*)(dst + (size_t)(n0 + nn) * Kdim + k0 + kc);
  d[0] = (u32x4){w[0], w[1], w[2], w[3]};
  d[1] = (u32x4){w[4], w[5], w[6], w[7]};
  __syncthreads();
}

DEV void convert_unit(const float* __restrict__ src, bf16_t* __restrict__ dst, int unit) {
  const int tid = threadIdx.x;
#pragma unroll
  for (int i = 0; i < 4; ++i) {
    const size_t e = (size_t)unit * 8192 + i * 2048 + tid * 8;
    const f32x4 a = *(const f32x4*)(src + e), b = *(const f32x4*)(src + e + 4);
    *(u32x4*)(dst + e) = (u32x4){pk_bf16(a[0], a[1]), pk_bf16(a[2], a[3]), pk_bf16(b[0], b[1]), pk_bf16(b[2], b[3])};
  }
}

typedef float f32x2v __attribute__((ext_vector_type(2)));
DEV unsigned pk4_fp8(float a, float b, float c, float d) {
  int w = __builtin_amdgcn_cvt_pk_fp8_f32(a, b, 0, false);
  w = __builtin_amdgcn_cvt_pk_fp8_f32(c, d, w, true);
  return (unsigned)w;
}
DEV void convert_unit_fp8(const float* __restrict__ src, unsigned char* __restrict__ dst, int unit, float scale) {
  const int tid = threadIdx.x;
#pragma unroll
  for (int i = 0; i < 2; ++i) {
    const size_t e = (size_t)unit * 8192 + i * 4096 + tid * 16;
    f32x4 a[4];
#pragma unroll
    for (int j = 0; j < 4; ++j) a[j] = *(const f32x4*)(src + e + 4 * j) * scale;
    *(u32x4*)(dst + e) = (u32x4){pk4_fp8(a[0][0], a[0][1], a[0][2], a[0][3]), pk4_fp8(a[1][0], a[1][1], a[1][2], a[1][3]),
                                 pk4_fp8(a[2][0], a[2][1], a[2][2], a[2][3]), pk4_fp8(a[3][0], a[3][1], a[3][2], a[3][3])};
  }
}
constexpr float U8_SCALE = 64.0f, V8_SCALE = 4.0f;

DEV void phase0(const Params& p, char* lds) {
  float* fl = (float*)lds;
  const int tid = threadIdx.x;
  constexpr int U_MOD = 768, U_WIN = 106 * 32, U_W1 = 128, U_W2 = 4, U_CB = 32;
  constexpr int TOT = U_MOD + U_WIN + U_W1 + U_W2 + U_CB;
  for (int u0 = blockIdx.x; u0 < TOT; u0 += gridDim.x) {
    int u = u0;
    if (u < U_MOD) {
      const int colblk = u % 48, ks = u / 48;
      for (int i = tid; i < 512; i += 256) {
        const int b = i >> 7, k = i & 127;
        const float cv = p.c[b * D + ks * 128 + k];
        fl[i] = cv * sigmoidf_(cv);
      }
      __syncthreads();
      const int col = colblk * 256 + tid;
      float a0 = 0, a1 = 0, a2 = 0, a3 = 0;
      const float* wp = p.w_ada + (size_t)(ks * 128) * 12288 + col;
#pragma unroll 8
      for (int k = 0; k < 128; ++k) {
        const float w = wp[(size_t)k * 12288];
        a0 += fl[k] * w; a1 += fl[128 + k] * w; a2 += fl[256 + k] * w; a3 += fl[384 + k] * w;
      }
      float* mp = p.mod_part + (size_t)ks * 4 * 12288 + col;
      mp[0] = a0; mp[12288] = a1; mp[2 * 12288] = a2; mp[3 * 12288] = a3;
      __syncthreads();
      continue;
    }
    u -= U_MOD;
    if (u < U_WIN) { transpose_tile(p.w_in, 6704, 1, p.WinT, 2048, (u >> 5) * 64, (u & 31) * 64, fl); continue; }
    u -= U_WIN;
    if (u < U_W1) {
      const int kv = u >> 6, r = u & 63;
      transpose_tile(kv ? p.cv_w1 : p.ck_w1, 128, 0, p.w1T + (size_t)kv * 128 * 2048, 2048, (r >> 5) * 64, (r & 31) * 64, fl);
      continue;
    }
    u -= U_W1;
    if (u < U_W2) {
      const int kv = u >> 1, r = u & 1;
      transpose_tile(kv ? p.cv_w2 : p.ck_w2, 64, 0, p.w2T + (size_t)kv * 64 * 128, 128, 0, r * 64, fl);
      continue;
    }
    u -= U_W2;
    if (u < U_CB) {
      const int kv = u >> 4, ks = u & 15, j = tid & 127, half = tid >> 7;
      const float* pe = kv ? p.pe_v : p.pe_k;
      const float* w1 = kv ? p.cv_w1 : p.ck_w1;
      const int i0 = ks * 128 + half * 64;
      float a = 0.f;
#pragma unroll 8
      for (int i = 0; i < 64; ++i) a += pe[i0 + i] * w1[(size_t)(i0 + i) * 128 + j];
      p.cbias[(kv * 32 + ks * 2 + half) * 128 + j] = a;
      continue;
    }
  }
}

DEV void phase1(const Params& p) {
  const int tid = threadIdx.x;
  for (int u = blockIdx.x; u < 192; u += gridDim.x) {
    const int idx = u * 256 + tid;
    const int col = idx % 12288;
    float a = p.b_ada[col];
#pragma unroll
    for (int ks = 0; ks < 16; ++ks) a += p.mod_part[(size_t)ks * 4 * 12288 + idx];
    p.mod[idx] = a;
  }
}

DEV void rms_mod_phase(const float* __restrict__ xin, const float* __restrict__ g, const float* __restrict__ mod, int shift_idx,
                       int scale_idx, bf16_t* __restrict__ dst) {
  const int lane = threadIdx.x & 63, wid = threadIdx.x >> 6;
  for (int u = blockIdx.x; u < T / 4; u += gridDim.x) {
    const int tok = u * 4 + wid, b = tok / S;
    const float* xr = xin + (size_t)tok * D;
    f32x4 v[8];
    float ss = 0.f;
#pragma unroll
    for (int i = 0; i < 8; ++i) {
      v[i] = *(const f32x4*)(xr + i * 256 + lane * 4);
      ss += v[i][0] * v[i][0] + v[i][1] * v[i][1] + v[i][2] * v[i][2] + v[i][3] * v[i][3];
    }
    ss = wave_sum(ss);
    const float rstd = rsqrtf(ss * (1.0f / D) + 1e-6f);
    const float* sh = mod + (size_t)b * 12288 + shift_idx * D;
    const float* sc = mod + (size_t)b * 12288 + scale_idx * D;
#pragma unroll
    for (int i = 0; i < 8; ++i) {
      const int col = i * 256 + lane * 4;
      const f32x4 gg = *(const f32x4*)(g + col), s1 = *(const f32x4*)(sc + col), s0 = *(const f32x4*)(sh + col);
      float y[4];
#pragma unroll
      for (int j = 0; j < 4; ++j) y[j] = v[i][j] * rstd * gg[j] * (1.0f + s1[j]) + s0[j];
      *(u32x2*)(dst + (size_t)tok * D + col) = (u32x2){pk_bf16(y[0], y[1]), pk_bf16(y[2], y[3])};
    }
  }
}

constexpr int GL = 72;
template <class Epi>
DEV void gemm_phase(const bf16_t* __restrict__ A, const bf16_t* __restrict__ Bt, int M, int N, int K, char* lds, const Epi& epi,
                    int panel_blocks = 0, unsigned* panel_cnt = nullptr, unsigned* claim_cnt = nullptr, unsigned* ready_cnt = nullptr,
                    unsigned ready_need = 0u) {
  bf16_t* sbuf = (bf16_t*)lds;
  const int ntn = N / 128, ntm = M / 128, nk = K / 64;
  const int xcd = blockIdx.x & 7, jb = blockIdx.x >> 3, bpx = (gridDim.x + 7 - xcd) >> 3;
  const int nsgn = (ntn + 7) >> 3, nsuper = (ntm >> 3) * nsgn;
  const int niter = panel_blocks > 0 ? ((int)blockIdx.x < panel_blocks ? (ntm * ntn - (int)blockIdx.x + panel_blocks - 1) / panel_blocks : 0)
                                     : ((nsuper - xcd + 7) >> 3) * (jb < 64 ? (64 - jb + bpx - 1) / bpx : 0);
  const int npb = jb < 64 ? (64 - jb + bpx - 1) / bpx : 0;
  for (int it = 0; claim_cnt != nullptr || it < niter; ++it) {
    int tm, tn;
    if (claim_cnt != nullptr) {
      int* slot = (int*)(lds + LDS_BYTES - 16);
      __syncthreads();
      if (threadIdx.x == 0) {
        const int i = (int)__hip_atomic_fetch_add(claim_cnt, 1u, __ATOMIC_RELAXED, __HIP_MEMORY_SCOPE_AGENT);
        if (i < ntm * ntn) {
          const int k = i / ntn, tmw = (k & 3) * 64 + (63 - (k >> 2));
          while (__hip_atomic_load(ready_cnt + 16 * tmw, __ATOMIC_RELAXED, __HIP_MEMORY_SCOPE_AGENT) < ready_need) __builtin_amdgcn_s_sleep(8);
          __builtin_amdgcn_fence(__ATOMIC_ACQUIRE, "agent");
          asm volatile("s_waitcnt vmcnt(0)" ::: "memory");
        }
        *slot = i;
      }
      __syncthreads();
      const int i = *slot;
      if (i >= ntm * ntn) break;
      const int k = i / ntn;
      tm = (k & 3) * 64 + (63 - (k >> 2)); tn = i - k * ntn;
    } else if (panel_blocks > 0) { const int i = (int)blockIdx.x + it * panel_blocks; tm = i / ntn; tn = i - tm * ntn; }
    else {
      const int sidx = xcd + 8 * (it / npb), jj = jb + bpx * (it % npb);
      tm = (sidx / nsgn) * 8 + (jj >> 3); tn = (sidx % nsgn) * 8 + (jj & 7);
      if (tn >= ntn) continue;
    }
    const int tid = opaque_tid(), lane = tid & 63, wid = tid >> 6, wm = wid >> 1, wn = wid & 1, lr = lane & 15, quad = lane >> 4;
    const int srow = tid >> 3, skc = (tid & 7) * 8;
    const bf16_t* Ag = A + (size_t)(tm * 128 + srow) * K + skc;
    const bf16_t* Bg = Bt + (size_t)(tn * 128 + srow) * K + skc;
    f32x4 acc[4][4];
#pragma unroll
    for (int i = 0; i < 4; ++i)
#pragma unroll
      for (int j = 0; j < 4; ++j) acc[i][j] = (f32x4){0.f, 0.f, 0.f, 0.f};
    u32x4 xa[4], xb[4], ya[4], yb[4];
#define G_LOAD(ra, rb, kt) do { _Pragma("unroll") for (int i = 0; i < 4; ++i) { \
      ra[i] = *(const u32x4*)(Ag + (size_t)(32 * i) * K + (kt) * 64); rb[i] = *(const u32x4*)(Bg + (size_t)(32 * i) * K + (kt) * 64); } } while (0)
#define G_STORE(ra, rb, buf) do { bf16_t* nA_ = sbuf + (buf) * (256 * GL); _Pragma("unroll") for (int i = 0; i < 4; ++i) { \
      *(u32x4*)(nA_ + (srow + 32 * i) * GL + skc) = ra[i]; *(u32x4*)(nA_ + 128 * GL + (srow + 32 * i) * GL + skc) = rb[i]; } } while (0)
#define G_COMPUTE(buf) do { const bf16_t* cA = sbuf + (buf) * (256 * GL); const bf16_t* cB = cA + 128 * GL; \
      _Pragma("unroll") for (int ks = 0; ks < 2; ++ks) { bf16x8 af[4], bfr[4]; \
        _Pragma("unroll") for (int i = 0; i < 4; ++i) { af[i] = ld8(cA + (wm * 64 + i * 16 + lr) * GL + ks * 32 + quad * 8); \
                                                      bfr[i] = ld8(cB + (wn * 64 + i * 16 + lr) * GL + ks * 32 + quad * 8); } \
        _Pragma("unroll") for (int i = 0; i < 4; ++i) _Pragma("unroll") for (int j = 0; j < 4; ++j) acc[i][j] = mfma16(af[i], bfr[j], acc[i][j]); \
        __builtin_amdgcn_sched_barrier(0); } } while (0)
    G_LOAD(xa, xb, 0);
    G_STORE(xa, xb, 0);
    G_LOAD(xa, xb, 1);
    G_LOAD(ya, yb, 2);
    __syncthreads();
    for (int kt = 0; kt < nk; kt += 2) {
      G_COMPUTE(0);
      G_STORE(xa, xb, 1);
      if (kt + 3 < nk) G_LOAD(xa, xb, kt + 3);
      __syncthreads();
      G_COMPUTE(1);
      if (kt + 2 < nk) G_STORE(ya, yb, 0);
      if (kt + 4 < nk) G_LOAD(ya, yb, kt + 4);
      __syncthreads();
    }
#undef G_LOAD
#undef G_STORE
#undef G_COMPUTE
    float* sC = (float*)lds;
    if (epi.rowmajor(tn)) {
#pragma unroll
      for (int i = 0; i < 4; ++i)
#pragma unroll
        for (int j = 0; j < 4; ++j)
#pragma unroll
          for (int r = 0; r < 4; ++r) sC[(wm * 64 + i * 16 + quad * 4 + r) * 132 + wn * 64 + j * 16 + lr] = acc[i][j][r];
      __syncthreads();
      epi(tm, tn, sC);
      __syncthreads();
    }
    if (epi.transposed(tn)) {
#pragma unroll
      for (int i = 0; i < 4; ++i)
#pragma unroll
        for (int j = 0; j < 4; ++j) *(f32x4*)(sC + (wn * 64 + j * 16 + lr) * 132 + wm * 64 + i * 16 + quad * 4) = acc[i][j];
      __syncthreads();
      epi.store_t(tm, tn, sC);
      __syncthreads();
    }
    if (panel_blocks > 0) {
      asm volatile("s_waitcnt vmcnt(0)" ::: "memory");
      __syncthreads();
      if (threadIdx.x == 0) {
        __builtin_amdgcn_fence(__ATOMIC_RELEASE, "agent");
        asm volatile("s_waitcnt vmcnt(0)" ::: "memory");
        __hip_atomic_fetch_add(panel_cnt + 16 * tm, 1u, __ATOMIC_RELAXED, __HIP_MEMORY_SCOPE_AGENT);
      }
    }
  }
}

struct Epi1 {
  bf16_t* Y; bf16_t* YT;
  DEV bool rowmajor(int tn) const { return !((tn == 14 || tn == 15) || (tn == 18 || tn == 19) || (tn >= 36 && tn < 44)); }
  DEV bool transposed(int tn) const { return (tn == 14 || tn == 15) || (tn == 18 || tn == 19) || (tn >= 28 && tn < 44); }
  DEV void operator()(int tm, int tn, const float* sC) const {
    const int tid = threadIdx.x;
#pragma unroll
    for (int i = 0; i < 8; ++i) {
      const int idx = tid + 256 * i, row = idx >> 4, c8 = idx & 15;
      const f32x4 a = *(const f32x4*)(sC + row * 132 + c8 * 8), b = *(const f32x4*)(sC + row * 132 + c8 * 8 + 4);
      *(u32x4*)(Y + (size_t)(tm * 128 + row) * LDY + tn * 128 + c8 * 8) =
          (u32x4){pk_bf16(a[0], a[1]), pk_bf16(a[2], a[3]), pk_bf16(b[0], b[1]), pk_bf16(b[2], b[3])};
    }
  }
  DEV void store_t(int tm, int tn, const float* sCT) const {
    const int tid = threadIdx.x;
    int r0;
    if (tn == 14 || tn == 15) r0 = R_VS + (tn - 14) * 128;
    else if (tn == 18 || tn == 19) r0 = R_VW + (tn - 18) * 128;
    else if (tn < 36) r0 = R_KR + (tn - 28) * 128;
    else r0 = R_VR + (tn - 36) * 128;
#pragma unroll
    for (int i = 0; i < 8; ++i) {
      const int idx = tid + 256 * i, col = idx >> 4, ch = idx & 15;
      const f32x4 a = *(const f32x4*)(sCT + col * 132 + ch * 8), b = *(const f32x4*)(sCT + col * 132 + ch * 8 + 4);
      *(u32x4*)(YT + (size_t)(r0 + col) * LDT + tm * 128 + ch * 8) =
          (u32x4){pk_bf16(a[0], a[1]), pk_bf16(a[2], a[3]), pk_bf16(b[0], b[1]), pk_bf16(b[2], b[3])};
    }
  }
};
struct Epi2 {
  const float* x; const float* mod; float* X1;
  DEV bool rowmajor(int) const { return true; }
  DEV bool transposed(int) const { return false; }
  DEV void store_t(int, int, const float*) const {}
  DEV void operator()(int tm, int tn, const float* sC) const {
    const int tid = threadIdx.x, b = (tm * 128) / S;
#pragma unroll
    for (int i = 0; i < 16; ++i) {
      const int idx = tid + 256 * i, row = idx >> 5, c4 = idx & 31;
      const f32x4 v = *(const f32x4*)(sC + row * 132 + c4 * 4);
      const size_t t = (size_t)tm * 128 + row;
      const int col = tn * 128 + c4 * 4;
      const f32x4 xi = *(const f32x4*)(x + t * D + col), gt = *(const f32x4*)(mod + (size_t)b * 12288 + 2 * D + col);
      *(f32x4*)(X1 + t * D + col) = xi + gt * v;
    }
  }
};
struct Epi3 {
  bf16_t* Q;
  DEV bool rowmajor(int) const { return true; }
  DEV bool transposed(int) const { return false; }
  DEV void store_t(int, int, const float*) const {}
  DEV void operator()(int tm, int tn, const float* sC) const {
    const int tid = threadIdx.x;
#pragma unroll
    for (int i = 0; i < 8; ++i) {
      const int idx = tid + 256 * i, row = idx >> 4, c8 = idx & 15;
      const f32x4 a = *(const f32x4*)(sC + row * 132 + c8 * 8), b = *(const f32x4*)(sC + row * 132 + c8 * 8 + 4);
      *(u32x4*)(Q + (size_t)(tm * 128 + row) * D + tn * 128 + c8 * 8) =
          (u32x4){pk_bf16(a[0], a[1]), pk_bf16(a[2], a[3]), pk_bf16(b[0], b[1]), pk_bf16(b[2], b[3])};
    }
  }
};

DEV float ret_lg2(int h) { return log1pf(-ex2(-5.0f - (float)h)) * LOG2E; }

DEV void ret_state_unit(const Params& p, int u) {
  const int tid_ = opaque_tid(), lane = tid_ & 63, w = tid_ >> 6, lr = lane & 15, quad = lane >> 4;
  const int es = u & 7, h = (u >> 3) & 7, b = u >> 6;
  const float lg2 = ret_lg2(h);
  const float cd = ex2(lg2 * 128.0f);
  const float kscale = 0.08838834764831845f;
  f32x4 st[2];
  st[0] = (f32x4){0.f, 0.f, 0.f, 0.f}; st[1] = st[0];
  const bf16_t* vrow = p.YT + (size_t)(R_VR + h * 128 + es * 16 + lr) * LDT + (size_t)b * S + quad * 8;
  const bf16_t* krow0 = p.YT + (size_t)(R_KR + h * 128 + w * 32 + lr) * LDT + (size_t)b * S + quad * 8;
  const bf16_t* krow1 = krow0 + (size_t)16 * LDT;
  bf16_t* rt = p.RT + ((size_t)((b * 8 + h) * 64)) * 16384 + (size_t)(es * 16 + lr) * 128 + w * 32 + quad * 4;
  for (int n = 0; n < 64; ++n) {
#pragma unroll
    for (int mt = 0; mt < 2; ++mt)
      *(u32x2*)(rt + (size_t)n * 16384 + mt * 16) = (u32x2){pk_bf16(st[mt][0], st[mt][1]), pk_bf16(st[mt][2], st[mt][3])};
    if (n == 63) break;
    f32x4 kv[2];
    kv[0] = (f32x4){0.f, 0.f, 0.f, 0.f}; kv[1] = kv[0];
#pragma unroll
    for (int ks = 0; ks < 4; ++ks) {
      const bf16x8 vb = ld8(vrow + n * 128 + ks * 32);
      const u32x4 ka = *(const u32x4*)(krow0 + n * 128 + ks * 32), kb = *(const u32x4*)(krow1 + n * 128 + ks * 32);
      u32x4 sa, sb;
#pragma unroll
      for (int q2 = 0; q2 < 4; ++q2) {
        const int j = ks * 32 + quad * 8 + q2 * 2;
        const float d0 = kscale * ex2(lg2 * (float)(127 - j)), d1 = kscale * ex2(lg2 * (float)(126 - j));
        sa[q2] = pk_bf16(bf_lo(ka[q2]) * d0, bf_hi(ka[q2]) * d1);
        sb[q2] = pk_bf16(bf_lo(kb[q2]) * d0, bf_hi(kb[q2]) * d1);
      }
      kv[0] = mfma16(as_bf8(sa), vb, kv[0]);
      kv[1] = mfma16(as_bf8(sb), vb, kv[1]);
    }
    st[0] = st[0] * cd + kv[0];
    st[1] = st[1] * cd + kv[1];
  }
}

DEV void compress_unit(const Params& p, int cu, char* lds) {
  const int tid_ = opaque_tid(), lane = tid_ & 63, w = tid_ >> 6, lr = lane & 15, quad = lane >> 4;
  const int kv = cu >> 7, rem = cu & 127, b = rem >> 5, g = (rem >> 3) & 3, nb = rem & 7;
  const int srccol = (kv ? C_VC : C_KC) + g * 64;
  const bf16_t* w1T = p.w1T + (size_t)kv * 128 * 2048;
  const bf16_t* w2T = p.w2T + (size_t)kv * 64 * 128;
  const float* cb = p.cbias + kv * 32 * 128;
  bf16_t* h1 = (bf16_t*)lds;
  f32x4 acc[4][2];
#pragma unroll
  for (int m = 0; m < 4; ++m) { acc[m][0] = (f32x4){0.f, 0.f, 0.f, 0.f}; acc[m][1] = acc[m][0]; }
  const bf16_t* b0 = w1T + (size_t)(w * 32 + lr) * 2048 + quad * 8;
  const bf16_t* b1 = b0 + (size_t)16 * 2048;
  const bf16_t* ybase = p.Y + (size_t)b * S * LDY + srccol;
#pragma unroll 2
  for (int ks = 0; ks < 64; ++ks) {
    const int l = ks >> 1, dof = (ks & 1) * 32 + quad * 8;
    const bf16x8 bf0 = ld8(b0 + ks * 32), bf1 = ld8(b1 + ks * 32);
#pragma unroll
    for (int m = 0; m < 4; ++m) {
      int tok = 16 * (nb * 64 + m * 16 + lr) + l;
      tok = tok < S ? tok : S - 1;
      const bf16x8 af = ld8(ybase + (size_t)tok * LDY + dof);
      acc[m][0] = mfma16(af, bf0, acc[m][0]);
      acc[m][1] = mfma16(af, bf1, acc[m][1]);
    }
  }
#pragma unroll
  for (int nt = 0; nt < 2; ++nt) {
    const int hc = w * 32 + nt * 16 + lr;
    float bias = 0.f;
#pragma unroll
    for (int pp = 0; pp < 32; ++pp) bias += cb[pp * 128 + hc];
#pragma unroll
    for (int m = 0; m < 4; ++m)
#pragma unroll
      for (int r = 0; r < 4; ++r) {
        const float v = gelu_tanh(acc[m][nt][r] + bias);
        h1[(m * 16 + quad * 4 + r) * 136 + hc] = (bf16_t)(pk_bf16(v, v) & 0xffffu);
      }
  }
  __syncthreads();
  const int d = w * 16 + lr;
  bf16x8 bb[4];
#pragma unroll
  for (int ks = 0; ks < 4; ++ks) bb[ks] = ld8(w2T + (size_t)d * 128 + ks * 32 + quad * 8);
#pragma unroll
  for (int m = 0; m < 4; ++m) {
    f32x4 o = (f32x4){0.f, 0.f, 0.f, 0.f};
#pragma unroll
    for (int ks = 0; ks < 4; ++ks) o = mfma16(ld8(h1 + (m * 16 + lr) * 136 + ks * 32 + quad * 8), bb[ks], o);
    const int n0 = nb * 64 + m * 16 + quad * 4;
    if (kv == 0) {
#pragma unroll
      for (int r = 0; r < 4; ++r) p.Kc[((size_t)(b * 4 + g) * 512 + n0 + r) * 64 + d] = (bf16_t)(pk_bf16(o[r], o[r]) & 0xffffu);
    } else {
      *(u32x2*)(p.VcT + ((size_t)(b * 4 + g) * 64 + d) * 512 + n0) = (u32x2){pk_bf16(o[0], o[1]), pk_bf16(o[2], o[3])};
    }
  }
  __syncthreads();
}

constexpr int NCONV = 1024 + 1024 + 32 + 4096 + 4096;
DEV void conv_unit(const Params& p, int u, char* lds) {
  constexpr int U_WOUT = 1024, U_WQ = 1024, U_SK = 32, U_U = 4096;
  if (u < U_WOUT) { transpose_tile(p.w_out, 2048, 0, p.WoutT, 2048, (u >> 5) * 64, (u & 31) * 64, (float*)lds); return; }
  u -= U_WOUT;
  if (u < U_WQ) { transpose_tile(p.w_q, 2048, 0, p.WqT, 2048, (u >> 5) * 64, (u & 31) * 64, (float*)lds); return; }
  u -= U_WQ;
  if (u < U_SK) { convert_unit(p.sub_keys, p.SK, u); return; }
  u -= U_SK;
  if (u < U_U) { convert_unit_fp8(p.peer_u, p.U8, u, U8_SCALE); return; }
  u -= U_U;
  convert_unit_fp8(p.peer_v, p.V8, u, V8_SCALE);
}
DEV void conv_drain(const Params& p, char* lds) {
  unsigned* cnt = p.bar + 64 * 100;
  int* slot = (int*)(lds + LDS_BYTES - 16);
  for (;;) {
    __syncthreads();
    if (threadIdx.x == 0) *slot = (int)__hip_atomic_fetch_add(cnt, 1u, __ATOMIC_RELAXED, __HIP_MEMORY_SCOPE_AGENT);
    __syncthreads();
    const int u = *slot;
    if (u >= NCONV) break;
    conv_unit(p, u, lds);
  }
}

DEV void phase4(const Params& p, char* lds) {
  for (int u = blockIdx.x; u < 512; u += gridDim.x) {
    if (u < 256) ret_state_unit(p, u);
    else compress_unit(p, u - 256, lds);
  }
  conv_drain(p, lds);
}

DEV void ret_out_unit(const Params& p, int u) {
  const int tid_ = opaque_tid(), lane = tid_ & 63, w = tid_ >> 6, lr = lane & 15, quad = lane >> 4;
  const int n = u & 63, h = (u >> 6) & 7, b = u >> 9;
  const float lg2 = ret_lg2(h);
  const float kscale = 0.08838834764831845f;
  const size_t tk0 = (size_t)b * S + n * 128;
  f32x4 o[8][2];
#pragma unroll
  for (int i = 0; i < 8; ++i) { o[i][0] = (f32x4){0.f, 0.f, 0.f, 0.f}; o[i][1] = o[i][0]; }
  bf16x8 qf[2][4];
#pragma unroll
  for (int nt = 0; nt < 2; ++nt)
#pragma unroll
    for (int ks = 0; ks < 4; ++ks)
      qf[nt][ks] = ld8(p.Y + (tk0 + w * 32 + nt * 16 + lr) * LDY + C_QR + h * 128 + ks * 32 + quad * 8);
  const bf16_t* rt = p.RT + ((size_t)((b * 8 + h) * 64 + n)) * 16384 + (size_t)lr * 128 + quad * 8;
#pragma unroll 2
  for (int ks = 0; ks < 4; ++ks)
#pragma unroll
    for (int et = 0; et < 8; ++et) {
      const bf16x8 af = ld8(rt + et * 16 * 128 + ks * 32);
      o[et][0] = mfma16(af, qf[0][ks], o[et][0]);
      o[et][1] = mfma16(af, qf[1][ks], o[et][1]);
    }
  int ti[2];
#pragma unroll
  for (int nt = 0; nt < 2; ++nt) {
    ti[nt] = w * 32 + nt * 16 + lr;
    const float qd = ex2(lg2 * (float)(ti[nt] + 1));
#pragma unroll
    for (int et = 0; et < 8; ++et) o[et][nt] = o[et][nt] * qd;
  }
  for (int jt = 0; jt <= w; ++jt) {
    const int j0 = jt * 32;
    f32x4 s[2][2];
#pragma unroll
    for (int mt = 0; mt < 2; ++mt) { s[mt][0] = (f32x4){0.f, 0.f, 0.f, 0.f}; s[mt][1] = s[mt][0]; }
#pragma unroll
    for (int mt = 0; mt < 2; ++mt)
#pragma unroll
      for (int ks = 0; ks < 4; ++ks) {
        const bf16x8 kf = ld8(p.Y + (tk0 + j0 + mt * 16 + lr) * LDY + C_KR + h * 128 + ks * 32 + quad * 8);
        s[mt][0] = mfma16(kf, qf[0][ks], s[mt][0]);
        s[mt][1] = mfma16(kf, qf[1][ks], s[mt][1]);
      }
    bf16x8 pb[2];
#pragma unroll
    for (int nt = 0; nt < 2; ++nt) {
      float pv[2][4];
#pragma unroll
      for (int mt = 0; mt < 2; ++mt)
#pragma unroll
        for (int r = 0; r < 4; ++r) {
          const int j = j0 + mt * 16 + quad * 4 + r;
          const int dd = ti[nt] - j;
          pv[mt][r] = dd >= 0 ? s[mt][nt][r] * kscale * ex2(lg2 * (float)dd) : 0.f;
        }
      pb[nt] = as_bf8((u32x4){pk_bf16(pv[0][0], pv[0][1]), pk_bf16(pv[0][2], pv[0][3]), pk_bf16(pv[1][0], pv[1][1]), pk_bf16(pv[1][2], pv[1][3])});
    }
#pragma unroll
    for (int et = 0; et < 8; ++et) {
      const bf16_t* vp = p.YT + (size_t)(R_VR + h * 128 + et * 16 + lr) * LDT + tk0 + j0 + quad * 4;
      const u32x2 lo = *(const u32x2*)vp, hi = *(const u32x2*)(vp + 16);
      const bf16x8 vf = as_bf8((u32x4){lo[0], lo[1], hi[0], hi[1]});
      o[et][0] = mfma16(vf, pb[0], o[et][0]);
      o[et][1] = mfma16(vf, pb[1], o[et][1]);
    }
  }
#pragma unroll
  for (int nt = 0; nt < 2; ++nt) {
    float sm = 0.f;
#pragma unroll
    for (int et = 0; et < 8; ++et) sm += o[et][nt][0] + o[et][nt][1] + o[et][nt][2] + o[et][nt][3];
    sm += __shfl_xor(sm, 16); sm += __shfl_xor(sm, 32);
    const float mu = sm * (1.0f / 128.0f);
    float sq = 0.f;
#pragma unroll
    for (int et = 0; et < 8; ++et)
#pragma unroll
      for (int r = 0; r < 4; ++r) { const float dlt = o[et][nt][r] - mu; sq += dlt * dlt; }
    sq += __shfl_xor(sq, 16); sq += __shfl_xor(sq, 32);
    const float rstd = rsqrtf(sq * (1.0f / 128.0f) + 1e-6f);
    const size_t tok = tk0 + ti[nt];
#pragma unroll
    for (int et = 0; et < 8; ++et) {
      const int e = et * 16 + quad * 4;
      const u32x2 gr = *(const u32x2*)(p.Y + tok * LDY + C_GR + h * 128 + e);
      const f32x4 gw = *(const f32x4*)(p.g_ret + h * 128 + e);
      const float gv[4] = {bf_lo(gr[0]), bf_hi(gr[0]), bf_lo(gr[1]), bf_hi(gr[1])};
      float y[4];
#pragma unroll
      for (int r = 0; r < 4; ++r) y[r] = (o[et][nt][r] - mu) * rstd * gw[r] * (gv[r] * sigmoidf_(gv[r]));
      *(u32x2*)(p.Omix + tok * D + 1024 + h * 128 + e) = (u32x2){pk_bf16(y[0], y[1]), pk_bf16(y[2], y[3])};
    }
  }
}

constexpr int NQT = 2;
struct AttnSt { f32x4 o[4][NQT]; float m[NQT], l[NQT]; };

DEV void attn_reset(AttnSt& st) {
#pragma unroll
  for (int j = 0; j < NQT; ++j) {
    st.m[j] = -1e30f; st.l[j] = 0.f;
#pragma unroll
    for (int i = 0; i < 4; ++i) st.o[i][j] = (f32x4){0.f, 0.f, 0.f, 0.f};
  }
}

constexpr int TL = 72;
constexpr int TILE_BUF_BYTES = 2 * 64 * TL * 2;
constexpr int NSA_TILE_OFF = 36864;
struct KVFrag { bf16x8 k[4][2]; bf16x8 v[4][2]; };

struct TileSrc { const bf16_t* kbase; size_t krs; const bf16_t* vbase; size_t vrs; };
template <bool WITH_V>
DEV void stage_load(u32x4 (&r)[4], const TileSrc& ts, int pos, int tid) {
#pragma unroll
  for (int i = 0; i < 2; ++i) {
    const int c = tid + 256 * i, row = c >> 3, ch = c & 7;
    r[i] = *(const u32x4*)(ts.kbase + (size_t)(pos + row) * ts.krs + ch * 8);
    if (WITH_V) r[2 + i] = *(const u32x4*)(ts.vbase + (size_t)row * ts.vrs + pos + ch * 8);
  }
}
template <bool WITH_V>
DEV void stage_store(bf16_t* tb, const u32x4 (&r)[4], int tid) {
#pragma unroll
  for (int i = 0; i < 2; ++i) {
    const int c = tid + 256 * i, row = c >> 3, ch = c & 7;
    *(u32x4*)(tb + row * TL + ch * 8) = r[i];
    if (WITH_V) *(u32x4*)(tb + 64 * TL + row * TL + ch * 8) = r[2 + i];
  }
}
DEV void lds_k(KVFrag& f, const bf16_t* tb, int lr, int quad) {
#pragma unroll
  for (int mt = 0; mt < 4; ++mt)
#pragma unroll
    for (int ks = 0; ks < 2; ++ks) f.k[mt][ks] = ld8(tb + (mt * 16 + lr) * TL + ks * 32 + quad * 8);
}
DEV void lds_v(KVFrag& f, const bf16_t* tb, int lr, int quad) {
#pragma unroll
  for (int dt = 0; dt < 4; ++dt)
#pragma unroll
    for (int hf = 0; hf < 2; ++hf) {
      const bf16_t* vp = tb + 64 * TL + (dt * 16 + lr) * TL + hf * 32 + quad * 4;
      const u32x2 lo = *(const u32x2*)vp, hi = *(const u32x2*)(vp + 16);
      f.v[dt][hf] = as_bf8((u32x4){lo[0], lo[1], hi[0], hi[1]});
    }
}
template <bool WITH_V, class NextFn, class ProcFn>
DEV void tile_loop(char* lds, int tid, const TileSrc& ts, NextFn next, ProcFn proc) {
  int cur = next();
  if (cur < 0) return;
  int n1 = next(), n2 = n1 >= 0 ? next() : -1;
  u32x4 r0[4], r1[4];
  stage_load<WITH_V>(r0, ts, cur, tid);
  stage_store<WITH_V>((bf16_t*)(lds + NSA_TILE_OFF), r0, tid);
  stage_load<WITH_V>(r0, ts, n1 >= 0 ? n1 : cur, tid);
  stage_load<WITH_V>(r1, ts, n2 >= 0 ? n2 : cur, tid);
  __syncthreads();
  while (true) {
    proc(cur, (const bf16_t*)(lds + NSA_TILE_OFF));
    stage_store<WITH_V>((bf16_t*)(lds + NSA_TILE_OFF + TILE_BUF_BYTES), r0, tid);
    const int n3 = n2 >= 0 ? next() : -1;
    stage_load<WITH_V>(r0, ts, n3 >= 0 ? n3 : cur, tid);
    __syncthreads();
    if (n1 < 0) break;
    proc(n1, (const bf16_t*)(lds + NSA_TILE_OFF + TILE_BUF_BYTES));
    stage_store<WITH_V>((bf16_t*)(lds + NSA_TILE_OFF), r1, tid);
    const int n4 = n3 >= 0 ? next() : -1;
    stage_load<WITH_V>(r1, ts, n4 >= 0 ? n4 : cur, tid);
    __syncthreads();
    if (n2 < 0) break;
    cur = n2; n1 = n3; n2 = n4;
  }
}

DEV void qk_tile(f32x4 (&s)[4][NQT], const KVFrag& f, const bf16x8 (&qf)[NQT][2]) {
#pragma unroll
  for (int mt = 0; mt < 4; ++mt)
#pragma unroll
    for (int nt = 0; nt < NQT; ++nt) {
      s[mt][nt] = mfma16(f.k[mt][0], qf[nt][0], (f32x4){0.f, 0.f, 0.f, 0.f});
      s[mt][nt] = mfma16(f.k[mt][1], qf[nt][1], s[mt][nt]);
    }
}
DEV void pv_tile(AttnSt& st, const KVFrag& f, const bf16x8 (&pb)[NQT][2]) {
#pragma unroll
  for (int dt = 0; dt < 4; ++dt)
#pragma unroll
    for (int hf = 0; hf < 2; ++hf)
#pragma unroll
      for (int nt = 0; nt < NQT; ++nt) st.o[dt][nt] = mfma16(f.v[dt][hf], pb[nt][hf], st.o[dt][nt]);
}

DEV void attn_tile(AttnSt& st, const bf16x8 (&qf)[NQT][2], const bf16_t* tb, int rel0, int lr, const unsigned (&selbit)[NQT], int maxdist,
                   bool need_mask, float c1, float slope2, int quad) {
  KVFrag f;
  lds_k(f, tb, lr, quad);
  f32x4 s[4][NQT];
  qk_tile(s, f, qf);
  lds_v(f, tb, lr, quad);
  const float b0 = slope2 * (float)(rel0 + quad * 4);
  float smaxv[NQT];
#pragma unroll
  for (int nt = 0; nt < NQT; ++nt) smaxv[nt] = -1e30f;
  float rbv = b0;
  const float step13 = slope2 * 13.0f;
#pragma unroll
  for (int mt = 0; mt < 4; ++mt)
#pragma unroll
    for (int r = 0; r < 4; ++r) {
      if (r > 0) rbv += slope2; else if (mt > 0) rbv += step13;
#pragma unroll
      for (int nt = 0; nt < NQT; ++nt) {
        const float v = fmaf(s[mt][nt][r], c1, rbv);
        s[mt][nt][r] = v;
        smaxv[nt] = fmaxf(smaxv[nt], v);
      }
    }
  if (need_mask) {
#pragma unroll
    for (int nt = 0; nt < NQT; ++nt) {
      float mx = -1e30f;
      const int dq = lr + nt * 16 - rel0 - quad * 4;
#pragma unroll
      for (int mt = 0; mt < 4; ++mt)
#pragma unroll
        for (int r = 0; r < 4; ++r) {
          const int dist = dq - (mt * 16 + r);
          const bool valid = selbit[nt] && dist >= 0 && dist <= maxdist;
          const float v = valid ? s[mt][nt][r] : -1e30f;
          s[mt][nt][r] = v;
          mx = fmaxf(mx, v);
        }
      smaxv[nt] = mx;
    }
  } else {
#pragma unroll
    for (int nt = 0; nt < NQT; ++nt) smaxv[nt] = selbit[nt] ? smaxv[nt] : -1e30f;
  }
  bf16x8 pb[NQT][2];
#pragma unroll
  for (int nt = 0; nt < NQT; ++nt) {
    float smax = smaxv[nt];
    smax = fmaxf(smax, __shfl_xor(smax, 16));
    smax = fmaxf(smax, __shfl_xor(smax, 32));
    const float mnew = fmaxf(st.m[nt], smax);
    const float alpha = ex2(st.m[nt] - mnew);
    st.m[nt] = mnew;
    const float mref = selbit[nt] ? fmaxf(mnew, -1e20f) : 1e30f;
    float ls = 0.f;
    float pv[4][4];
#pragma unroll
    for (int mt = 0; mt < 4; ++mt)
#pragma unroll
      for (int r = 0; r < 4; ++r) { const float e = ex2(s[mt][nt][r] - mref); pv[mt][r] = e; ls += e; }
    st.l[nt] = st.l[nt] * alpha + ls;
#pragma unroll
    for (int hf = 0; hf < 2; ++hf)
      pb[nt][hf] = as_bf8((u32x4){pk_bf16(pv[2 * hf][0], pv[2 * hf][1]), pk_bf16(pv[2 * hf][2], pv[2 * hf][3]),
                                  pk_bf16(pv[2 * hf + 1][0], pv[2 * hf + 1][1]), pk_bf16(pv[2 * hf + 1][2], pv[2 * hf + 1][3])});
#pragma unroll
    for (int dt = 0; dt < 4; ++dt) st.o[dt][nt] = st.o[dt][nt] * alpha;
  }
  pv_tile(st, f, pb);
}

DEV void cmp_scores(f32x4 (&s)[4][NQT], int n0, int t0, int lr, int quad, float c1, float slope2, bool full) {
  float rbv = slope2 * (float)(16 * (n0 + quad * 4) + 31 - t0);
  const float step16 = slope2 * 16.0f, step208 = slope2 * 208.0f;
#pragma unroll
  for (int mt = 0; mt < 4; ++mt)
#pragma unroll
    for (int r = 0; r < 4; ++r) {
      if (r > 0) rbv += step16; else if (mt > 0) rbv += step208;
      const int rel = 16 * (n0 + mt * 16 + quad * 4 + r) + 31 - t0;
#pragma unroll
      for (int nt = 0; nt < NQT; ++nt) {
        float v = fmaf(s[mt][nt][r], c1, rbv);
        if (!full) v = (rel <= lr + nt * 16) ? v : -1e30f;
        s[mt][nt][r] = v;
      }
    }
}

DEV void nsa_unit(const Params& p, int u, char* lds) {
  const int tid = opaque_tid(), lane = tid & 63, w = tid >> 6, lr = lane & 15, quad = lane >> 4;
  const int q32 = u & 255, g = (u >> 8) & 3, b = u >> 10;
  const int h = g * 4 + w, t0 = q32 * 32, qb = t0 >> 6;
  const size_t tokbase = (size_t)b * S;
  float* imp = (float*)lds;
  float* stash = (float*)lds;
  unsigned* selmask = (unsigned*)(lds + 32768);
  unsigned* unionm = (unsigned*)(lds + 32768 + 512);
  const float slope = ex2(-0.5f * (float)(h + 1));
  const float slope2 = slope * LOG2E, c1 = 0.125f * LOG2E;
  const int tq0 = t0 + lr;
  const float skipd = 200.0f / slope2;
  const float skipd_g = 200.0f / (ex2(-0.5f * (float)(g * 4 + 4)) * LOG2E);

  for (int i = tid; i < 32 * 129; i += 256) imp[i] = 0.f;
  if (tid < 4) unionm[tid] = 0u;
  bf16x8 qf[NQT][2];
#pragma unroll
  for (int nt = 0; nt < NQT; ++nt)
#pragma unroll
    for (int ks = 0; ks < 2; ++ks) qf[nt][ks] = ld8(p.Y + (tokbase + tq0 + nt * 16) * LDY + C_QA + h * 64 + ks * 32 + quad * 8);
  __syncthreads();
  auto gate = [&](int nt, int br) -> float {
    const bf16_t* gp = p.Y + (tokbase + tq0 + nt * 16) * LDY + C_GA + h * 3 + br;
    asm volatile("" : "+v"(gp));
    return sigmoidf_(bf2f(*gp));
  };

  AttnSt st;
  int nmax = t0 / 16;
  if (nmax > 510) nmax = 510;
  TileSrc tsc;
  tsc.kbase = p.Kc + (size_t)(b * 4 + g) * 512 * 64; tsc.krs = 64;
  tsc.vbase = p.VcT + (size_t)(b * 4 + g) * 64 * 512; tsc.vrs = 512;
  float m1[NQT], l1[NQT];
#pragma unroll
  for (int nt = 0; nt < NQT; ++nt) { m1[nt] = -1e30f; l1[nt] = 0.f; }
  int nstart = 0;
  while (nstart + 64 <= nmax && (float)(t0 - (16 * (nstart + 63) + 31)) > skipd_g) nstart += 64;
  {
    int nn = nstart;
    tile_loop<false>(lds, tid, tsc, [&]() -> int { const int r = nn <= nmax ? nn : -1; nn += 64; return r; },
      [&](int n0, const bf16_t* tb) {
        if ((float)(t0 - (16 * (n0 + 63) + 31)) > skipd) return;
        KVFrag f;
        lds_k(f, tb, lr, quad);
        f32x4 s[4][NQT];
        qk_tile(s, f, qf);
        const bool full = 16 * (n0 + 63) + 31 <= t0;
        if (full) cmp_scores(s, n0, t0, lr, quad, c1, slope2, true); else cmp_scores(s, n0, t0, lr, quad, c1, slope2, false);
#pragma unroll
        for (int nt = 0; nt < NQT; ++nt) {
          float smax = -1e30f;
#pragma unroll
          for (int mt = 0; mt < 4; ++mt)
#pragma unroll
            for (int r = 0; r < 4; ++r) smax = fmaxf(smax, s[mt][nt][r]);
          smax = fmaxf(smax, __shfl_xor(smax, 16));
          smax = fmaxf(smax, __shfl_xor(smax, 32));
          const float mnew = fmaxf(m1[nt], smax);
          const float mref = fmaxf(mnew, -1e20f);
          float ls = 0.f;
#pragma unroll
          for (int mt = 0; mt < 4; ++mt)
#pragma unroll
            for (int r = 0; r < 4; ++r) ls += ex2(s[mt][nt][r] - mref);
          l1[nt] = l1[nt] * ex2(m1[nt] - mnew) + ls;
          m1[nt] = mnew;
        }
      });
  }
  float il1[NQT];
#pragma unroll
  for (int nt = 0; nt < NQT; ++nt) {
    float l = l1[nt];
    l += __shfl_xor(l, 16); l += __shfl_xor(l, 32);
    il1[nt] = l > 0.f ? 1.0f / l : 0.f;
  }
  attn_reset(st);
  {
    int nn = nstart;
    tile_loop<true>(lds, tid, tsc, [&]() -> int { const int r = nn <= nmax ? nn : -1; nn += 64; return r; },
      [&](int n0, const bf16_t* tb) {
        if ((float)(t0 - (16 * (n0 + 63) + 31)) > skipd) return;
        KVFrag f;
        lds_k(f, tb, lr, quad);
        f32x4 s[4][NQT];
        qk_tile(s, f, qf);
        lds_v(f, tb, lr, quad);
        {
          const bool full = 16 * (n0 + 63) + 31 <= t0;
          if (full) cmp_scores(s, n0, t0, lr, quad, c1, slope2, true); else cmp_scores(s, n0, t0, lr, quad, c1, slope2, false);
        }
        bf16x8 pb[NQT][2];
#pragma unroll
        for (int nt = 0; nt < NQT; ++nt) {
          const float mref = fmaxf(m1[nt], -1e20f);
          float pv[4][4];
#pragma unroll
          for (int mt = 0; mt < 4; ++mt) {
#pragma unroll
            for (int r = 0; r < 4; ++r) pv[mt][r] = ex2(s[mt][nt][r] - mref) * il1[nt];
            const int msel = (n0 + mt * 16 + quad * 4) >> 2;
            const float s4 = (pv[mt][0] + pv[mt][1]) + (pv[mt][2] + pv[mt][3]);
            float* ip = imp + (nt * 16 + lr) * 129 + msel;
            if (s4 != 0.f) {
              atomicAdd(ip, s4);
              if (msel + 1 < 128 && pv[mt][3] != 0.f) atomicAdd(ip + 1, pv[mt][3]);
            }
          }
#pragma unroll
          for (int hf = 0; hf < 2; ++hf)
            pb[nt][hf] = as_bf8((u32x4){pk_bf16(pv[2 * hf][0], pv[2 * hf][1]), pk_bf16(pv[2 * hf][2], pv[2 * hf][3]),
                                        pk_bf16(pv[2 * hf + 1][0], pv[2 * hf + 1][1]), pk_bf16(pv[2 * hf + 1][2], pv[2 * hf + 1][3])});
        }
        pv_tile(st, f, pb);
      });
  }
  {
    unsigned um0 = 0, um1 = 0, um2 = 0, um3 = 0;
    for (int qi = 0; qi < 8; ++qi) {
      const int q = w * 8 + qi;
      unsigned key[2];
#pragma unroll
      for (int j = 0; j < 2; ++j) {
        const int m = lane + 64 * j;
        const float v = imp[q * 129 + m];
        unsigned k = (__float_as_uint(v) & 0xffffff80u) + 0x80u + (unsigned)(127 - m);
        if (m == 0 || m == qb || m + 1 == qb) k = 0x7f000000u + (unsigned)(127 - m);
        if (m > qb) k = 0u;
        key[j] = k;
      }
      unsigned thr = 0u;
#pragma unroll 1
      for (int bit = 30; bit >= 0; --bit) {
        const unsigned cand = thr | (1u << bit);
        const int cnt = __popcll(__ballot(key[0] >= cand)) + __popcll(__ballot(key[1] >= cand));
        if (cnt >= 16) thr = cand;
      }
      const bool sel0 = key[0] >= thr && key[0] != 0u, sel1 = key[1] >= thr && key[1] != 0u;
      const unsigned long long b0 = __ballot(sel0), b1 = __ballot(sel1);
      const unsigned w0 = (unsigned)b0, w1 = (unsigned)(b0 >> 32), w2 = (unsigned)b1, w3 = (unsigned)(b1 >> 32);
      if (lane == 0) { selmask[q * 4 + 0] = w0; selmask[q * 4 + 1] = w1; selmask[q * 4 + 2] = w2; selmask[q * 4 + 3] = w3; }
      um0 |= w0; um1 |= w1; um2 |= w2; um3 |= w3;
    }
    if (lane == 0) { atomicOr(&unionm[0], um0); atomicOr(&unionm[1], um1); atomicOr(&unionm[2], um2); atomicOr(&unionm[3], um3); }
  }
  __syncthreads();
#pragma unroll
  for (int nt = 0; nt < NQT; ++nt) {
    const float g0 = gate(nt, 0);
#pragma unroll
    for (int dt = 0; dt < 4; ++dt)
#pragma unroll
      for (int r = 0; r < 4; ++r) stash[((dt * NQT + nt) * 4 + r) * 256 + tid] = g0 * st.o[dt][nt][r];
  }

  attn_reset(st);
  {
    TileSrc ts;
    ts.kbase = p.Y + tokbase * LDY + C_KS + g * 64; ts.krs = LDY;
    ts.vbase = p.YT + (size_t)(R_VS + g * 64) * LDT + tokbase; ts.vrs = LDT;
    const unsigned u0 = unionm[0], u1 = unionm[1], u2 = unionm[2], u3 = unionm[3];
    int wd = 0;
    unsigned um = u0;
    tile_loop<true>(lds, tid, ts,
      [&]() -> int {
        for (;;) {
          while (um == 0u && wd < 3) { ++wd; um = wd == 1 ? u1 : (wd == 2 ? u2 : u3); }
          if (um == 0u) return -1;
          const int bit = __builtin_ctz(um);
          um &= um - 1;
          const int pos = (wd * 32 + bit) * 64;
          if ((float)(t0 - pos - 63) <= skipd_g) return pos;
        }
      },
      [&](int pos0, const bf16_t* tb) {
        if ((float)(t0 - pos0 - 63) > skipd) return;
        const int m = pos0 >> 6;
        unsigned selbit[NQT];
#pragma unroll
        for (int nt = 0; nt < NQT; ++nt) selbit[nt] = (selmask[(nt * 16 + lr) * 4 + (m >> 5)] >> (m & 31)) & 1u;
        attn_tile(st, qf, tb, pos0 - t0, lr, selbit, 1 << 30, m >= qb, c1, slope2, quad);
      });
  }
#pragma unroll
  for (int nt = 0; nt < NQT; ++nt) {
    float l = st.l[nt];
    l += __shfl_xor(l, 16); l += __shfl_xor(l, 32);
    const float f = gate(nt, 1) / l;
#pragma unroll
    for (int dt = 0; dt < 4; ++dt)
#pragma unroll
      for (int r = 0; r < 4; ++r) stash[((dt * NQT + nt) * 4 + r) * 256 + tid] += f * st.o[dt][nt][r];
  }
  attn_reset(st);
  {
    unsigned one[NQT];
#pragma unroll
    for (int nt = 0; nt < NQT; ++nt) one[nt] = 1u;
    int pstart = (t0 - 512) & ~63;
    if (pstart < 0) pstart = 0;
    TileSrc ts;
    ts.kbase = p.Y + tokbase * LDY + C_KW + g * 64; ts.krs = LDY;
    ts.vbase = p.YT + (size_t)(R_VW + g * 64) * LDT + tokbase; ts.vrs = LDT;
    int pp = pstart;
    tile_loop<true>(lds, tid, ts, [&]() -> int { const int r = pp < t0 + 32 ? pp : -1; pp += 64; return r; },
      [&](int pos0, const bf16_t* tb) {
        const int rel0 = pos0 - t0;
        if ((float)(-rel0 - 63) > skipd) return;
        attn_tile(st, qf, tb, rel0, lr, one, 511, !(rel0 + 63 <= 0 && rel0 >= 31 - 511), c1, slope2, quad);
      });
  }
#pragma unroll
  for (int nt = 0; nt < NQT; ++nt) {
    float l = st.l[nt];
    l += __shfl_xor(l, 16); l += __shfl_xor(l, 32);
    const float f = gate(nt, 2) / l;
    float ss = 0.f;
#pragma unroll
    for (int dt = 0; dt < 4; ++dt)
#pragma unroll
      for (int r = 0; r < 4; ++r) {
        const float v = stash[((dt * NQT + nt) * 4 + r) * 256 + tid] + f * st.o[dt][nt][r];
        st.o[dt][nt][r] = v;
        ss += v * v;
      }
    ss += __shfl_xor(ss, 16); ss += __shfl_xor(ss, 32);
    const float rstd = rsqrtf(ss * (1.0f / 64.0f) + 1e-6f);
#pragma unroll
    for (int dt = 0; dt < 4; ++dt) {
      const int d = dt * 16 + quad * 4;
      const f32x4 gn = *(const f32x4*)(p.g_nsa + h * 64 + d);
      *(u32x2*)(p.Omix + (tokbase + tq0 + nt * 16) * D + h * 64 + d) =
          (u32x2){pk_bf16(st.o[dt][nt][0] * rstd * gn[0], st.o[dt][nt][1] * rstd * gn[1]),
                  pk_bf16(st.o[dt][nt][2] * rstd * gn[2], st.o[dt][nt][3] * rstd * gn[3])};
    }
  }
  __syncthreads();
}

DEV void publish_unit(unsigned* cnt) {
  asm volatile("s_waitcnt vmcnt(0)" ::: "memory");
  __syncthreads();
  if (threadIdx.x == 0) {
    __builtin_amdgcn_fence(__ATOMIC_RELEASE, "agent");
    asm volatile("s_waitcnt vmcnt(0)" ::: "memory");
    __hip_atomic_fetch_add(cnt, 1u, __ATOMIC_RELAXED, __HIP_MEMORY_SCOPE_AGENT);
  }
}
DEV void phase5(const Params& p, char* lds, int GP, unsigned* ready_cnt) {
  const int bid = blockIdx.x;
  if (bid >= GP) return;
  for (int r = 0; r * GP < 6144; ++r) {
    const int v = r * GP + ((r & 1) ? GP - 1 - bid : bid);
    if (v >= 6144) continue;
    const int step = v / 24, within = v - step * 24, q32 = 255 - step, chunk = q32 >> 2;
    if (within < 16) {
      const int bb = within >> 2;
      nsa_unit(p, (bb << 10) | ((within & 3) << 8) | q32, lds);
      publish_unit(ready_cnt + 16 * (bb * 64 + chunk));
    } else {
      const int j = (step & 3) * 8 + (within - 16), bb = j >> 3, hh = j & 7;
      ret_out_unit(p, (bb << 9) | (hh << 6) | chunk);
      publish_unit(ready_cnt + 16 * (bb * 64 + chunk));
    }
  }
}

DEV int order_key(float v, int idx) {
  int bits = __float_as_int(v);
  bits ^= (bits >> 31) & 0x7fffffff;
  return (bits & ~0x7f) | (127 - idx);
}
DEV float key_val(int key) {
  int bits = key & ~0x7f;
  bits ^= (bits >> 31) & 0x7fffffff;
  return __int_as_float(bits);
}

DEV void peer_unit(const Params& p, int u, char* lds) {
  const int tid = opaque_tid(), lane = tid & 63, w = tid >> 6, lr = lane & 15, quad = lane >> 4;
  const int t0 = u * 16;
  int* sc = (int*)lds;
  int* tk = (int*)(lds + 16384);
  float* cval = (float*)(lds + 18432);
  int* exi = (int*)(lds + 22528);
  float* exg = (float*)(lds + 30720);
  for (int h = 0; h < 8; ++h) {
    {
      const int pp = w >> 1, nt0 = (w & 1) * 4;
      bf16x8 af[4];
#pragma unroll
      for (int ks = 0; ks < 4; ++ks) af[ks] = ld8(p.Qp + (size_t)(t0 + lr) * D + h * 256 + pp * 128 + ks * 32 + quad * 8);
#pragma unroll
      for (int nn = 0; nn < 4; ++nn) {
        const int nt = nt0 + nn;
        f32x4 acc = (f32x4){0.f, 0.f, 0.f, 0.f};
#pragma unroll
        for (int ks = 0; ks < 4; ++ks)
          acc = mfma16(af[ks], ld8(p.SK + ((size_t)((h * 2 + pp) * 128 + nt * 16 + lr)) * 128 + ks * 32 + quad * 8), acc);
#pragma unroll
        for (int r = 0; r < 4; ++r) sc[(pp * 16 + quad * 4 + r) * 128 + nt * 16 + lr] = order_key(acc[r], nt * 16 + lr);
      }
    }
    __syncthreads();
    for (int rr = 0; rr < 8; rr += 2) {
      const int rowA = w * 8 + rr, rowB = rowA + 1;
      const int a0 = sc[rowA * 128 + lane], a1 = sc[rowA * 128 + 64 + lane], b0 = sc[rowB * 128 + lane], b1 = sc[rowB * 128 + 64 + lane];
      const unsigned ua0 = (unsigned)a0 ^ 0x80000000u, ua1 = (unsigned)a1 ^ 0x80000000u, ub0 = (unsigned)b0 ^ 0x80000000u, ub1 = (unsigned)b1 ^ 0x80000000u;
      unsigned thA = 0u, thB = 0u;
#pragma unroll 1
      for (int bit = 31; bit >= 0; --bit) {
        const unsigned cA = thA | (1u << bit), cB = thB | (1u << bit);
        const int nA = __popcll(__ballot(ua0 >= cA)) + __popcll(__ballot(ua1 >= cA));
        const int nB = __popcll(__ballot(ub0 >= cB)) + __popcll(__ballot(ub1 >= cB));
        if (nA >= 16) thA = cA;
        if (nB >= 16) thB = cB;
      }
      const unsigned long long lt = (1ull << lane) - 1ull;
      {
        const unsigned long long m0 = __ballot(ua0 >= thA), m1 = __ballot(ua1 >= thA);
        if (ua0 >= thA) tk[rowA * 16 + __popcll(m0 & lt)] = a0;
        if (ua1 >= thA) tk[rowA * 16 + __popcll(m0) + __popcll(m1 & lt)] = a1;
      }
      {
        const unsigned long long m0 = __ballot(ub0 >= thB), m1 = __ballot(ub1 >= thB);
        if (ub0 >= thB) tk[rowB * 16 + __popcll(m0 & lt)] = b0;
        if (ub1 >= thB) tk[rowB * 16 + __popcll(m0) + __popcll(m1 & lt)] = b1;
      }
      if (lane < 32) {
        const int row = lane < 16 ? rowA : rowB, me = lane & 15;
        const int4 q0 = *(const int4*)(tk + row * 16), q1 = *(const int4*)(tk + row * 16 + 4), q2 = *(const int4*)(tk + row * 16 + 8), q3 = *(const int4*)(tk + row * 16 + 12);
        const int mine = tk[row * 16 + me];
        const int rank = (q0.x > mine) + (q0.y > mine) + (q0.z > mine) + (q0.w > mine) + (q1.x > mine) + (q1.y > mine) + (q1.z > mine) + (q1.w > mine) +
                         (q2.x > mine) + (q2.y > mine) + (q2.z > mine) + (q2.w > mine) + (q3.x > mine) + (q3.y > mine) + (q3.z > mine) + (q3.w > mine);
        tk[row * 16 + rank] = mine;
      }
    }
    __syncthreads();
    for (int tt = 0; tt < 4; ++tt) {
      const int tok = w * 4 + tt;
      int a = -1, bq = 0;
      {
        int c = lane;
        if (c < 16) { a = 0; bq = c; }
        else if (c < 24) { a = 1; bq = c - 16; }
        else if (c < 29) { a = 2; bq = c - 24; }
        else if (c < 33) { a = 3; bq = c - 29; }
        else if (c < 36) { a = 4; bq = c - 33; }
        else if (c < 38) { a = 5; bq = c - 36; }
        else if (c < 40) { a = 6; bq = c - 38; }
        else if (c < 42) { a = 7; bq = c - 40; }
        else if (c < 50) { a = c - 34; bq = 0; }
      }
      const bool act = a >= 0;
      const int ka = tk[(0 * 16 + tok) * 16 + (act ? a : 0)], kb = tk[(1 * 16 + tok) * 16 + bq];
      const float myv = act ? key_val(ka) + key_val(kb) : -3.0e38f;
      float* cv = cval + tok * 64;
      cv[lane] = myv;
      int rank = 0;
      for (int j = 0; j < 50; ++j) {
        const float vj = cv[j];
        rank += (vj > myv) || (vj == myv && j < lane);
      }
      float mx = act && rank == 0 ? myv : -3.0e38f;
#pragma unroll
      for (int o = 32; o >= 1; o >>= 1) mx = fmaxf(mx, __shfl_xor(mx, o));
      const bool win = act && rank < 16;
      const float ev = win ? __expf(myv - mx) : 0.f;
      const float sum = wave_sum(ev);
      if (win) {
        const int i0 = 127 - (ka & 0x7f), i1 = 127 - (kb & 0x7f);
        exi[tok * 128 + h * 16 + rank] = i0 * 128 + i1;
        exg[tok * 128 + h * 16 + rank] = ev / sum;
      }
    }
    __syncthreads();
  }
  for (int tt = 0; tt < 4; ++tt) {
    const int tok = w * 4 + tt;
    const size_t gt = (size_t)t0 + tok;
    const int b = (int)(gt / S);
    float hf[32];
#pragma unroll
    for (int i = 0; i < 2; ++i)
#pragma unroll
      for (int hh = 0; hh < 2; ++hh) {
        const u32x4 hv = *(const u32x4*)(p.H2 + gt * D + (i * 64 + lane) * 16 + hh * 8);
#pragma unroll
        for (int j = 0; j < 4; ++j) { hf[i * 16 + hh * 8 + 2 * j] = bf_lo(hv[j]); hf[i * 16 + hh * 8 + 2 * j + 1] = bf_hi(hv[j]); }
      }
    auto load_rows = [&](u32x4 (&r)[8], const unsigned char* base, int e0) {
#pragma unroll
      for (int k = 0; k < 4; ++k) {
        const unsigned char* rp = base + (size_t)exi[tok * 128 + e0 + k] * D + lane * 16;
        r[2 * k] = *(const u32x4*)rp; r[2 * k + 1] = *(const u32x4*)(rp + 1024);
      }
    };
    auto dot_rows = [&](const u32x4 (&r)[8], int e0) {
      float sv[4];
#pragma unroll
      for (int k = 0; k < 4; ++k) {
        float sa = 0.f, sb = 0.f;
#pragma unroll
        for (int j = 0; j < 4; ++j) {
          const f32x2v a0 = __builtin_amdgcn_cvt_pk_f32_fp8((int)r[2 * k][j], false), a1 = __builtin_amdgcn_cvt_pk_f32_fp8((int)r[2 * k][j], true);
          const f32x2v b0 = __builtin_amdgcn_cvt_pk_f32_fp8((int)r[2 * k + 1][j], false), b1 = __builtin_amdgcn_cvt_pk_f32_fp8((int)r[2 * k + 1][j], true);
          sa += a0[0] * hf[j * 4 + 0] + a0[1] * hf[j * 4 + 1] + a1[0] * hf[j * 4 + 2] + a1[1] * hf[j * 4 + 3];
          sb += b0[0] * hf[16 + j * 4 + 0] + b0[1] * hf[16 + j * 4 + 1] + b1[0] * hf[16 + j * 4 + 2] + b1[1] * hf[16 + j * 4 + 3];
        }
        sv[k] = sa + sb;
      }
      float r2[2], r1;
      const bool h32 = (lane & 32) != 0, h16 = (lane & 16) != 0;
#pragma unroll
      for (int k = 0; k < 2; ++k) { const float mine = h32 ? sv[k + 2] : sv[k], oth = h32 ? sv[k] : sv[k + 2]; r2[k] = mine + __shfl_xor(oth, 32); }
      { const float mine = h16 ? r2[1] : r2[0], oth = h16 ? r2[0] : r2[1]; r1 = mine + __shfl_xor(oth, 16); }
      r1 += __shfl_xor(r1, 8); r1 += __shfl_xor(r1, 4); r1 += __shfl_xor(r1, 2); r1 += __shfl_xor(r1, 1);
      if ((lane & 15) == 0) {
        const int k = (h32 ? 2 : 0) + (h16 ? 1 : 0);
        const int ei = tok * 128 + e0 + k;
        exg[ei] = exg[ei] * gelu_tanh(r1 * (1.0f / U8_SCALE)) * (1.0f / V8_SCALE);
      }
    };
    u32x4 ra[8], rb[8];
    load_rows(ra, p.U8, 0);
#pragma unroll 1
    for (int e0 = 0; e0 < 128; e0 += 8) {
      load_rows(rb, p.U8, e0 + 4);
      dot_rows(ra, e0);
      load_rows(ra, p.U8, e0 + 8 < 128 ? e0 + 8 : 124);
      dot_rows(rb, e0 + 4);
    }
    float oacc[32];
#pragma unroll
    for (int i = 0; i < 32; ++i) oacc[i] = 0.f;
    auto acc_rows = [&](const u32x4 (&r)[8], int e0) {
#pragma unroll
      for (int k = 0; k < 4; ++k) {
        const float coef = exg[tok * 128 + e0 + k];
#pragma unroll
        for (int j = 0; j < 4; ++j) {
          const f32x2v a0 = __builtin_amdgcn_cvt_pk_f32_fp8((int)r[2 * k][j], false), a1 = __builtin_amdgcn_cvt_pk_f32_fp8((int)r[2 * k][j], true);
          const f32x2v b0 = __builtin_amdgcn_cvt_pk_f32_fp8((int)r[2 * k + 1][j], false), b1 = __builtin_amdgcn_cvt_pk_f32_fp8((int)r[2 * k + 1][j], true);
          oacc[j * 4 + 0] += coef * a0[0]; oacc[j * 4 + 1] += coef * a0[1]; oacc[j * 4 + 2] += coef * a1[0]; oacc[j * 4 + 3] += coef * a1[1];
          oacc[16 + j * 4 + 0] += coef * b0[0]; oacc[16 + j * 4 + 1] += coef * b0[1]; oacc[16 + j * 4 + 2] += coef * b1[0]; oacc[16 + j * 4 + 3] += coef * b1[1];
        }
      }
    };
    load_rows(ra, p.V8, 0);
#pragma unroll 1
    for (int e0 = 0; e0 < 128; e0 += 8) {
      load_rows(rb, p.V8, e0 + 4);
      acc_rows(ra, e0);
      load_rows(ra, p.V8, e0 + 8 < 128 ? e0 + 8 : 124);
      acc_rows(rb, e0 + 4);
    }
    const float* g2 = p.mod + (size_t)b * 12288 + 5 * D;
    float ss = 0.f;
#pragma unroll
    for (int i = 0; i < 2; ++i)
#pragma unroll
      for (int q4 = 0; q4 < 4; ++q4) {
        const int col = (i * 64 + lane) * 16 + q4 * 4;
        const f32x4 x1 = *(const f32x4*)(p.X1 + gt * D + col), gg = *(const f32x4*)(g2 + col);
#pragma unroll
        for (int j = 0; j < 4; ++j) {
          const float v = x1[j] + gg[j] * oacc[i * 16 + q4 * 4 + j];
          oacc[i * 16 + q4 * 4 + j] = v;
          ss += v * v;
        }
      }
    ss = wave_sum(ss);
    const float rstd = rsqrtf(ss * (1.0f / D) + 1e-6f);
#pragma unroll
    for (int i = 0; i < 2; ++i)
#pragma unroll
      for (int q4 = 0; q4 < 4; ++q4) {
        const int col = (i * 64 + lane) * 16 + q4 * 4;
        const f32x4 gf = *(const f32x4*)(p.g_final + col);
        f32x4 o;
#pragma unroll
        for (int j = 0; j < 4; ++j) o[j] = oacc[i * 16 + q4 * 4 + j] * rstd * gf[j];
        *(f32x4*)(p.out + gt * D + col) = o;
      }
  }
  __syncthreads();
}

DEV void phase9(const Params& p, char* lds) {
  for (int u = blockIdx.x; u < T / 16; u += gridDim.x) peer_unit(p, u, lds);
}
DEV void phase9_dynamic(const Params& p, char* lds, unsigned* unit_cnt, unsigned* panel_cnt) {
  int* slot = (int*)(lds + LDS_BYTES - 16);
  for (;;) {
    __syncthreads();
    if (threadIdx.x == 0) {
      const int u = (int)__hip_atomic_fetch_add(unit_cnt, 1u, __ATOMIC_RELAXED, __HIP_MEMORY_SCOPE_AGENT);
      if (u < T / 16) {
        while (__hip_atomic_load(panel_cnt + 16 * (u >> 3), __ATOMIC_RELAXED, __HIP_MEMORY_SCOPE_AGENT) < 16u) __builtin_amdgcn_s_sleep(8);
        __builtin_amdgcn_fence(__ATOMIC_ACQUIRE, "agent");
        asm volatile("s_waitcnt vmcnt(0)" ::: "memory");
      }
      *slot = u;
    }
    __syncthreads();
    const int u = *slot;
    if (u >= T / 16) break;
    peer_unit(p, u, lds);
  }
}

DEV void gbar(unsigned* bar, unsigned& gen) {
  asm volatile("s_waitcnt vmcnt(0) lgkmcnt(0)" ::: "memory");
  __syncthreads();
  gen += 1u;
  if (threadIdx.x == 0) {
    __builtin_amdgcn_fence(__ATOMIC_RELEASE, "agent");
    asm volatile("s_waitcnt vmcnt(0)" ::: "memory");
    const unsigned G = gridDim.x, bidx = blockIdx.x;
    if ((G & 63u) == 0u) {
      const unsigned x = bidx & 7u, j = bidx >> 3, n2 = G >> 6;
      unsigned* c1 = bar + 64 * (x * 8 + (j >> 3));
      unsigned* c2 = bar + 64 * (64 + x);
      unsigned* c3 = bar + 64 * 72;
      unsigned* flag = bar + 64 * (73 + x);
      if (__hip_atomic_fetch_add(c1, 1u, __ATOMIC_RELAXED, __HIP_MEMORY_SCOPE_AGENT) + 1u == gen * 8u)
        if (__hip_atomic_fetch_add(c2, 1u, __ATOMIC_RELAXED, __HIP_MEMORY_SCOPE_AGENT) + 1u == gen * n2)
          if (__hip_atomic_fetch_add(c3, 1u, __ATOMIC_RELAXED, __HIP_MEMORY_SCOPE_AGENT) + 1u == gen * 8u)
            for (unsigned k = 0; k < 8u; ++k) __hip_atomic_store(bar + 64 * (73 + k), gen, __ATOMIC_RELAXED, __HIP_MEMORY_SCOPE_AGENT);
      while (__hip_atomic_load(flag, __ATOMIC_RELAXED, __HIP_MEMORY_SCOPE_AGENT) < gen) __builtin_amdgcn_s_sleep(2);
    } else {
      unsigned* c = bar + 64 * 72;
      __hip_atomic_fetch_add(c, 1u, __ATOMIC_RELAXED, __HIP_MEMORY_SCOPE_AGENT);
      while (__hip_atomic_load(c, __ATOMIC_RELAXED, __HIP_MEMORY_SCOPE_AGENT) < gen * G) __builtin_amdgcn_s_sleep(2);
    }
    __builtin_amdgcn_fence(__ATOMIC_ACQUIRE, "agent");
    asm volatile("s_waitcnt vmcnt(0)" ::: "memory");
  }
  __syncthreads();
}

__global__ void __launch_bounds__(256, 2) mega(Params p_unused) {
  __shared__ __attribute__((aligned(16))) char lds[LDS_BYTES];
  cg::grid_group grid = cg::this_grid();
  const Params& p = *(const Params*)__builtin_amdgcn_kernarg_segment_ptr();
  const int lo = p.ph_lo, hi = p.ph_hi;
  unsigned gen = 0u;
  if (hi > lo) grid.sync();
#ifndef ONLY
#define ONLY -1
#endif
#ifndef REP
#define REP -1
#endif
#define PH_ON(n) ((ONLY < 0 || ONLY == (n)) && lo <= (n) && (n) <= hi)
#define RP(n) for (int rep_ = 0; rep_ < ((REP == (n)) ? 2 : 1); ++rep_)
#define SYNC_AFTER(n) if (lo <= (n) && (n) < hi) gbar(p.bar, gen);
  if (PH_ON(0)) RP(0) phase0(p, lds);
  SYNC_AFTER(0)
  if (PH_ON(1)) phase1(p);
  SYNC_AFTER(1)
  if (PH_ON(2)) RP(2) rms_mod_phase(p.x, p.g_mix, p.mod, 0, 1, p.H);
  SYNC_AFTER(2)
  if (PH_ON(3)) RP(3) { Epi1 e{p.Y, p.YT}; gemm_phase(p.H, p.WinT, T, LDY, D, lds, e); conv_drain(p, lds); }
  SYNC_AFTER(3)
  if (PH_ON(4)) RP(4) phase4(p, lds);
  SYNC_AFTER(4)
  if (PH_ON(5)) {
    const int G = gridDim.x, NC = G >= 512 ? 64 : 0;
    unsigned* ready = p.bar + 12288;
    phase5(p, lds, G - NC, ready);
    Epi2 e{p.x, p.mod, p.X1};
    gemm_phase(p.Omix, p.WoutT, T, D, D, lds, e, 0, nullptr, p.bar + 64 * 102, ready, 24u);
  }
  SYNC_AFTER(6)
  if (PH_ON(7)) RP(7) rms_mod_phase(p.X1, p.g_ffn, p.mod, 3, 4, p.H2);
  SYNC_AFTER(7)
  if (PH_ON(8)) {
    Epi3 e{p.Qp};
    unsigned* panel_cnt = p.bar + 8192;
    gemm_phase(p.H2, p.WqT, T, D, D, lds, e, (int)gridDim.x >= 256 ? 128 : (int)gridDim.x, panel_cnt);
    phase9_dynamic(p, lds, p.bar + 64 * 101, panel_cnt);
  }
}

extern "C" void kernel_launch(void* const* d_in, const int* in_sizes, int n_in, void* d_out, int out_size, void* d_ws, size_t ws_size,
                              hipStream_t stream) {
  static int grid_blocks = 0;
  if (!grid_blocks) {
    int dev = 0, cus = 0, per_cu = 0;
    (void)hipGetDevice(&dev);
    (void)hipDeviceGetAttribute(&cus, hipDeviceAttributeMultiprocessorCount, dev);
    (void)hipOccupancyMaxActiveBlocksPerMultiprocessor(&per_cu, mega, 256, 0);
    if (per_cu < 1) per_cu = 1;
    if (per_cu > 2) per_cu = 2;
    grid_blocks = cus * per_cu;
  }
  Params p;
  memset(&p, 0, sizeof(p));
  const float* const* in = (const float* const*)d_in;
  p.x = in[0]; p.c = in[1]; p.w_ada = in[2]; p.b_ada = in[3]; p.g_mix = in[4]; p.g_ffn = in[5]; p.g_final = in[6]; p.w_in = in[7];
  p.pe_k = in[8]; p.pe_v = in[9]; p.ck_w1 = in[10]; p.ck_w2 = in[11]; p.cv_w1 = in[12]; p.cv_w2 = in[13]; p.g_nsa = in[14];
  p.g_ret = in[15]; p.w_out = in[16]; p.w_q = in[17]; p.sub_keys = in[18]; p.peer_u = in[19]; p.peer_v = in[20];
  p.out = (float*)d_out;
  char* ws = (char*)d_ws;
  size_t off = 0;
  auto take = [&](size_t bytes) { char* r = ws + off; off += (bytes + 255) & ~(size_t)255; return r; };
  p.bar = (unsigned*)take(65536);
  p.mod_part = (float*)take((size_t)16 * 4 * 12288 * 4);
  p.mod = (float*)take((size_t)4 * 12288 * 4);
  p.cbias = (float*)take((size_t)2 * 32 * 128 * 4);
  p.WinT = (bf16_t*)take((size_t)LDY * 2048 * 2);
  p.WoutT = (bf16_t*)take((size_t)2048 * 2048 * 2);
  p.WqT = (bf16_t*)take((size_t)2048 * 2048 * 2);
  p.SK = (bf16_t*)take((size_t)8 * 2 * 128 * 128 * 2);
  p.U8 = (unsigned char*)take((size_t)16384 * 2048);
  p.V8 = (unsigned char*)take((size_t)16384 * 2048);
  p.w1T = (bf16_t*)take((size_t)2 * 128 * 2048 * 2);
  p.w2T = (bf16_t*)take((size_t)2 * 64 * 128 * 2);
  p.Kc = (bf16_t*)take((size_t)16 * 512 * 64 * 2);
  p.VcT = (bf16_t*)take((size_t)16 * 64 * 512 * 2);
  p.RT = (bf16_t*)take((size_t)32 * 64 * 16384 * 2);
  p.H = (bf16_t*)take((size_t)T * D * 2);
  p.Omix = p.H;
  p.Y = (bf16_t*)take((size_t)T * LDY * 2);
  p.X1 = (float*)d_out;
  p.H2 = (bf16_t*)p.Y;
  p.YT = (bf16_t*)take((size_t)NYT * LDT * 2);
  p.Qp = p.YT;
  if (off > ws_size) fprintf(stderr, "workspace too small: need %zu have %zu\n", off, ws_size);
  p.ph_lo = 0; p.ph_hi = 9;
  (void)hipMemsetAsync(p.bar, 0, 65536, stream);
  void* args[] = {&p};
  hipError_t e = hipLaunchCooperativeKernel((void*)mega, dim3(grid_blocks), dim3(256), args, 0, stream);
  if (e != hipSuccess) fprintf(stderr, "cooperative launch failed: %s (grid %d)\n", hipGetErrorString(e), grid_blocks);
}
```

```cpp
#include <hip/hip_runtime.h>
#include <hip/hip_cooperative_groups.h>
#include <stdint.h>
#include <cstdio>
#include <cstring>
namespace cg = cooperative_groups;

#define DEV __device__ __forceinline__
typedef unsigned short bf16_t;
typedef short bf16x8 __attribute__((ext_vector_type(8)));
typedef float f32x4 __attribute__((ext_vector_type(4)));
typedef unsigned u32x4 __attribute__((ext_vector_type(4)));
typedef unsigned u32x2 __attribute__((ext_vector_type(2)));

constexpr int D = 2048, NB = 4, S = 8192, T = NB * S;
constexpr int LDY = 6784;
constexpr int LDT = T + 192;
constexpr int C_QA = 0, C_KC = 1024, C_VC = 1280, C_KS = 1536, C_VS = 1792, C_KW = 2048, C_VW = 2304,
              C_QR = 2560, C_KR = 3584, C_VR = 4608, C_GR = 5632, C_GA = 6656;
constexpr int R_VS = 0, R_VW = 256, R_KR = 512, R_VR = 1536, NYT = 2560;
constexpr int LDS_BYTES = 73728;
constexpr float LOG2E = 1.4426950408889634f;

struct Params {
  const float *x, *c, *w_ada, *b_ada, *g_mix, *g_ffn, *g_final, *w_in, *pe_k, *pe_v, *ck_w1, *ck_w2, *cv_w1, *cv_w2,
      *g_nsa, *g_ret, *w_out, *w_q, *sub_keys, *peer_u, *peer_v;
  float* out;
  float *mod_part, *mod, *cbias, *X1;
  unsigned* bar;
  unsigned char *U8, *V8;
  bf16_t *WinT, *WoutT, *WqT, *SK, *w1T, *w2T, *H, *Y, *YT, *Kc, *VcT, *RT, *H2, *Qp, *Omix;
  int ph_lo, ph_hi;
};

typedef __bf16 bf16v2_t __attribute__((ext_vector_type(2)));
typedef float f32x2_t __attribute__((ext_vector_type(2)));
DEV unsigned pk_bf16(float lo, float hi) {
  const bf16v2_t r = __builtin_convertvector((f32x2_t){lo, hi}, bf16v2_t);
  return __builtin_bit_cast(unsigned, r);
}
DEV float bf_lo(unsigned w) { return __uint_as_float(w << 16); }
DEV float bf_hi(unsigned w) { return __uint_as_float(w & 0xffff0000u); }
DEV float bf2f(bf16_t h) { return __uint_as_float(((unsigned)h) << 16); }
DEV float ex2(float x) { return __builtin_amdgcn_exp2f(x); }
DEV float sigmoidf_(float x) { return 1.0f / (1.0f + __expf(-x)); }
DEV float gelu_tanh(float x) {
  float u = 0.7978845608028654f * (x + 0.044715f * x * x * x);
  float t = 1.0f - 2.0f / (__expf(2.0f * u) + 1.0f);
  return 0.5f * x * (1.0f + t);
}
DEV f32x4 mfma16(bf16x8 a, bf16x8 b, f32x4 c) { return __builtin_amdgcn_mfma_f32_16x16x32_bf16(a, b, c, 0, 0, 0); }
DEV bf16x8 ld8(const bf16_t* p) { return *(const bf16x8*)p; }
DEV bf16x8 as_bf8(u32x4 v) { return __builtin_bit_cast(bf16x8, v); }
DEV float wave_sum(float v) {
#pragma unroll
  for (int o = 32; o >= 1; o >>= 1) v += __shfl_xor(v, o);
  return v;
}


DEV int opaque_tid() { int t = threadIdx.x; asm volatile("" : "+v"(t)); return t; }

DEV void transpose_tile(const float* __restrict__ src, int ld_src, int mode, bf16_t* __restrict__ dst, int Kdim, int n0, int k0,
                        float* tile) {
  const int tid = threadIdx.x, tx = tid & 63, ty = tid >> 6;
  const int n = n0 + tx;
  int sc = n;
  bool ok = true;
  if (mode == 1) {
    if (n < 2560) sc = n;
    else if (n < 6656) sc = n + 48;
    else if (n < 6704) sc = n - 6656 + 2560;
    else { sc = 0; ok = false; }
  }
#pragma unroll
  for (int i = 0; i < 16; ++i) {
    const int kk = ty + 4 * i;
    tile[kk * 65 + tx] = ok ? src[(size_t)(k0 + kk) * ld_src + sc] : 0.f;
  }
  __syncthreads();
  const int nn = tid >> 2, kc = (tid & 3) * 16;
  unsigned w[8];
#pragma unroll
  for (int j = 0; j < 8; ++j) w[j] = pk_bf16(tile[(kc + 2 * j) * 65 + nn], tile[(kc + 2 * j + 1) * 65 + nn]);
  u32x4* d = (u32x4*)(dst + (size_t)(n0 + nn) * Kdim + k0 + kc);
  d[0] = (u32x4){w[0], w[1], w[2], w[3]};
  d[1] = (u32x4){w[4], w[5], w[6], w[7]};
  __syncthreads();
}

DEV void convert_unit(const float* __restrict__ src, bf16_t* __restrict__ dst, int unit) {
  const int tid = threadIdx.x;
#pragma unroll
  for (int i = 0; i < 4; ++i) {
    const size_t e = (size_t)unit * 8192 + i * 2048 + tid * 8;
    const f32x4 a = *(const f32x4*)(src + e), b = *(const f32x4*)(src + e + 4);
    *(u32x4*)(dst + e) = (u32x4){pk_bf16(a[0], a[1]), pk_bf16(a[2], a[3]), pk_bf16(b[0], b[1]), pk_bf16(b[2], b[3])};
  }
}

typedef float f32x2v __attribute__((ext_vector_type(2)));
DEV unsigned pk4_fp8(float a, float b, float c, float d) {
  int w = __builtin_amdgcn_cvt_pk_fp8_f32(a, b, 0, false);
  w = __builtin_amdgcn_cvt_pk_fp8_f32(c, d, w, true);
  return (unsigned)w;
}
DEV void convert_unit_fp8(const float* __restrict__ src, unsigned char* __restrict__ dst, int unit, float scale) {
  const int tid = threadIdx.x;
#pragma unroll
  for (int i = 0; i < 2; ++i) {
    const size_t e = (size_t)unit * 8192 + i * 4096 + tid * 16;
    f32x4 a[4];
#pragma unroll
    for (int j = 0; j < 4; ++j) a[j] = *(const f32x4*)(src + e + 4 * j) * scale;
    *(u32x4*)(dst + e) = (u32x4){pk4_fp8(a[0][0], a[0][1], a[0][2], a[0][3]), pk4_fp8(a[1][0], a[1][1], a[1][2], a[1][3]),
                                 pk4_fp8(a[2][0], a[2][1], a[2][2], a[2][3]), pk4_fp8(a[3][0], a[3][1], a[3][2], a[3][3])};
  }
}
constexpr float U8_SCALE = 64.0f, V8_SCALE = 4.0f;

DEV void phase0(const Params& p, char* lds) {
  float* fl = (float*)lds;
  const int tid = threadIdx.x;
  constexpr int U_MOD = 768, U_WIN = 106 * 32, U_W1 = 128, U_W2 = 4, U_CB = 32;
  constexpr int TOT = U_MOD + U_WIN + U_W1 + U_W2 + U_CB;
  for (int u0 = blockIdx.x; u0 < TOT; u0 += gridDim.x) {
    int u = u0;
    if (u < U_MOD) {
      const int colblk = u % 48, ks = u / 48;
      for (int i = tid; i < 512; i += 256) {
        const int b = i >> 7, k = i & 127;
        const float cv = p.c[b * D + ks * 128 + k];
        fl[i] = cv * sigmoidf_(cv);
      }
      __syncthreads();
      const int col = colblk * 256 + tid;
      float a0 = 0, a1 = 0, a2 = 0, a3 = 0;
      const float* wp = p.w_ada + (size_t)(ks * 128) * 12288 + col;
#pragma unroll 8
      for (int k = 0; k < 128; ++k) {
        const float w = wp[(size_t)k * 12288];
        a0 += fl[k] * w; a1 += fl[128 + k] * w; a2 += fl[256 + k] * w; a3 += fl[384 + k] * w;
      }
      float* mp = p.mod_part + (size_t)ks * 4 * 12288 + col;
      mp[0] = a0; mp[12288] = a1; mp[2 * 12288] = a2; mp[3 * 12288] = a3;
      __syncthreads();
      continue;
    }
    u -= U_MOD;
    if (u < U_WIN) { transpose_tile(p.w_in, 6704, 1, p.WinT, 2048, (u >> 5) * 64, (u & 31) * 64, fl); continue; }
    u -= U_WIN;
    if (u < U_W1) {
      const int kv = u >> 6, r = u & 63;
      transpose_tile(kv ? p.cv_w1 : p.ck_w1, 128, 0, p.w1T + (size_t)kv * 128 * 2048, 2048, (r >> 5) * 64, (r & 31) * 64, fl);
      continue;
    }
    u -= U_W1;
    if (u < U_W2) {
      const int kv = u >> 1, r = u & 1;
      transpose_tile(kv ? p.cv_w2 : p.ck_w2, 64, 0, p.w2T + (size_t)kv * 64 * 128, 128, 0, r * 64, fl);
      continue;
    }
    u -= U_W2;
    if (u < U_CB) {
      const int kv = u >> 4, ks = u & 15, j = tid & 127, half = tid >> 7;
      const float* pe = kv ? p.pe_v : p.pe_k;
      const float* w1 = kv ? p.cv_w1 : p.ck_w1;
      const int i0 = ks * 128 + half * 64;
      float a = 0.f;
#pragma unroll 8
      for (int i = 0; i < 64; ++i) a += pe[i0 + i] * w1[(size_t)(i0 + i) * 128 + j];
      p.cbias[(kv * 32 + ks * 2 + half) * 128 + j] = a;
      continue;
    }
  }
}

DEV void phase1(const Params& p) {
  const int tid = threadIdx.x;
  for (int u = blockIdx.x; u < 192; u += gridDim.x) {
    const int idx = u * 256 + tid;
    const int col = idx % 12288;
    float a = p.b_ada[col];
#pragma unroll
    for (int ks = 0; ks < 16; ++ks) a += p.mod_part[(size_t)ks * 4 * 12288 + idx];
    p.mod[idx] = a;
  }
}

DEV void rms_mod_phase(const float* __restrict__ xin, const float* __restrict__ g, const float* __restrict__ mod, int shift_idx,
                       int scale_idx, bf16_t* __restrict__ dst) {
  const int lane = threadIdx.x & 63, wid = threadIdx.x >> 6;
  for (int u = blockIdx.x; u < T / 4; u += gridDim.x) {
    const int tok = u * 4 + wid, b = tok / S;
    const float* xr = xin + (size_t)tok * D;
    f32x4 v[8];
    float ss = 0.f;
#pragma unroll
    for (int i = 0; i < 8; ++i) {
      v[i] = *(const f32x4*)(xr + i * 256 + lane * 4);
      ss += v[i][0] * v[i][0] + v[i][1] * v[i][1] + v[i][2] * v[i][2] + v[i][3] * v[i][3];
    }
    ss = wave_sum(ss);
    const float rstd = rsqrtf(ss * (1.0f / D) + 1e-6f);
    const float* sh = mod + (size_t)b * 12288 + shift_idx * D;
    const float* sc = mod + (size_t)b * 12288 + scale_idx * D;
#pragma unroll
    for (int i = 0; i < 8; ++i) {
      const int col = i * 256 + lane * 4;
      const f32x4 gg = *(const f32x4*)(g + col), s1 = *(const f32x4*)(sc + col), s0 = *(const f32x4*)(sh + col);
      float y[4];
#pragma unroll
      for (int j = 0; j < 4; ++j) y[j] = v[i][j] * rstd * gg[j] * (1.0f + s1[j]) + s0[j];
      *(u32x2*)(dst + (size_t)tok * D + col) = (u32x2){pk_bf16(y[0], y[1]), pk_bf16(y[2], y[3])};
    }
  }
}

constexpr int GL = 72;
template <class Epi>
DEV void gemm_phase(const bf16_t* __restrict__ A, const bf16_t* __restrict__ Bt, int M, int N, int K, char* lds, const Epi& epi,
                    int panel_blocks = 0, unsigned* panel_cnt = nullptr, unsigned* claim_cnt = nullptr, unsigned* ready_cnt = nullptr,
                    unsigned ready_need = 0u) {
  bf16_t* sbuf = (bf16_t*)lds;
  const int ntn = N / 128, ntm = M / 128, nk = K / 64;
  const int xcd = blockIdx.x & 7, jb = blockIdx.x >> 3, bpx = (gridDim.x + 7 - xcd) >> 3;
  const int nsgn = (ntn + 7) >> 3, nsuper = (ntm >> 3) * nsgn;
  const int niter = panel_blocks > 0 ? ((int)blockIdx.x < panel_blocks ? (ntm * ntn - (int)blockIdx.x + panel_blocks - 1) / panel_blocks : 0)
                                     : ((nsuper - xcd + 7) >> 3) * (jb < 64 ? (64 - jb + bpx - 1) / bpx : 0);
  const int npb = jb < 64 ? (64 - jb + bpx - 1) / bpx : 0;
  int pend_tm = -1;
  for (int it = 0; claim_cnt != nullptr || it < niter; ++it) {
    int tm, tn;
    if (claim_cnt != nullptr) {
      int* slot = (int*)(lds + LDS_BYTES - 16);
      __syncthreads();
      if (threadIdx.x == 0) {
        const int i = (int)__hip_atomic_fetch_add(claim_cnt, 1u, __ATOMIC_RELAXED, __HIP_MEMORY_SCOPE_AGENT);
        if (i < ntm * ntn) {
          const int k = i / ntn, tmw = (k & 3) * 64 + (63 - (k >> 2));
          while (__hip_atomic_load(ready_cnt + 16 * tmw, __ATOMIC_RELAXED, __HIP_MEMORY_SCOPE_AGENT) < ready_need) __builtin_amdgcn_s_sleep(8);
          __builtin_amdgcn_fence(__ATOMIC_ACQUIRE, "agent");
          asm volatile("s_waitcnt vmcnt(0)" ::: "memory");
        }
        *slot = i;
      }
      __syncthreads();
      const int i = *slot;
      if (i >= ntm * ntn) break;
      const int k = i / ntn;
      tm = (k & 3) * 64 + (63 - (k >> 2)); tn = i - k * ntn;
    } else if (panel_blocks > 0) { const int i = (int)blockIdx.x + it * panel_blocks; tm = i / ntn; tn = i - tm * ntn; }
    else {
      const int sidx = xcd + 8 * (it / npb), jj = jb + bpx * (it % npb);
      tm = (sidx / nsgn) * 8 + (jj >> 3); tn = (sidx % nsgn) * 8 + (jj & 7);
      if (tn >= ntn) continue;
    }
    const int tid = opaque_tid(), lane = tid & 63, wid = tid >> 6, wm = wid >> 1, wn = wid & 1, lr = lane & 15, quad = lane >> 4;
    const int srow = tid >> 3, skc = (tid & 7) * 8;
    const bf16_t* Ag = A + (size_t)(tm * 128 + srow) * K + skc;
    const bf16_t* Bg = Bt + (size_t)(tn * 128 + srow) * K + skc;
    f32x4 acc[4][4];
#pragma unroll
    for (int i = 0; i < 4; ++i)
#pragma unroll
      for (int j = 0; j < 4; ++j) acc[i][j] = (f32x4){0.f, 0.f, 0.f, 0.f};
    u32x4 xa[4], xb[4], ya[4], yb[4];
#define G_LOAD(ra, rb, kt) do { _Pragma("unroll") for (int i = 0; i < 4; ++i) { \
      ra[i] = *(const u32x4*)(Ag + (size_t)(32 * i) * K + (kt) * 64); rb[i] = *(const u32x4*)(Bg + (size_t)(32 * i) * K + (kt) * 64); } } while (0)
#define G_STORE(ra, rb, buf) do { bf16_t* nA_ = sbuf + (buf) * (256 * GL); _Pragma("unroll") for (int i = 0; i < 4; ++i) { \
      *(u32x4*)(nA_ + (srow + 32 * i) * GL + skc) = ra[i]; *(u32x4*)(nA_ + 128 * GL + (srow + 32 * i) * GL + skc) = rb[i]; } } while (0)
#define G_COMPUTE(buf) do { const bf16_t* cA = sbuf + (buf) * (256 * GL); const bf16_t* cB = cA + 128 * GL; \
      _Pragma("unroll") for (int ks = 0; ks < 2; ++ks) { bf16x8 af[4], bfr[4]; \
        _Pragma("unroll") for (int i = 0; i < 4; ++i) { af[i] = ld8(cA + (wm * 64 + i * 16 + lr) * GL + ks * 32 + quad * 8); \
                                                      bfr[i] = ld8(cB + (wn * 64 + i * 16 + lr) * GL + ks * 32 + quad * 8); } \
        _Pragma("unroll") for (int i = 0; i < 4; ++i) _Pragma("unroll") for (int j = 0; j < 4; ++j) acc[i][j] = mfma16(af[i], bfr[j], acc[i][j]); \
        __builtin_amdgcn_sched_barrier(0); } } while (0)
    G_LOAD(xa, xb, 0);
    G_STORE(xa, xb, 0);
    G_LOAD(xa, xb, 1);
    G_LOAD(ya, yb, 2);
    __syncthreads();
    for (int kt = 0; kt < nk; kt += 2) {
      G_COMPUTE(0);
      G_STORE(xa, xb, 1);
      if (kt + 3 < nk) G_LOAD(xa, xb, kt + 3);
      __syncthreads();
      G_COMPUTE(1);
      if (kt + 2 < nk) G_STORE(ya, yb, 0);
      if (kt + 4 < nk) G_LOAD(ya, yb, kt + 4);
      __syncthreads();
    }
#undef G_LOAD
#undef G_STORE
#undef G_COMPUTE
    float* sC = (float*)lds;
    if (epi.rowmajor(tn)) {
#pragma unroll
      for (int i = 0; i < 4; ++i)
#pragma unroll
        for (int j = 0; j < 4; ++j)
#pragma unroll
          for (int r = 0; r < 4; ++r) sC[(wm * 64 + i * 16 + quad * 4 + r) * 132 + wn * 64 + j * 16 + lr] = acc[i][j][r];
      __syncthreads();
      epi(tm, tn, sC);
      __syncthreads();
    }
    if (epi.transposed(tn)) {
#pragma unroll
      for (int i = 0; i < 4; ++i)
#pragma unroll
        for (int j = 0; j < 4; ++j) *(f32x4*)(sC + (wn * 64 + j * 16 + lr) * 132 + wm * 64 + i * 16 + quad * 4) = acc[i][j];
      __syncthreads();
      epi.store_t(tm, tn, sC);
      __syncthreads();
    }
    if (panel_blocks > 0) {
      const bool flush = (it & 1) == 0 || it == niter - 1;
      if (!flush) pend_tm = tm;
      else {
        asm volatile("s_waitcnt vmcnt(0)" ::: "memory");
        __syncthreads();
        if (threadIdx.x == 0) {
          __builtin_amdgcn_fence(__ATOMIC_RELEASE, "agent");
          asm volatile("s_waitcnt vmcnt(0)" ::: "memory");
          if (pend_tm >= 0) __hip_atomic_fetch_add(panel_cnt + 16 * pend_tm, 1u, __ATOMIC_RELAXED, __HIP_MEMORY_SCOPE_AGENT);
          __hip_atomic_fetch_add(panel_cnt + 16 * tm, 1u, __ATOMIC_RELAXED, __HIP_MEMORY_SCOPE_AGENT);
        }
        pend_tm = -1;
      }
    }
  }
}

struct Epi1 {
  bf16_t* Y; bf16_t* YT;
  DEV bool rowmajor(int tn) const { return !((tn == 14 || tn == 15) || (tn == 18 || tn == 19) || (tn >= 36 && tn < 44)); }
  DEV bool transposed(int tn) const { return (tn == 14 || tn == 15) || (tn == 18 || tn == 19) || (tn >= 28 && tn < 44); }
  DEV void operator()(int tm, int tn, const float* sC) const {
    const int tid = threadIdx.x;
#pragma unroll
    for (int i = 0; i < 8; ++i) {
      const int idx = tid + 256 * i, row = idx >> 4, c8 = idx & 15;
      const f32x4 a = *(const f32x4*)(sC + row * 132 + c8 * 8), b = *(const f32x4*)(sC + row * 132 + c8 * 8 + 4);
      *(u32x4*)(Y + (size_t)(tm * 128 + row) * LDY + tn * 128 + c8 * 8) =
          (u32x4){pk_bf16(a[0], a[1]), pk_bf16(a[2], a[3]), pk_bf16(b[0], b[1]), pk_bf16(b[2], b[3])};
    }
  }
  DEV void store_t(int tm, int tn, const float* sCT) const {
    const int tid = threadIdx.x;
    int r0;
    if (tn == 14 || tn == 15) r0 = R_VS + (tn - 14) * 128;
    else if (tn == 18 || tn == 19) r0 = R_VW + (tn - 18) * 128;
    else if (tn < 36) r0 = R_KR + (tn - 28) * 128;
    else r0 = R_VR + (tn - 36) * 128;
#pragma unroll
    for (int i = 0; i < 8; ++i) {
      const int idx = tid + 256 * i, col = idx >> 4, ch = idx & 15;
      const f32x4 a = *(const f32x4*)(sCT + col * 132 + ch * 8), b = *(const f32x4*)(sCT + col * 132 + ch * 8 + 4);
      *(u32x4*)(YT + (size_t)(r0 + col) * LDT + tm * 128 + ch * 8) =
          (u32x4){pk_bf16(a[0], a[1]), pk_bf16(a[2], a[3]), pk_bf16(b[0], b[1]), pk_bf16(b[2], b[3])};
    }
  }
};
struct Epi2 {
  const float* x; const float* mod; float* X1;
  DEV bool rowmajor(int) const { return true; }
  DEV bool transposed(int) const { return false; }
  DEV void store_t(int, int, const float*) const {}
  DEV void operator()(int tm, int tn, const float* sC) const {
    const int tid = threadIdx.x, b = (tm * 128) / S;
#pragma unroll
    for (int i = 0; i < 16; ++i) {
      const int idx = tid + 256 * i, row = idx >> 5, c4 = idx & 31;
      const f32x4 v = *(const f32x4*)(sC + row * 132 + c4 * 4);
      const size_t t = (size_t)tm * 128 + row;
      const int col = tn * 128 + c4 * 4;
      const f32x4 xi = *(const f32x4*)(x + t * D + col), gt = *(const f32x4*)(mod + (size_t)b * 12288 + 2 * D + col);
      *(f32x4*)(X1 + t * D + col) = xi + gt * v;
    }
  }
};
struct Epi3 {
  bf16_t* Q;
  DEV bool rowmajor(int) const { return true; }
  DEV bool transposed(int) const { return false; }
  DEV void store_t(int, int, const float*) const {}
  DEV void operator()(int tm, int tn, const float* sC) const {
    const int tid = threadIdx.x;
#pragma unroll
    for (int i = 0; i < 8; ++i) {
      const int idx = tid + 256 * i, row = idx >> 4, c8 = idx & 15;
      const f32x4 a = *(const f32x4*)(sC + row * 132 + c8 * 8), b = *(const f32x4*)(sC + row * 132 + c8 * 8 + 4);
      *(u32x4*)(Q + (size_t)(tm * 128 + row) * D + tn * 128 + c8 * 8) =
          (u32x4){pk_bf16(a[0], a[1]), pk_bf16(a[2], a[3]), pk_bf16(b[0], b[1]), pk_bf16(b[2], b[3])};
    }
  }
};

DEV float ret_lg2(int h) { return log1pf(-ex2(-5.0f - (float)h)) * LOG2E; }

DEV void ret_state_unit(const Params& p, int u) {
  const int tid_ = opaque_tid(), lane = tid_ & 63, w = tid_ >> 6, lr = lane & 15, quad = lane >> 4;
  const int es = u & 7, h = (u >> 3) & 7, b = u >> 6;
  const float lg2 = ret_lg2(h);
  const float cd = ex2(lg2 * 128.0f);
  const float kscale = 0.08838834764831845f;
  f32x4 st[2];
  st[0] = (f32x4){0.f, 0.f, 0.f, 0.f}; st[1] = st[0];
  const bf16_t* vrow = p.YT + (size_t)(R_VR + h * 128 + es * 16 + lr) * LDT + (size_t)b * S + quad * 8;
  const bf16_t* krow0 = p.YT + (size_t)(R_KR + h * 128 + w * 32 + lr) * LDT + (size_t)b * S + quad * 8;
  const bf16_t* krow1 = krow0 + (size_t)16 * LDT;
  bf16_t* rt = p.RT + ((size_t)((b * 8 + h) * 64)) * 16384 + (size_t)(es * 16 + lr) * 128 + w * 32 + quad * 4;
  for (int n = 0; n < 64; ++n) {
#pragma unroll
    for (int mt = 0; mt < 2; ++mt)
      *(u32x2*)(rt + (size_t)n * 16384 + mt * 16) = (u32x2){pk_bf16(st[mt][0], st[mt][1]), pk_bf16(st[mt][2], st[mt][3])};
    if (n == 63) break;
    f32x4 kv[2];
    kv[0] = (f32x4){0.f, 0.f, 0.f, 0.f}; kv[1] = kv[0];
#pragma unroll
    for (int ks = 0; ks < 4; ++ks) {
      const bf16x8 vb = ld8(vrow + n * 128 + ks * 32);
      const u32x4 ka = *(const u32x4*)(krow0 + n * 128 + ks * 32), kb = *(const u32x4*)(krow1 + n * 128 + ks * 32);
      u32x4 sa, sb;
#pragma unroll
      for (int q2 = 0; q2 < 4; ++q2) {
        const int j = ks * 32 + quad * 8 + q2 * 2;
        const float d0 = kscale * ex2(lg2 * (float)(127 - j)), d1 = kscale * ex2(lg2 * (float)(126 - j));
        sa[q2] = pk_bf16(bf_lo(ka[q2]) * d0, bf_hi(ka[q2]) * d1);
        sb[q2] = pk_bf16(bf_lo(kb[q2]) * d0, bf_hi(kb[q2]) * d1);
      }
      kv[0] = mfma16(as_bf8(sa), vb, kv[0]);
      kv[1] = mfma16(as_bf8(sb), vb, kv[1]);
    }
    st[0] = st[0] * cd + kv[0];
    st[1] = st[1] * cd + kv[1];
  }
}

DEV void compress_unit(const Params& p, int cu, char* lds) {
  const int tid_ = opaque_tid(), lane = tid_ & 63, w = tid_ >> 6, lr = lane & 15, quad = lane >> 4;
  const int kv = cu >> 7, rem = cu & 127, b = rem >> 5, g = (rem >> 3) & 3, nb = rem & 7;
  const int srccol = (kv ? C_VC : C_KC) + g * 64;
  const bf16_t* w1T = p.w1T + (size_t)kv * 128 * 2048;
  const bf16_t* w2T = p.w2T + (size_t)kv * 64 * 128;
  const float* cb = p.cbias + kv * 32 * 128;
  bf16_t* h1 = (bf16_t*)lds;
  f32x4 acc[4][2];
#pragma unroll
  for (int m = 0; m < 4; ++m) { acc[m][0] = (f32x4){0.f, 0.f, 0.f, 0.f}; acc[m][1] = acc[m][0]; }
  const bf16_t* b0 = w1T + (size_t)(w * 32 + lr) * 2048 + quad * 8;
  const bf16_t* b1 = b0 + (size_t)16 * 2048;
  const bf16_t* ybase = p.Y + (size_t)b * S * LDY + srccol;
#pragma unroll 2
  for (int ks = 0; ks < 64; ++ks) {
    const int l = ks >> 1, dof = (ks & 1) * 32 + quad * 8;
    const bf16x8 bf0 = ld8(b0 + ks * 32), bf1 = ld8(b1 + ks * 32);
#pragma unroll
    for (int m = 0; m < 4; ++m) {
      int tok = 16 * (nb * 64 + m * 16 + lr) + l;
      tok = tok < S ? tok : S - 1;
      const bf16x8 af = ld8(ybase + (size_t)tok * LDY + dof);
      acc[m][0] = mfma16(af, bf0, acc[m][0]);
      acc[m][1] = mfma16(af, bf1, acc[m][1]);
    }
  }
#pragma unroll
  for (int nt = 0; nt < 2; ++nt) {
    const int hc = w * 32 + nt * 16 + lr;
    float bias = 0.f;
#pragma unroll
    for (int pp = 0; pp < 32; ++pp) bias += cb[pp * 128 + hc];
#pragma unroll
    for (int m = 0; m < 4; ++m)
#pragma unroll
      for (int r = 0; r < 4; ++r) {
        const float v = gelu_tanh(acc[m][nt][r] + bias);
        h1[(m * 16 + quad * 4 + r) * 136 + hc] = (bf16_t)(pk_bf16(v, v) & 0xffffu);
      }
  }
  __syncthreads();
  const int d = w * 16 + lr;
  bf16x8 bb[4];
#pragma unroll
  for (int ks = 0; ks < 4; ++ks) bb[ks] = ld8(w2T + (size_t)d * 128 + ks * 32 + quad * 8);
#pragma unroll
  for (int m = 0; m < 4; ++m) {
    f32x4 o = (f32x4){0.f, 0.f, 0.f, 0.f};
#pragma unroll
    for (int ks = 0; ks < 4; ++ks) o = mfma16(ld8(h1 + (m * 16 + lr) * 136 + ks * 32 + quad * 8), bb[ks], o);
    const int n0 = nb * 64 + m * 16 + quad * 4;
    if (kv == 0) {
#pragma unroll
      for (int r = 0; r < 4; ++r) p.Kc[((size_t)(b * 4 + g) * 512 + n0 + r) * 64 + d] = (bf16_t)(pk_bf16(o[r], o[r]) & 0xffffu);
    } else {
      *(u32x2*)(p.VcT + ((size_t)(b * 4 + g) * 64 + d) * 512 + n0) = (u32x2){pk_bf16(o[0], o[1]), pk_bf16(o[2], o[3])};
    }
  }
  __syncthreads();
}

constexpr int NCONV = 1024 + 1024 + 32 + 4096 + 4096;
DEV void conv_unit(const Params& p, int u, char* lds) {
  constexpr int U_WOUT = 1024, U_WQ = 1024, U_SK = 32, U_U = 4096;
  if (u < U_WOUT) { transpose_tile(p.w_out, 2048, 0, p.WoutT, 2048, (u >> 5) * 64, (u & 31) * 64, (float*)lds); return; }
  u -= U_WOUT;
  if (u < U_WQ) { transpose_tile(p.w_q, 2048, 0, p.WqT, 2048, (u >> 5) * 64, (u & 31) * 64, (float*)lds); return; }
  u -= U_WQ;
  if (u < U_SK) { convert_unit(p.sub_keys, p.SK, u); return; }
  u -= U_SK;
  if (u < U_U) { convert_unit_fp8(p.peer_u, p.U8, u, U8_SCALE); return; }
  u -= U_U;
  convert_unit_fp8(p.peer_v, p.V8, u, V8_SCALE);
}
DEV void conv_drain(const Params& p, char* lds) {
  unsigned* cnt = p.bar + 64 * 100;
  int* slot = (int*)(lds + LDS_BYTES - 16);
  for (;;) {
    __syncthreads();
    if (threadIdx.x == 0) *slot = (int)__hip_atomic_fetch_add(cnt, 1u, __ATOMIC_RELAXED, __HIP_MEMORY_SCOPE_AGENT);
    __syncthreads();
    const int u = *slot;
    if (u >= NCONV) break;
    conv_unit(p, u, lds);
  }
}

DEV void phase4(const Params& p, char* lds) {
  for (int u = blockIdx.x; u < 512; u += gridDim.x) {
    if (u < 256) ret_state_unit(p, u);
    else compress_unit(p, u - 256, lds);
  }
  conv_drain(p, lds);
}

DEV void ret_out_unit(const Params& p, int u) {
  const int tid_ = opaque_tid(), lane = tid_ & 63, w = tid_ >> 6, lr = lane & 15, quad = lane >> 4;
  const int n = u & 63, h = (u >> 6) & 7, b = u >> 9;
  const float lg2 = ret_lg2(h);
  const float kscale = 0.08838834764831845f;
  const size_t tk0 = (size_t)b * S + n * 128;
  f32x4 o[8][2];
#pragma unroll
  for (int i = 0; i < 8; ++i) { o[i][0] = (f32x4){0.f, 0.f, 0.f, 0.f}; o[i][1] = o[i][0]; }
  bf16x8 qf[2][4];
#pragma unroll
  for (int nt = 0; nt < 2; ++nt)
#pragma unroll
    for (int ks = 0; ks < 4; ++ks)
      qf[nt][ks] = ld8(p.Y + (tk0 + w * 32 + nt * 16 + lr) * LDY + C_QR + h * 128 + ks * 32 + quad * 8);
  const bf16_t* rt = p.RT + ((size_t)((b * 8 + h) * 64 + n)) * 16384 + (size_t)lr * 128 + quad * 8;
#pragma unroll 2
  for (int ks = 0; ks < 4; ++ks)
#pragma unroll
    for (int et = 0; et < 8; ++et) {
      const bf16x8 af = ld8(rt + et * 16 * 128 + ks * 32);
      o[et][0] = mfma16(af, qf[0][ks], o[et][0]);
      o[et][1] = mfma16(af, qf[1][ks], o[et][1]);
    }
  int ti[2];
#pragma unroll
  for (int nt = 0; nt < 2; ++nt) {
    ti[nt] = w * 32 + nt * 16 + lr;
    const float qd = ex2(lg2 * (float)(ti[nt] + 1));
#pragma unroll
    for (int et = 0; et < 8; ++et) o[et][nt] = o[et][nt] * qd;
  }
  for (int jt = 0; jt <= w; ++jt) {
    const int j0 = jt * 32;
    f32x4 s[2][2];
#pragma unroll
    for (int mt = 0; mt < 2; ++mt) { s[mt][0] = (f32x4){0.f, 0.f, 0.f, 0.f}; s[mt][1] = s[mt][0]; }
#pragma unroll
    for (int mt = 0; mt < 2; ++mt)
#pragma unroll
      for (int ks = 0; ks < 4; ++ks) {
        const bf16x8 kf = ld8(p.Y + (tk0 + j0 + mt * 16 + lr) * LDY + C_KR + h * 128 + ks * 32 + quad * 8);
        s[mt][0] = mfma16(kf, qf[0][ks], s[mt][0]);
        s[mt][1] = mfma16(kf, qf[1][ks], s[mt][1]);
      }
    bf16x8 pb[2];
#pragma unroll
    for (int nt = 0; nt < 2; ++nt) {
      float pv[2][4];
#pragma unroll
      for (int mt = 0; mt < 2; ++mt)
#pragma unroll
        for (int r = 0; r < 4; ++r) {
          const int j = j0 + mt * 16 + quad * 4 + r;
          const int dd = ti[nt] - j;
          pv[mt][r] = dd >= 0 ? s[mt][nt][r] * kscale * ex2(lg2 * (float)dd) : 0.f;
        }
      pb[nt] = as_bf8((u32x4){pk_bf16(pv[0][0], pv[0][1]), pk_bf16(pv[0][2], pv[0][3]), pk_bf16(pv[1][0], pv[1][1]), pk_bf16(pv[1][2], pv[1][3])});
    }
#pragma unroll
    for (int et = 0; et < 8; ++et) {
      const bf16_t* vp = p.YT + (size_t)(R_VR + h * 128 + et * 16 + lr) * LDT + tk0 + j0 + quad * 4;
      const u32x2 lo = *(const u32x2*)vp, hi = *(const u32x2*)(vp + 16);
      const bf16x8 vf = as_bf8((u32x4){lo[0], lo[1], hi[0], hi[1]});
      o[et][0] = mfma16(vf, pb[0], o[et][0]);
      o[et][1] = mfma16(vf, pb[1], o[et][1]);
    }
  }
#pragma unroll
  for (int nt = 0; nt < 2; ++nt) {
    float sm = 0.f;
#pragma unroll
    for (int et = 0; et < 8; ++et) sm += o[et][nt][0] + o[et][nt][1] + o[et][nt][2] + o[et][nt][3];
    sm += __shfl_xor(sm, 16); sm += __shfl_xor(sm, 32);
    const float mu = sm * (1.0f / 128.0f);
    float sq = 0.f;
#pragma unroll
    for (int et = 0; et < 8; ++et)
#pragma unroll
      for (int r = 0; r < 4; ++r) { const float dlt = o[et][nt][r] - mu; sq += dlt * dlt; }
    sq += __shfl_xor(sq, 16); sq += __shfl_xor(sq, 32);
    const float rstd = rsqrtf(sq * (1.0f / 128.0f) + 1e-6f);
    const size_t tok = tk0 + ti[nt];
#pragma unroll
    for (int et = 0; et < 8; ++et) {
      const int e = et * 16 + quad * 4;
      const u32x2 gr = *(const u32x2*)(p.Y + tok * LDY + C_GR + h * 128 + e);
      const f32x4 gw = *(const f32x4*)(p.g_ret + h * 128 + e);
      const float gv[4] = {bf_lo(gr[0]), bf_hi(gr[0]), bf_lo(gr[1]), bf_hi(gr[1])};
      float y[4];
#pragma unroll
      for (int r = 0; r < 4; ++r) y[r] = (o[et][nt][r] - mu) * rstd * gw[r] * (gv[r] * sigmoidf_(gv[r]));
      *(u32x2*)(p.Omix + tok * D + 1024 + h * 128 + e) = (u32x2){pk_bf16(y[0], y[1]), pk_bf16(y[2], y[3])};
    }
  }
}

constexpr int NQT = 2;
struct AttnSt { f32x4 o[4][NQT]; float m[NQT], l[NQT]; };

DEV void attn_reset(AttnSt& st) {
#pragma unroll
  for (int j = 0; j < NQT; ++j) {
    st.m[j] = -1e30f; st.l[j] = 0.f;
#pragma unroll
    for (int i = 0; i < 4; ++i) st.o[i][j] = (f32x4){0.f, 0.f, 0.f, 0.f};
  }
}

constexpr int TL = 72;
constexpr int TILE_BUF_BYTES = 2 * 64 * TL * 2;
constexpr int NSA_TILE_OFF = 36864;
struct KVFrag { bf16x8 k[4][2]; bf16x8 v[4][2]; };

struct TileSrc { const bf16_t* kbase; size_t krs; const bf16_t* vbase; size_t vrs; };
template <bool WITH_V>
DEV void stage_load(u32x4 (&r)[4], const TileSrc& ts, int pos, int tid) {
#pragma unroll
  for (int i = 0; i < 2; ++i) {
    const int c = tid + 256 * i, row = c >> 3, ch = c & 7;
    r[i] = *(const u32x4*)(ts.kbase + (size_t)(pos + row) * ts.krs + ch * 8);
    if (WITH_V) r[2 + i] = *(const u32x4*)(ts.vbase + (size_t)row * ts.vrs + pos + ch * 8);
  }
}
template <bool WITH_V>
DEV void stage_store(bf16_t* tb, const u32x4 (&r)[4], int tid) {
#pragma unroll
  for (int i = 0; i < 2; ++i) {
    const int c = tid + 256 * i, row = c >> 3, ch = c & 7;
    *(u32x4*)(tb + row * TL + ch * 8) = r[i];
    if (WITH_V) *(u32x4*)(tb + 64 * TL + row * TL + ch * 8) = r[2 + i];
  }
}
DEV void lds_k(KVFrag& f, const bf16_t* tb, int lr, int quad) {
#pragma unroll
  for (int mt = 0; mt < 4; ++mt)
#pragma unroll
    for (int ks = 0; ks < 2; ++ks) f.k[mt][ks] = ld8(tb + (mt * 16 + lr) * TL + ks * 32 + quad * 8);
}
DEV void lds_v(KVFrag& f, const bf16_t* tb, int lr, int quad) {
#pragma unroll
  for (int dt = 0; dt < 4; ++dt)
#pragma unroll
    for (int hf = 0; hf < 2; ++hf) {
      const bf16_t* vp = tb + 64 * TL + (dt * 16 + lr) * TL + hf * 32 + quad * 4;
      const u32x2 lo = *(const u32x2*)vp, hi = *(const u32x2*)(vp + 16);
      f.v[dt][hf] = as_bf8((u32x4){lo[0], lo[1], hi[0], hi[1]});
    }
}
template <bool WITH_V, class NextFn, class ProcFn>
DEV void tile_loop(char* lds, int tid, const TileSrc& ts, NextFn next, ProcFn proc) {
  int cur = next();
  if (cur < 0) return;
  int n1 = next(), n2 = n1 >= 0 ? next() : -1;
  u32x4 r0[4], r1[4];
  stage_load<WITH_V>(r0, ts, cur, tid);
  stage_store<WITH_V>((bf16_t*)(lds + NSA_TILE_OFF), r0, tid);
  stage_load<WITH_V>(r0, ts, n1 >= 0 ? n1 : cur, tid);
  stage_load<WITH_V>(r1, ts, n2 >= 0 ? n2 : cur, tid);
  __syncthreads();
  while (true) {
    proc(cur, (const bf16_t*)(lds + NSA_TILE_OFF));
    stage_store<WITH_V>((bf16_t*)(lds + NSA_TILE_OFF + TILE_BUF_BYTES), r0, tid);
    const int n3 = n2 >= 0 ? next() : -1;
    stage_load<WITH_V>(r0, ts, n3 >= 0 ? n3 : cur, tid);
    __syncthreads();
    if (n1 < 0) break;
    proc(n1, (const bf16_t*)(lds + NSA_TILE_OFF + TILE_BUF_BYTES));
    stage_store<WITH_V>((bf16_t*)(lds + NSA_TILE_OFF), r1, tid);
    const int n4 = n3 >= 0 ? next() : -1;
    stage_load<WITH_V>(r1, ts, n4 >= 0 ? n4 : cur, tid);
    __syncthreads();
    if (n2 < 0) break;
    cur = n2; n1 = n3; n2 = n4;
  }
}

DEV void qk_tile(f32x4 (&s)[4][NQT], const KVFrag& f, const bf16x8 (&qf)[NQT][2]) {
#pragma unroll
  for (int mt = 0; mt < 4; ++mt)
#pragma unroll
    for (int nt = 0; nt < NQT; ++nt) {
      s[mt][nt] = mfma16(f.k[mt][0], qf[nt][0], (f32x4){0.f, 0.f, 0.f, 0.f});
      s[mt][nt] = mfma16(f.k[mt][1], qf[nt][1], s[mt][nt]);
    }
}
DEV void pv_tile(AttnSt& st, const KVFrag& f, const bf16x8 (&pb)[NQT][2]) {
#pragma unroll
  for (int dt = 0; dt < 4; ++dt)
#pragma unroll
    for (int hf = 0; hf < 2; ++hf)
#pragma unroll
      for (int nt = 0; nt < NQT; ++nt) st.o[dt][nt] = mfma16(f.v[dt][hf], pb[nt][hf], st.o[dt][nt]);
}

DEV void attn_tile(AttnSt& st, const bf16x8 (&qf)[NQT][2], const bf16_t* tb, int rel0, int lr, const unsigned (&selbit)[NQT], int maxdist,
                   bool need_mask, float c1, float slope2, int quad) {
  KVFrag f;
  lds_k(f, tb, lr, quad);
  f32x4 s[4][NQT];
  qk_tile(s, f, qf);
  lds_v(f, tb, lr, quad);
  const float b0 = slope2 * (float)(rel0 + quad * 4);
  float smaxv[NQT];
#pragma unroll
  for (int nt = 0; nt < NQT; ++nt) smaxv[nt] = -1e30f;
  float rbv = b0;
  const float step13 = slope2 * 13.0f;
#pragma unroll
  for (int mt = 0; mt < 4; ++mt)
#pragma unroll
    for (int r = 0; r < 4; ++r) {
      if (r > 0) rbv += slope2; else if (mt > 0) rbv += step13;
#pragma unroll
      for (int nt = 0; nt < NQT; ++nt) {
        const float v = fmaf(s[mt][nt][r], c1, rbv);
        s[mt][nt][r] = v;
        smaxv[nt] = fmaxf(smaxv[nt], v);
      }
    }
  if (need_mask) {
#pragma unroll
    for (int nt = 0; nt < NQT; ++nt) {
      float mx = -1e30f;
      const int dq = lr + nt * 16 - rel0 - quad * 4;
#pragma unroll
      for (int mt = 0; mt < 4; ++mt)
#pragma unroll
        for (int r = 0; r < 4; ++r) {
          const int dist = dq - (mt * 16 + r);
          const bool valid = selbit[nt] && dist >= 0 && dist <= maxdist;
          const float v = valid ? s[mt][nt][r] : -1e30f;
          s[mt][nt][r] = v;
          mx = fmaxf(mx, v);
        }
      smaxv[nt] = mx;
    }
  } else {
#pragma unroll
    for (int nt = 0; nt < NQT; ++nt) smaxv[nt] = selbit[nt] ? smaxv[nt] : -1e30f;
  }
  bf16x8 pb[NQT][2];
#pragma unroll
  for (int nt = 0; nt < NQT; ++nt) {
    float smax = smaxv[nt];
    smax = fmaxf(smax, __shfl_xor(smax, 16));
    smax = fmaxf(smax, __shfl_xor(smax, 32));
    const float mnew = fmaxf(st.m[nt], smax);
    const float alpha = ex2(st.m[nt] - mnew);
    st.m[nt] = mnew;
    const float mref = selbit[nt] ? fmaxf(mnew, -1e20f) : 1e30f;
    float ls = 0.f;
    float pv[4][4];
#pragma unroll
    for (int mt = 0; mt < 4; ++mt)
#pragma unroll
      for (int r = 0; r < 4; ++r) { const float e = ex2(s[mt][nt][r] - mref); pv[mt][r] = e; ls += e; }
    st.l[nt] = st.l[nt] * alpha + ls;
#pragma unroll
    for (int hf = 0; hf < 2; ++hf)
      pb[nt][hf] = as_bf8((u32x4){pk_bf16(pv[2 * hf][0], pv[2 * hf][1]), pk_bf16(pv[2 * hf][2], pv[2 * hf][3]),
                                  pk_bf16(pv[2 * hf + 1][0], pv[2 * hf + 1][1]), pk_bf16(pv[2 * hf + 1][2], pv[2 * hf + 1][3])});
#pragma unroll
    for (int dt = 0; dt < 4; ++dt) st.o[dt][nt] = st.o[dt][nt] * alpha;
  }
  pv_tile(st, f, pb);
}

DEV void cmp_scores(f32x4 (&s)[4][NQT], int n0, int t0, int lr, int quad, float c1, float slope2, bool full) {
  float rbv = slope2 * (float)(16 * (n0 + quad * 4) + 31 - t0);
  const float step16 = slope2 * 16.0f, step208 = slope2 * 208.0f;
#pragma unroll
  for (int mt = 0; mt < 4; ++mt)
#pragma unroll
    for (int r = 0; r < 4; ++r) {
      if (r > 0) rbv += step16; else if (mt > 0) rbv += step208;
      const int rel = 16 * (n0 + mt * 16 + quad * 4 + r) + 31 - t0;
#pragma unroll
      for (int nt = 0; nt < NQT; ++nt) {
        float v = fmaf(s[mt][nt][r], c1, rbv);
        if (!full) v = (rel <= lr + nt * 16) ? v : -1e30f;
        s[mt][nt][r] = v;
      }
    }
}

DEV void nsa_unit(const Params& p, int u, char* lds) {
  const int tid = opaque_tid(), lane = tid & 63, w = tid >> 6, lr = lane & 15, quad = lane >> 4;
  const int q32 = u & 255, g = (u >> 8) & 3, b = u >> 10;
  const int h = g * 4 + w, t0 = q32 * 32, qb = t0 >> 6;
  const size_t tokbase = (size_t)b * S;
  float* imp = (float*)lds;
  float* stash = (float*)lds;
  unsigned* selmask = (unsigned*)(lds + 32768);
  unsigned* unionm = (unsigned*)(lds + 32768 + 512);
  const float slope = ex2(-0.5f * (float)(h + 1));
  const float slope2 = slope * LOG2E, c1 = 0.125f * LOG2E;
  const int tq0 = t0 + lr;
  const float skipd = 200.0f / slope2;
  const float skipd_g = 200.0f / (ex2(-0.5f * (float)(g * 4 + 4)) * LOG2E);

  for (int i = tid; i < 32 * 129; i += 256) imp[i] = 0.f;
  if (tid < 4) unionm[tid] = 0u;
  bf16x8 qf[NQT][2];
#pragma unroll
  for (int nt = 0; nt < NQT; ++nt)
#pragma unroll
    for (int ks = 0; ks < 2; ++ks) qf[nt][ks] = ld8(p.Y + (tokbase + tq0 + nt * 16) * LDY + C_QA + h * 64 + ks * 32 + quad * 8);
  __syncthreads();
  auto gate = [&](int nt, int br) -> float {
    const bf16_t* gp = p.Y + (tokbase + tq0 + nt * 16) * LDY + C_GA + h * 3 + br;
    asm volatile("" : "+v"(gp));
    return sigmoidf_(bf2f(*gp));
  };

  AttnSt st;
  int nmax = t0 / 16;
  if (nmax > 510) nmax = 510;
  TileSrc tsc;
  tsc.kbase = p.Kc + (size_t)(b * 4 + g) * 512 * 64; tsc.krs = 64;
  tsc.vbase = p.VcT + (size_t)(b * 4 + g) * 64 * 512; tsc.vrs = 512;
  float m1[NQT], l1[NQT];
#pragma unroll
  for (int nt = 0; nt < NQT; ++nt) { m1[nt] = -1e30f; l1[nt] = 0.f; }
  int nstart = 0;
  while (nstart + 64 <= nmax && (float)(t0 - (16 * (nstart + 63) + 31)) > skipd_g) nstart += 64;
  {
    int nn = nstart;
    tile_loop<false>(lds, tid, tsc, [&]() -> int { const int r = nn <= nmax ? nn : -1; nn += 64; return r; },
      [&](int n0, const bf16_t* tb) {
        if ((float)(t0 - (16 * (n0 + 63) + 31)) > skipd) return;
        KVFrag f;
        lds_k(f, tb, lr, quad);
        f32x4 s[4][NQT];
        qk_tile(s, f, qf);
        const bool full = 16 * (n0 + 63) + 31 <= t0;
        if (full) cmp_scores(s, n0, t0, lr, quad, c1, slope2, true); else cmp_scores(s, n0, t0, lr, quad, c1, slope2, false);
#pragma unroll
        for (int nt = 0; nt < NQT; ++nt) {
          float smax = -1e30f;
#pragma unroll
          for (int mt = 0; mt < 4; ++mt)
#pragma unroll
            for (int r = 0; r < 4; ++r) smax = fmaxf(smax, s[mt][nt][r]);
          smax = fmaxf(smax, __shfl_xor(smax, 16));
          smax = fmaxf(smax, __shfl_xor(smax, 32));
          const float mnew = fmaxf(m1[nt], smax);
          const float mref = fmaxf(mnew, -1e20f);
          float ls = 0.f;
#pragma unroll
          for (int mt = 0; mt < 4; ++mt)
#pragma unroll
            for (int r = 0; r < 4; ++r) ls += ex2(s[mt][nt][r] - mref);
          l1[nt] = l1[nt] * ex2(m1[nt] - mnew) + ls;
          m1[nt] = mnew;
        }
      });
  }
  float il1[NQT];
#pragma unroll
  for (int nt = 0; nt < NQT; ++nt) {
    float l = l1[nt];
    l += __shfl_xor(l, 16); l += __shfl_xor(l, 32);
    il1[nt] = l > 0.f ? 1.0f / l : 0.f;
  }
  attn_reset(st);
  {
    int nn = nstart;
    tile_loop<true>(lds, tid, tsc, [&]() -> int { const int r = nn <= nmax ? nn : -1; nn += 64; return r; },
      [&](int n0, const bf16_t* tb) {
        if ((float)(t0 - (16 * (n0 + 63) + 31)) > skipd) return;
        KVFrag f;
        lds_k(f, tb, lr, quad);
        f32x4 s[4][NQT];
        qk_tile(s, f, qf);
        lds_v(f, tb, lr, quad);
        {
          const bool full = 16 * (n0 + 63) + 31 <= t0;
          if (full) cmp_scores(s, n0, t0, lr, quad, c1, slope2, true); else cmp_scores(s, n0, t0, lr, quad, c1, slope2, false);
        }
        bf16x8 pb[NQT][2];
#pragma unroll
        for (int nt = 0; nt < NQT; ++nt) {
          const float mref = fmaxf(m1[nt], -1e20f);
          float pv[4][4];
#pragma unroll
          for (int mt = 0; mt < 4; ++mt) {
#pragma unroll
            for (int r = 0; r < 4; ++r) pv[mt][r] = ex2(s[mt][nt][r] - mref) * il1[nt];
            const int msel = (n0 + mt * 16 + quad * 4) >> 2;
            const float s4 = (pv[mt][0] + pv[mt][1]) + (pv[mt][2] + pv[mt][3]);
            float* ip = imp + (nt * 16 + lr) * 129 + msel;
            if (s4 != 0.f) {
              atomicAdd(ip, s4);
              if (msel + 1 < 128 && pv[mt][3] != 0.f) atomicAdd(ip + 1, pv[mt][3]);
            }
          }
#pragma unroll
          for (int hf = 0; hf < 2; ++hf)
            pb[nt][hf] = as_bf8((u32x4){pk_bf16(pv[2 * hf][0], pv[2 * hf][1]), pk_bf16(pv[2 * hf][2], pv[2 * hf][3]),
                                        pk_bf16(pv[2 * hf + 1][0], pv[2 * hf + 1][1]), pk_bf16(pv[2 * hf + 1][2], pv[2 * hf + 1][3])});
        }
        pv_tile(st, f, pb);
      });
  }
  {
    unsigned um0 = 0, um1 = 0, um2 = 0, um3 = 0;
    for (int qi = 0; qi < 8; ++qi) {
      const int q = w * 8 + qi;
      unsigned key[2];
#pragma unroll
      for (int j = 0; j < 2; ++j) {
        const int m = lane + 64 * j;
        const float v = imp[q * 129 + m];
        unsigned k = (__float_as_uint(v) & 0xffffff80u) + 0x80u + (unsigned)(127 - m);
        if (m == 0 || m == qb || m + 1 == qb) k = 0x7f000000u + (unsigned)(127 - m);
        if (m > qb) k = 0u;
        key[j] = k;
      }
      unsigned thr = 0u;
#pragma unroll 1
      for (int bit = 30; bit >= 0; --bit) {
        const unsigned cand = thr | (1u << bit);
        const int cnt = __popcll(__ballot(key[0] >= cand)) + __popcll(__ballot(key[1] >= cand));
        if (cnt >= 16) thr = cand;
      }
      const bool sel0 = key[0] >= thr && key[0] != 0u, sel1 = key[1] >= thr && key[1] != 0u;
      const unsigned long long b0 = __ballot(sel0), b1 = __ballot(sel1);
      const unsigned w0 = (unsigned)b0, w1 = (unsigned)(b0 >> 32), w2 = (unsigned)b1, w3 = (unsigned)(b1 >> 32);
      if (lane == 0) { selmask[q * 4 + 0] = w0; selmask[q * 4 + 1] = w1; selmask[q * 4 + 2] = w2; selmask[q * 4 + 3] = w3; }
      um0 |= w0; um1 |= w1; um2 |= w2; um3 |= w3;
    }
    if (lane == 0) { atomicOr(&unionm[0], um0); atomicOr(&unionm[1], um1); atomicOr(&unionm[2], um2); atomicOr(&unionm[3], um3); }
  }
  __syncthreads();
#pragma unroll
  for (int nt = 0; nt < NQT; ++nt) {
    const float g0 = gate(nt, 0);
#pragma unroll
    for (int dt = 0; dt < 4; ++dt)
#pragma unroll
      for (int r = 0; r < 4; ++r) stash[((dt * NQT + nt) * 4 + r) * 256 + tid] = g0 * st.o[dt][nt][r];
  }

  attn_reset(st);
  {
    TileSrc ts;
    ts.kbase = p.Y + tokbase * LDY + C_KS + g * 64; ts.krs = LDY;
    ts.vbase = p.YT + (size_t)(R_VS + g * 64) * LDT + tokbase; ts.vrs = LDT;
    const unsigned u0 = unionm[0], u1 = unionm[1], u2 = unionm[2], u3 = unionm[3];
    int wd = 0;
    unsigned um = u0;
    tile_loop<true>(lds, tid, ts,
      [&]() -> int {
        for (;;) {
          while (um == 0u && wd < 3) { ++wd; um = wd == 1 ? u1 : (wd == 2 ? u2 : u3); }
          if (um == 0u) return -1;
          const int bit = __builtin_ctz(um);
          um &= um - 1;
          const int pos = (wd * 32 + bit) * 64;
          if ((float)(t0 - pos - 63) <= skipd_g) return pos;
        }
      },
      [&](int pos0, const bf16_t* tb) {
        if ((float)(t0 - pos0 - 63) > skipd) return;
        const int m = pos0 >> 6;
        unsigned selbit[NQT];
#pragma unroll
        for (int nt = 0; nt < NQT; ++nt) selbit[nt] = (selmask[(nt * 16 + lr) * 4 + (m >> 5)] >> (m & 31)) & 1u;
        attn_tile(st, qf, tb, pos0 - t0, lr, selbit, 1 << 30, m >= qb, c1, slope2, quad);
      });
  }
#pragma unroll
  for (int nt = 0; nt < NQT; ++nt) {
    float l = st.l[nt];
    l += __shfl_xor(l, 16); l += __shfl_xor(l, 32);
    const float f = gate(nt, 1) / l;
#pragma unroll
    for (int dt = 0; dt < 4; ++dt)
#pragma unroll
      for (int r = 0; r < 4; ++r) stash[((dt * NQT + nt) * 4 + r) * 256 + tid] += f * st.o[dt][nt][r];
  }
  attn_reset(st);
  {
    unsigned one[NQT];
#pragma unroll
    for (int nt = 0; nt < NQT; ++nt) one[nt] = 1u;
    int pstart = (t0 - 512) & ~63;
    if (pstart < 0) pstart = 0;
    TileSrc ts;
    ts.kbase = p.Y + tokbase * LDY + C_KW + g * 64; ts.krs = LDY;
    ts.vbase = p.YT + (size_t)(R_VW + g * 64) * LDT + tokbase; ts.vrs = LDT;
    int pp = pstart;
    tile_loop<true>(lds, tid, ts, [&]() -> int { const int r = pp < t0 + 32 ? pp : -1; pp += 64; return r; },
      [&](int pos0, const bf16_t* tb) {
        const int rel0 = pos0 - t0;
        if ((float)(-rel0 - 63) > skipd) return;
        attn_tile(st, qf, tb, rel0, lr, one, 511, !(rel0 + 63 <= 0 && rel0 >= 31 - 511), c1, slope2, quad);
      });
  }
#pragma unroll
  for (int nt = 0; nt < NQT; ++nt) {
    float l = st.l[nt];
    l += __shfl_xor(l, 16); l += __shfl_xor(l, 32);
    const float f = gate(nt, 2) / l;
    float ss = 0.f;
#pragma unroll
    for (int dt = 0; dt < 4; ++dt)
#pragma unroll
      for (int r = 0; r < 4; ++r) {
        const float v = stash[((dt * NQT + nt) * 4 + r) * 256 + tid] + f * st.o[dt][nt][r];
        st.o[dt][nt][r] = v;
        ss += v * v;
      }
    ss += __shfl_xor(ss, 16); ss += __shfl_xor(ss, 32);
    const float rstd = rsqrtf(ss * (1.0f / 64.0f) + 1e-6f);
#pragma unroll
    for (int dt = 0; dt < 4; ++dt) {
      const int d = dt * 16 + quad * 4;
      const f32x4 gn = *(const f32x4*)(p.g_nsa + h * 64 + d);
      *(u32x2*)(p.Omix + (tokbase + tq0 + nt * 16) * D + h * 64 + d) =
          (u32x2){pk_bf16(st.o[dt][nt][0] * rstd * gn[0], st.o[dt][nt][1] * rstd * gn[1]),
                  pk_bf16(st.o[dt][nt][2] * rstd * gn[2], st.o[dt][nt][3] * rstd * gn[3])};
    }
  }
  __syncthreads();
}

DEV void publish_unit(unsigned* cnt) {
  asm volatile("s_waitcnt vmcnt(0)" ::: "memory");
  __syncthreads();
  if (threadIdx.x == 0) {
    __builtin_amdgcn_fence(__ATOMIC_RELEASE, "agent");
    asm volatile("s_waitcnt vmcnt(0)" ::: "memory");
    __hip_atomic_fetch_add(cnt, 1u, __ATOMIC_RELAXED, __HIP_MEMORY_SCOPE_AGENT);
  }
}
DEV void phase5(const Params& p, char* lds, int GP, unsigned* ready_cnt) {
  const int bid = blockIdx.x;
  if (bid >= GP) return;
  for (int r = 0; r * GP < 6144; ++r) {
    const int v = r * GP + ((r & 1) ? GP - 1 - bid : bid);
    if (v >= 6144) continue;
    const int step = v / 24, within = v - step * 24, q32 = 255 - step, chunk = q32 >> 2;
    if (within < 16) {
      const int bb = within >> 2;
      nsa_unit(p, (bb << 10) | ((within & 3) << 8) | q32, lds);
      publish_unit(ready_cnt + 16 * (bb * 64 + chunk));
    } else {
      const int j = (step & 3) * 8 + (within - 16), bb = j >> 3, hh = j & 7;
      ret_out_unit(p, (bb << 9) | (hh << 6) | chunk);
      publish_unit(ready_cnt + 16 * (bb * 64 + chunk));
    }
  }
}

DEV int order_key(float v, int idx) {
  int bits = __float_as_int(v);
  bits ^= (bits >> 31) & 0x7fffffff;
  return (bits & ~0x7f) | (127 - idx);
}
DEV float key_val(int key) {
  int bits = key & ~0x7f;
  bits ^= (bits >> 31) & 0x7fffffff;
  return __int_as_float(bits);
}

DEV void peer_unit(const Params& p, int u, char* lds) {
  const int tid = opaque_tid(), lane = tid & 63, w = tid >> 6, lr = lane & 15, quad = lane >> 4;
  const int t0 = u * 16;
  int* sc = (int*)lds;
  int* tk = (int*)(lds + 16384);
  float* cval = (float*)(lds + 18432);
  int* exi = (int*)(lds + 22528);
  float* exg = (float*)(lds + 30720);
  for (int h = 0; h < 8; ++h) {
    {
      const int pp = w >> 1, nt0 = (w & 1) * 4;
      bf16x8 af[4];
#pragma unroll
      for (int ks = 0; ks < 4; ++ks) af[ks] = ld8(p.Qp + (size_t)(t0 + lr) * D + h * 256 + pp * 128 + ks * 32 + quad * 8);
#pragma unroll
      for (int nn = 0; nn < 4; ++nn) {
        const int nt = nt0 + nn;
        f32x4 acc = (f32x4){0.f, 0.f, 0.f, 0.f};
#pragma unroll
        for (int ks = 0; ks < 4; ++ks)
          acc = mfma16(af[ks], ld8(p.SK + ((size_t)((h * 2 + pp) * 128 + nt * 16 + lr)) * 128 + ks * 32 + quad * 8), acc);
#pragma unroll
        for (int r = 0; r < 4; ++r) sc[(pp * 16 + quad * 4 + r) * 128 + nt * 16 + lr] = order_key(acc[r], nt * 16 + lr);
      }
    }
    __syncthreads();
    for (int rr = 0; rr < 8; rr += 2) {
      const int rowA = w * 8 + rr, rowB = rowA + 1;
      const int a0 = sc[rowA * 128 + lane], a1 = sc[rowA * 128 + 64 + lane], b0 = sc[rowB * 128 + lane], b1 = sc[rowB * 128 + 64 + lane];
      const unsigned ua0 = (unsigned)a0 ^ 0x80000000u, ua1 = (unsigned)a1 ^ 0x80000000u, ub0 = (unsigned)b0 ^ 0x80000000u, ub1 = (unsigned)b1 ^ 0x80000000u;
      unsigned thA = 0u, thB = 0u;
#pragma unroll 1
      for (int bit = 31; bit >= 0; --bit) {
        const unsigned cA = thA | (1u << bit), cB = thB | (1u << bit);
        const int nA = __popcll(__ballot(ua0 >= cA)) + __popcll(__ballot(ua1 >= cA));
        const int nB = __popcll(__ballot(ub0 >= cB)) + __popcll(__ballot(ub1 >= cB));
        if (nA >= 16) thA = cA;
        if (nB >= 16) thB = cB;
      }
      const unsigned long long lt = (1ull << lane) - 1ull;
      {
        const unsigned long long m0 = __ballot(ua0 >= thA), m1 = __ballot(ua1 >= thA);
        if (ua0 >= thA) tk[rowA * 16 + __popcll(m0 & lt)] = a0;
        if (ua1 >= thA) tk[rowA * 16 + __popcll(m0) + __popcll(m1 & lt)] = a1;
      }
      {
        const unsigned long long m0 = __ballot(ub0 >= thB), m1 = __ballot(ub1 >= thB);
        if (ub0 >= thB) tk[rowB * 16 + __popcll(m0 & lt)] = b0;
        if (ub1 >= thB) tk[rowB * 16 + __popcll(m0) + __popcll(m1 & lt)] = b1;
      }
      if (lane < 32) {
        const int row = lane < 16 ? rowA : rowB, me = lane & 15;
        const int4 q0 = *(const int4*)(tk + row * 16), q1 = *(const int4*)(tk + row * 16 + 4), q2 = *(const int4*)(tk + row * 16 + 8), q3 = *(const int4*)(tk + row * 16 + 12);
        const int mine = tk[row * 16 + me];
        const int rank = (q0.x > mine) + (q0.y > mine) + (q0.z > mine) + (q0.w > mine) + (q1.x > mine) + (q1.y > mine) + (q1.z > mine) + (q1.w > mine) +
                         (q2.x > mine) + (q2.y > mine) + (q2.z > mine) + (q2.w > mine) + (q3.x > mine) + (q3.y > mine) + (q3.z > mine) + (q3.w > mine);
        tk[row * 16 + rank] = mine;
      }
    }
    __syncthreads();
    for (int tt = 0; tt < 4; ++tt) {
      const int tok = w * 4 + tt;
      int a = -1, bq = 0;
      {
        int c = lane;
        if (c < 16) { a = 0; bq = c; }
        else if (c < 24) { a = 1; bq = c - 16; }
        else if (c < 29) { a = 2; bq = c - 24; }
        else if (c < 33) { a = 3; bq = c - 29; }
        else if (c < 36) { a = 4; bq = c - 33; }
        else if (c < 38) { a = 5; bq = c - 36; }
        else if (c < 40) { a = 6; bq = c - 38; }
        else if (c < 42) { a = 7; bq = c - 40; }
        else if (c < 50) { a = c - 34; bq = 0; }
      }
      const bool act = a >= 0;
      const int ka = tk[(0 * 16 + tok) * 16 + (act ? a : 0)], kb = tk[(1 * 16 + tok) * 16 + bq];
      const float myv = act ? key_val(ka) + key_val(kb) : -3.0e38f;
      float* cv = cval + tok * 64;
      cv[lane] = myv;
      int rank = 0;
      for (int j = 0; j < 50; ++j) {
        const float vj = cv[j];
        rank += (vj > myv) || (vj == myv && j < lane);
      }
      float mx = act && rank == 0 ? myv : -3.0e38f;
#pragma unroll
      for (int o = 32; o >= 1; o >>= 1) mx = fmaxf(mx, __shfl_xor(mx, o));
      const bool win = act && rank < 16;
      const float ev = win ? __expf(myv - mx) : 0.f;
      const float sum = wave_sum(ev);
      if (win) {
        const int i0 = 127 - (ka & 0x7f), i1 = 127 - (kb & 0x7f);
        exi[tok * 128 + h * 16 + rank] = i0 * 128 + i1;
        exg[tok * 128 + h * 16 + rank] = ev / sum;
      }
    }
    __syncthreads();
  }
  for (int tt = 0; tt < 4; ++tt) {
    const int tok = w * 4 + tt;
    const size_t gt = (size_t)t0 + tok;
    const int b = (int)(gt / S);
    float hf[32];
#pragma unroll
    for (int i = 0; i < 2; ++i)
#pragma unroll
      for (int hh = 0; hh < 2; ++hh) {
        const u32x4 hv = *(const u32x4*)(p.H2 + gt * D + (i * 64 + lane) * 16 + hh * 8);
#pragma unroll
        for (int j = 0; j < 4; ++j) { hf[i * 16 + hh * 8 + 2 * j] = bf_lo(hv[j]); hf[i * 16 + hh * 8 + 2 * j + 1] = bf_hi(hv[j]); }
      }
    auto load_rows = [&](u32x4 (&r)[8], const unsigned char* base, int e0) {
#pragma unroll
      for (int k = 0; k < 4; ++k) {
        const unsigned char* rp = base + (size_t)exi[tok * 128 + e0 + k] * D + lane * 16;
        r[2 * k] = *(const u32x4*)rp; r[2 * k + 1] = *(const u32x4*)(rp + 1024);
      }
    };
    auto dot_rows = [&](const u32x4 (&r)[8], int e0) {
      float sv[4];
#pragma unroll
      for (int k = 0; k < 4; ++k) {
        float sa = 0.f, sb = 0.f;
#pragma unroll
        for (int j = 0; j < 4; ++j) {
          const f32x2v a0 = __builtin_amdgcn_cvt_pk_f32_fp8((int)r[2 * k][j], false), a1 = __builtin_amdgcn_cvt_pk_f32_fp8((int)r[2 * k][j], true);
          const f32x2v b0 = __builtin_amdgcn_cvt_pk_f32_fp8((int)r[2 * k + 1][j], false), b1 = __builtin_amdgcn_cvt_pk_f32_fp8((int)r[2 * k + 1][j], true);
          sa += a0[0] * hf[j * 4 + 0] + a0[1] * hf[j * 4 + 1] + a1[0] * hf[j * 4 + 2] + a1[1] * hf[j * 4 + 3];
          sb += b0[0] * hf[16 + j * 4 + 0] + b0[1] * hf[16 + j * 4 + 1] + b1[0] * hf[16 + j * 4 + 2] + b1[1] * hf[16 + j * 4 + 3];
        }
        sv[k] = sa + sb;
      }
      float r2[2], r1;
      const bool h32 = (lane & 32) != 0, h16 = (lane & 16) != 0;
#pragma unroll
      for (int k = 0; k < 2; ++k) { const float mine = h32 ? sv[k + 2] : sv[k], oth = h32 ? sv[k] : sv[k + 2]; r2[k] = mine + __shfl_xor(oth, 32); }
      { const float mine = h16 ? r2[1] : r2[0], oth = h16 ? r2[0] : r2[1]; r1 = mine + __shfl_xor(oth, 16); }
      r1 += __shfl_xor(r1, 8); r1 += __shfl_xor(r1, 4); r1 += __shfl_xor(r1, 2); r1 += __shfl_xor(r1, 1);
      if ((lane & 15) == 0) {
        const int k = (h32 ? 2 : 0) + (h16 ? 1 : 0);
        const int ei = tok * 128 + e0 + k;
        exg[ei] = exg[ei] * gelu_tanh(r1 * (1.0f / U8_SCALE)) * (1.0f / V8_SCALE);
      }
    };
    u32x4 ra[8], rb[8];
    load_rows(ra, p.U8, 0);
#pragma unroll 1
    for (int e0 = 0; e0 < 128; e0 += 8) {
      load_rows(rb, p.U8, e0 + 4);
      dot_rows(ra, e0);
      load_rows(ra, p.U8, e0 + 8 < 128 ? e0 + 8 : 124);
      dot_rows(rb, e0 + 4);
    }
    float oacc[32];
#pragma unroll
    for (int i = 0; i < 32; ++i) oacc[i] = 0.f;
    auto acc_rows = [&](const u32x4 (&r)[8], int e0) {
#pragma unroll
      for (int k = 0; k < 4; ++k) {
        const float coef = exg[tok * 128 + e0 + k];
#pragma unroll
        for (int j = 0; j < 4; ++j) {
          const f32x2v a0 = __builtin_amdgcn_cvt_pk_f32_fp8((int)r[2 * k][j], false), a1 = __builtin_amdgcn_cvt_pk_f32_fp8((int)r[2 * k][j], true);
          const f32x2v b0 = __builtin_amdgcn_cvt_pk_f32_fp8((int)r[2 * k + 1][j], false), b1 = __builtin_amdgcn_cvt_pk_f32_fp8((int)r[2 * k + 1][j], true);
          oacc[j * 4 + 0] += coef * a0[0]; oacc[j * 4 + 1] += coef * a0[1]; oacc[j * 4 + 2] += coef * a1[0]; oacc[j * 4 + 3] += coef * a1[1];
          oacc[16 + j * 4 + 0] += coef * b0[0]; oacc[16 + j * 4 + 1] += coef * b0[1]; oacc[16 + j * 4 + 2] += coef * b1[0]; oacc[16 + j * 4 + 3] += coef * b1[1];
        }
      }
    };
    load_rows(ra, p.V8, 0);
#pragma unroll 1
    for (int e0 = 0; e0 < 128; e0 += 8) {
      load_rows(rb, p.V8, e0 + 4);
      acc_rows(ra, e0);
      load_rows(ra, p.V8, e0 + 8 < 128 ? e0 + 8 : 124);
      acc_rows(rb, e0 + 4);
    }
    const float* g2 = p.mod + (size_t)b * 12288 + 5 * D;
    float ss = 0.f;
#pragma unroll
    for (int i = 0; i < 2; ++i)
#pragma unroll
      for (int q4 = 0; q4 < 4; ++q4) {
        const int col = (i * 64 + lane) * 16 + q4 * 4;
        const f32x4 x1 = *(const f32x4*)(p.X1 + gt * D + col), gg = *(const f32x4*)(g2 + col);
#pragma unroll
        for (int j = 0; j < 4; ++j) {
          const float v = x1[j] + gg[j] * oacc[i * 16 + q4 * 4 + j];
          oacc[i * 16 + q4 * 4 + j] = v;
          ss += v * v;
        }
      }
    ss = wave_sum(ss);
    const float rstd = rsqrtf(ss * (1.0f / D) + 1e-6f);
#pragma unroll
    for (int i = 0; i < 2; ++i)
#pragma unroll
      for (int q4 = 0; q4 < 4; ++q4) {
        const int col = (i * 64 + lane) * 16 + q4 * 4;
        const f32x4 gf = *(const f32x4*)(p.g_final + col);
        f32x4 o;
#pragma unroll
        for (int j = 0; j < 4; ++j) o[j] = oacc[i * 16 + q4 * 4 + j] * rstd * gf[j];
        *(f32x4*)(p.out + gt * D + col) = o;
      }
  }
  __syncthreads();
}

DEV void phase9(const Params& p, char* lds) {
  for (int u = blockIdx.x; u < T / 16; u += gridDim.x) peer_unit(p, u, lds);
}
DEV void phase9_dynamic(const Params& p, char* lds, unsigned* unit_cnt, unsigned* panel_cnt) {
  int* slot = (int*)(lds + LDS_BYTES - 16);
  for (;;) {
    __syncthreads();
    if (threadIdx.x == 0) {
      const int u = (int)__hip_atomic_fetch_add(unit_cnt, 1u, __ATOMIC_RELAXED, __HIP_MEMORY_SCOPE_AGENT);
      if (u < T / 16) {
        while (__hip_atomic_load(panel_cnt + 16 * (u >> 3), __ATOMIC_RELAXED, __HIP_MEMORY_SCOPE_AGENT) < 16u) __builtin_amdgcn_s_sleep(8);
        __builtin_amdgcn_fence(__ATOMIC_ACQUIRE, "agent");
        asm volatile("s_waitcnt vmcnt(0)" ::: "memory");
      }
      *slot = u;
    }
    __syncthreads();
    const int u = *slot;
    if (u >= T / 16) break;
    peer_unit(p, u, lds);
  }
}

DEV void gbar(unsigned* bar, unsigned& gen) {
  asm volatile("s_waitcnt vmcnt(0) lgkmcnt(0)" ::: "memory");
  __syncthreads();
  gen += 1u;
  if (threadIdx.x == 0) {
    __builtin_amdgcn_fence(__ATOMIC_RELEASE, "agent");
    asm volatile("s_waitcnt vmcnt(0)" ::: "memory");
    const unsigned G = gridDim.x, bidx = blockIdx.x;
    if ((G & 63u) == 0u) {
      const unsigned x = bidx & 7u, j = bidx >> 3, n2 = G >> 6;
      unsigned* c1 = bar + 64 * (x * 8 + (j >> 3));
      unsigned* c2 = bar + 64 * (64 + x);
      unsigned* c3 = bar + 64 * 72;
      unsigned* flag = bar + 64 * (73 + x);
      if (__hip_atomic_fetch_add(c1, 1u, __ATOMIC_RELAXED, __HIP_MEMORY_SCOPE_AGENT) + 1u == gen * 8u)
        if (__hip_atomic_fetch_add(c2, 1u, __ATOMIC_RELAXED, __HIP_MEMORY_SCOPE_AGENT) + 1u == gen * n2)
          if (__hip_atomic_fetch_add(c3, 1u, __ATOMIC_RELAXED, __HIP_MEMORY_SCOPE_AGENT) + 1u == gen * 8u)
            for (unsigned k = 0; k < 8u; ++k) __hip_atomic_store(bar + 64 * (73 + k), gen, __ATOMIC_RELAXED, __HIP_MEMORY_SCOPE_AGENT);
      while (__hip_atomic_load(flag, __ATOMIC_RELAXED, __HIP_MEMORY_SCOPE_AGENT) < gen) __builtin_amdgcn_s_sleep(2);
    } else {
      unsigned* c = bar + 64 * 72;
      __hip_atomic_fetch_add(c, 1u, __ATOMIC_RELAXED, __HIP_MEMORY_SCOPE_AGENT);
      while (__hip_atomic_load(c, __ATOMIC_RELAXED, __HIP_MEMORY_SCOPE_AGENT) < gen * G) __builtin_amdgcn_s_sleep(2);
    }
    __builtin_amdgcn_fence(__ATOMIC_ACQUIRE, "agent");
    asm volatile("s_waitcnt vmcnt(0)" ::: "memory");
  }
  __syncthreads();
}

__global__ void __launch_bounds__(256, 2) mega(Params p_unused) {
  __shared__ __attribute__((aligned(16))) char lds[LDS_BYTES];
  cg::grid_group grid = cg::this_grid();
  const Params& p = *(const Params*)__builtin_amdgcn_kernarg_segment_ptr();
  const int lo = p.ph_lo, hi = p.ph_hi;
  unsigned gen = 0u;
  if (hi > lo) grid.sync();
#ifndef ONLY
#define ONLY -1
#endif
#ifndef REP
#define REP -1
#endif
#define PH_ON(n) ((ONLY < 0 || ONLY == (n)) && lo <= (n) && (n) <= hi)
#define RP(n) for (int rep_ = 0; rep_ < ((REP == (n)) ? 2 : 1); ++rep_)
#define SYNC_AFTER(n) if (lo <= (n) && (n) < hi) gbar(p.bar, gen);
  if (PH_ON(0)) RP(0) phase0(p, lds);
  SYNC_AFTER(0)
  if (PH_ON(1)) phase1(p);
  SYNC_AFTER(1)
  if (PH_ON(2)) RP(2) rms_mod_phase(p.x, p.g_mix, p.mod, 0, 1, p.H);
  SYNC_AFTER(2)
  if (PH_ON(3)) RP(3) { Epi1 e{p.Y, p.YT}; gemm_phase(p.H, p.WinT, T, LDY, D, lds, e); conv_drain(p, lds); }
  SYNC_AFTER(3)
  if (PH_ON(4)) RP(4) phase4(p, lds);
  SYNC_AFTER(4)
  if (PH_ON(5)) {
    const int G = gridDim.x, NC = G >= 512 ? 64 : 0;
    unsigned* ready = p.bar + 12288;
    phase5(p, lds, G - NC, ready);
    Epi2 e{p.x, p.mod, p.X1};
    gemm_phase(p.Omix, p.WoutT, T, D, D, lds, e, 0, nullptr, p.bar + 64 * 102, ready, 24u);
  }
  SYNC_AFTER(6)
  if (PH_ON(7)) RP(7) rms_mod_phase(p.X1, p.g_ffn, p.mod, 3, 4, p.H2);
  SYNC_AFTER(7)
  if (PH_ON(8)) {
    Epi3 e{p.Qp};
    unsigned* panel_cnt = p.bar + 8192;
    gemm_phase(p.H2, p.WqT, T, D, D, lds, e, (int)gridDim.x >= 256 ? 128 : (int)gridDim.x, panel_cnt);
    phase9_dynamic(p, lds, p.bar + 64 * 101, panel_cnt);
  }
}

extern "C" void kernel_launch(void* const* d_in, const int* in_sizes, int n_in, void* d_out, int out_size, void* d_ws, size_t ws_size,
                              hipStream_t stream) {
  static int grid_blocks = 0;
  if (!grid_blocks) {
    int dev = 0, cus = 0, per_cu = 0;
    (void)hipGetDevice(&dev);
    (void)hipDeviceGetAttribute(&cus, hipDeviceAttributeMultiprocessorCount, dev);
    (void)hipOccupancyMaxActiveBlocksPerMultiprocessor(&per_cu, mega, 256, 0);
    if (per_cu < 1) per_cu = 1;
    if (per_cu > 2) per_cu = 2;
    grid_blocks = cus * per_cu;
  }
  Params p;
  memset(&p, 0, sizeof(p));
  const float* const* in = (const float* const*)d_in;
  p.x = in[0]; p.c = in[1]; p.w_ada = in[2]; p.b_ada = in[3]; p.g_mix = in[4]; p.g_ffn = in[5]; p.g_final = in[6]; p.w_in = in[7];
  p.pe_k = in[8]; p.pe_v = in[9]; p.ck_w1 = in[10]; p.ck_w2 = in[11]; p.cv_w1 = in[12]; p.cv_w2 = in[13]; p.g_nsa = in[14];
  p.g_ret = in[15]; p.w_out = in[16]; p.w_q = in[17]; p.sub_keys = in[18]; p.peer_u = in[19]; p.peer_v = in[20];
  p.out = (float*)d_out;
  char* ws = (char*)d_ws;
  size_t off = 0;
  auto take = [&](size_t bytes) { char* r = ws + off; off += (bytes + 255) & ~(size_t)255; return r; };
  p.bar = (unsigned*)take(65536);
  p.mod_part = (float*)take((size_t)16 * 4 * 12288 * 4);
  p.mod = (float*)take((size_t)4 * 12288 * 4);
  p.cbias = (float*)take((size_t)2 * 32 * 128 * 4);
  p.WinT = (bf16_t*)take((size_t)LDY * 2048 * 2);
  p.WoutT = (bf16_t*)take((size_t)2048 * 2048 * 2);
  p.WqT = (bf16_t*)take((size_t)2048 * 2048 * 2);
  p.SK = (bf16_t*)take((size_t)8 * 2 * 128 * 128 * 2);
  p.U8 = (unsigned char*)take((size_t)16384 * 2048);
  p.V8 = (unsigned char*)take((size_t)16384 * 2048);
  p.w1T = (bf16_t*)take((size_t)2 * 128 * 2048 * 2);
  p.w2T = (bf16_t*)take((size_t)2 * 64 * 128 * 2);
  p.Kc = (bf16_t*)take((size_t)16 * 512 * 64 * 2);
  p.VcT = (bf16_t*)take((size_t)16 * 64 * 512 * 2);
  p.RT = (bf16_t*)take((size_t)32 * 64 * 16384 * 2);
  p.H = (bf16_t*)take((size_t)T * D * 2);
  p.Omix = p.H;
  p.Y = (bf16_t*)take((size_t)T * LDY * 2);
  p.X1 = (float*)d_out;
  p.H2 = (bf16_t*)p.Y;
  p.YT = (bf16_t*)take((size_t)NYT * LDT * 2);
  p.Qp = p.YT;
  if (off > ws_size) fprintf(stderr, "workspace too small: need %zu have %zu\n", off, ws_size);
  p.ph_lo = 0; p.ph_hi = 9;
  (void)hipMemsetAsync(p.bar, 0, 65536, stream);
  void* args[] = {&p};
  hipError_t e = hipLaunchCooperativeKernel((void*)mega, dim3(grid_blocks), dim3(256), args, 0, stream);
  if (e != hipSuccess) fprintf(stderr, "cooperative launch failed: %s (grid %d)\n", hipGetErrorString(e), grid_blocks);
}
```
